# Optimizing an MI355X kernel written in HIP

```python
import math
import jax, jax.numpy as jnp
from jax import lax
import numpy as np

D_MODEL = 1024
BATCH = 2
SEQ = 8192
DEPTH = 2

N_BRANCH = 4
A_HEADS = 4
A_HEAD_DIM = 128
A_WIDTH = A_HEADS * A_HEAD_DIM
IDX_HEADS = 4
IDX_DIM = 64
TOPK_MAX = 256
CB_WIDTH = 512
CB_CONV = 31
CC_WIDTH = 512
CC_CONV = 3
SB_HEADS = 4
SB_HEAD_DIM = 128
SB_WIDTH = SB_HEADS * SB_HEAD_DIM
D_FF = 2816
FFN_CONV = 3
ROPE_THETA = 500000.0
ROT_FRACTION_DIV = 4
BLOCK_Q = 128
NORM_EPS = 1e-6

SPLIT_SIZES = (A_WIDTH, A_WIDTH, A_WIDTH, IDX_HEADS * IDX_DIM, IDX_DIM, IDX_HEADS,
               2 * CB_WIDTH, 3 * CC_WIDTH, 3 * SB_WIDTH, N_BRANCH * D_MODEL)
N_IN = sum(SPLIT_SIZES)

kernel_name = "hybrid_gated_dsa_conformer_shortconv_stickbreak"


def _split_offsets(sizes):
    offs, acc = [], 0
    for s in sizes[:-1]:
        acc += s
        offs.append(acc)
    return offs


def rms_norm(x, g):
    xf = x.astype(jnp.float32)
    y = xf * lax.rsqrt(jnp.mean(xf * xf, axis=-1, keepdims=True) + NORM_EPS)
    return (y * g.astype(jnp.float32)).astype(x.dtype)


def layer_norm(x, g, b):
    xf = x.astype(jnp.float32)
    mu = jnp.mean(xf, axis=-1, keepdims=True)
    xc = xf - mu
    y = xc * lax.rsqrt(jnp.mean(xc * xc, axis=-1, keepdims=True) + NORM_EPS)
    return (y * g.astype(jnp.float32) + b.astype(jnp.float32)).astype(x.dtype)


def partial_rope(x, pos):
    d = x.shape[-1]
    rot = d // ROT_FRACTION_DIV
    half = rot // 2
    inv_freq = ROPE_THETA ** (-(jnp.arange(half, dtype=jnp.float32) * 2.0) / rot)
    ang = pos.astype(jnp.float32)[..., None] * inv_freq
    cos = jnp.cos(ang)[:, :, None, :]
    sin = jnp.sin(ang)[:, :, None, :]
    xf = x.astype(jnp.float32)
    x1, x2 = xf[..., :half], xf[..., half:rot]
    out = jnp.concatenate([x1 * cos - x2 * sin, x2 * cos + x1 * sin, xf[..., rot:]], axis=-1)
    return out.astype(x.dtype)


def causal_dwconv(x, w, b=None):
    width = w.shape[0]
    y = lax.conv_general_dilated(
        x, w.astype(x.dtype)[:, None, :], window_strides=(1,), padding=[(width - 1, 0)],
        dimension_numbers=('NWC', 'WIO', 'NWC'), feature_group_count=x.shape[-1])
    if b is not None:
        y = y + b.astype(x.dtype)
    return y


def _to_blocks(a, nb):
    return jnp.moveaxis(a.reshape((a.shape[0], nb, BLOCK_Q) + a.shape[2:]), 1, 0)


def _from_blocks(a):
    a = jnp.moveaxis(a, 0, 1)
    return a.reshape(a.shape[0], -1, a.shape[-2] * a.shape[-1])


def dsa_attention(q, k, v, q_idx, k_idx, w_idx):
    bsz, seq = q.shape[0], q.shape[1]
    nb = seq // BLOCK_Q
    k_sel = min(TOPK_MAX, seq // 4)
    kv = jnp.stack([k, v], axis=2)
    s_idx = jnp.arange(seq)
    k_idx_f = k_idx.astype(jnp.float32)

    def block(args):
        qb, qib, wb, tb = args
        rel = jax.nn.relu(jnp.einsum('bthd,bsd->bths', qib.astype(jnp.float32), k_idx_f) * IDX_DIM ** -0.5)
        score = jnp.einsum('bths,bth->bts', rel, wb.astype(jnp.float32)) * IDX_HEADS ** -0.5
        causal = s_idx[None, :] <= tb[:, None]
        score = jnp.where(causal[None], score, -jnp.inf)
        _, sel = lax.top_k(score, k_sel)
        valid = sel <= tb[None, :, None]
        kv_sel = jax.vmap(lambda a, i: a[i])(kv, sel)
        logits = jnp.einsum('bthd,btkhd->bthk', qb.astype(jnp.float32),
                            kv_sel[:, :, :, 0].astype(jnp.float32)) * A_HEAD_DIM ** -0.5
        logits = jnp.where(valid[:, :, None, :], logits, -jnp.inf)
        p = jax.nn.softmax(logits, axis=-1)
        out = jnp.einsum('bthk,btkhd->bthd', p, kv_sel[:, :, :, 1].astype(jnp.float32))
        return out.astype(qb.dtype)

    t_blocks = jnp.arange(seq).reshape(nb, BLOCK_Q)
    out = lax.map(block, (_to_blocks(q, nb), _to_blocks(q_idx, nb), _to_blocks(w_idx, nb), t_blocks))
    return _from_blocks(out)


def stick_breaking_attention(q, k, v):
    seq = q.shape[1]
    nb = seq // BLOCK_Q
    s_idx = jnp.arange(seq)
    k_f = k.astype(jnp.float32)
    v_f = v.astype(jnp.float32)

    def block(args):
        qb, tb = args
        z = jnp.einsum('bthd,bshd->bhts', qb.astype(jnp.float32), k_f) * SB_HEAD_DIM ** -0.5
        mask = (s_idx[None, :] < tb[:, None])[None, None]
        log_keep = jnp.where(mask, jax.nn.log_sigmoid(-z), 0.0)
        between = lax.cumsum(log_keep, axis=3, reverse=True) - log_keep
        a = jnp.where(mask, jnp.exp(jax.nn.log_sigmoid(z) + between), 0.0)
        return jnp.einsum('bhts,bshd->bthd', a, v_f).astype(qb.dtype)

    t_blocks = jnp.arange(seq).reshape(nb, BLOCK_Q)
    out = lax.map(block, (_to_blocks(q, nb), t_blocks))
    return _from_blocks(out)


def setup_inputs(seed: int = 0) -> dict:
    key = jax.random.key(seed)
    ks = jax.random.split(key, 24)
    f32 = jnp.float32

    def nrm(k, shape, scale):
        return jax.random.normal(k, shape, f32) * scale

    def gain(k, shape):
        return 1.0 + 0.05 * jax.random.normal(k, shape, f32)

    L, D = DEPTH, D_MODEL
    return {
        "x": jax.random.normal(ks[0], (BATCH, SEQ, D), f32),
        "positions": jnp.broadcast_to(jnp.arange(SEQ, dtype=jnp.int32), (BATCH, SEQ)),
        "g_mix": gain(ks[1], (L, D)),
        "w_in": nrm(ks[2], (L, D, N_IN), D ** -0.5),
        "b_gate": nrm(ks[3], (L, N_BRANCH * D), 0.1),
        "g_qa": gain(ks[4], (L, A_HEAD_DIM)),
        "g_ka": gain(ks[5], (L, A_HEAD_DIM)),
        "g_kidx": gain(ks[6], (L, IDX_DIM)),
        "w_oa": nrm(ks[7], (L, A_WIDTH, D), A_WIDTH ** -0.5),
        "cb_conv_w": nrm(ks[8], (L, CB_CONV, CB_WIDTH), CB_CONV ** -0.5),
        "cb_conv_b": nrm(ks[9], (L, CB_WIDTH), 0.02),
        "cb_ln_g": gain(ks[10], (L, CB_WIDTH)),
        "cb_ln_b": nrm(ks[11], (L, CB_WIDTH), 0.02),
        "w_ob": nrm(ks[12], (L, CB_WIDTH, D), CB_WIDTH ** -0.5),
        "cc_conv_w": nrm(ks[13], (L, CC_CONV, CC_WIDTH), CC_CONV ** -0.5),
        "w_oc": nrm(ks[14], (L, CC_WIDTH, D), CC_WIDTH ** -0.5),
        "w_od": nrm(ks[15], (L, SB_WIDTH, D), SB_WIDTH ** -0.5),
        "w_merge": nrm(ks[16], (L, D, D), D ** -0.5),
        "g_ffn": gain(ks[17], (L, D)),
        "w_ffn_gate": nrm(ks[18], (L, D, D_FF), D ** -0.5),
        "w_ffn_up": nrm(ks[19], (L, D, D_FF), D ** -0.5),
        "ffn_conv_w": nrm(ks[20], (L, FFN_CONV, D_FF), FFN_CONV ** -0.5),
        "w_ffn_down": nrm(ks[21], (L, D_FF, D), D_FF ** -0.5),
    }


def reference(x, positions, g_mix, w_in, b_gate, g_qa, g_ka, g_kidx, w_oa,
              cb_conv_w, cb_conv_b, cb_ln_g, cb_ln_b, w_ob, cc_conv_w, w_oc, w_od,
              w_merge, g_ffn, w_ffn_gate, w_ffn_up, ffn_conv_w, w_ffn_down):
    bsz, seq, dm = x.shape
    offs = _split_offsets(SPLIT_SIZES)
    for l in range(DEPTH):
        h = rms_norm(x, g_mix[l])
        proj = h @ w_in[l]
        aq, ak, av, iq, ik, iw, glu_in, cc_in, sb_in, gate_in = jnp.split(proj, offs, axis=-1)

        qa = partial_rope(rms_norm(aq.reshape(bsz, seq, A_HEADS, A_HEAD_DIM), g_qa[l]), positions)
        ka = partial_rope(rms_norm(ak.reshape(bsz, seq, A_HEADS, A_HEAD_DIM), g_ka[l]), positions)
        va = av.reshape(bsz, seq, A_HEADS, A_HEAD_DIM)
        qi = partial_rope(iq.reshape(bsz, seq, IDX_HEADS, IDX_DIM), positions)
        ki = partial_rope(rms_norm(ik, g_kidx[l])[:, :, None, :], positions)[:, :, 0]
        y_a = dsa_attention(qa, ka, va, qi, ki, iw) @ w_oa[l]

        glu_a, glu_b = jnp.split(glu_in, 2, axis=-1)
        u = causal_dwconv(glu_a * jax.nn.sigmoid(glu_b), cb_conv_w[l], cb_conv_b[l])
        y_b = jax.nn.silu(layer_norm(u, cb_ln_g[l], cb_ln_b[l])) @ w_ob[l]

        gb, gc, xc = jnp.split(cc_in, 3, axis=-1)
        y_c = (gb * causal_dwconv(gc * xc, cc_conv_w[l])) @ w_oc[l]

        sq, sk, sv = jnp.split(sb_in, 3, axis=-1)
        shp = (bsz, seq, SB_HEADS, SB_HEAD_DIM)
        y_d = stick_breaking_attention(sq.reshape(shp), sk.reshape(shp), sv.reshape(shp)) @ w_od[l]

        gates = jax.nn.sigmoid(gate_in + b_gate[l]).reshape(bsz, seq, N_BRANCH, dm)
        merged = (gates[:, :, 0] * y_a + gates[:, :, 1] * y_b
                  + gates[:, :, 2] * y_c + gates[:, :, 3] * y_d)
        x = x + merged @ w_merge[l]

        h2 = rms_norm(x, g_ffn[l])
        gt = causal_dwconv(h2 @ w_ffn_gate[l], ffn_conv_w[l])
        x = x + (jax.nn.silu(gt) * (h2 @ w_ffn_up[l])) @ w_ffn_down[l]
    return x
```

```cpp
#include <hip/hip_runtime.h>
#include <cstdint>
#include <cstdio>
#include <cmath>

typedef unsigned short bf16_t;
typedef short bf16x8 __attribute__((ext_vector_type(8)));
typedef float f32x4 __attribute__((ext_vector_type(4)));
typedef unsigned u32x4 __attribute__((ext_vector_type(4)));
typedef unsigned u32x2 __attribute__((ext_vector_type(2)));

constexpr int SEQ = 8192, DM = 1024, MTOK = 2 * SEQ, DEPTH = 2, NIN_SRC = 10052, DFF = 2816;
constexpr float EPS = 1e-6f;
constexpr float QSCALE = 0.08838834764831845f * 1.4426950408889634f;

constexpr size_t MiB = 1u << 20;
constexpr size_t WS_WIN = 1 * MiB, WS_WGATE = 13 * MiB, WS_WO = 21 * MiB, WS_WM = 25 * MiB, WS_WFG = 27 * MiB, WS_WFU = WS_WFG + 5767168, WS_WFD = WS_WFU + 5767168;
constexpr size_t WS_H = 44 * MiB;
constexpr size_t WS_QA = 76 * MiB, WS_GLUB = 92 * MiB, WS_XC = 108 * MiB, WS_SQ = 124 * MiB;
constexpr size_t WS_KA = 140 * MiB, WS_VA = 156 * MiB, WS_IDX = 172 * MiB, WS_GLUA = 188 * MiB, WS_GB = 204 * MiB, WS_GC = 220 * MiB, WS_SK = 236 * MiB, WS_SV = 252 * MiB;
constexpr size_t WS_MASK = 268 * MiB, WS_END = 284 * MiB;
constexpr size_t WS_GATES = 140 * MiB;
constexpr size_t WS_GP = 76 * MiB, WS_ACT = 164 * MiB;
constexpr size_t WS_BR = WS_QA;

__device__ __forceinline__ float bf2f(bf16_t b) { return __uint_as_float((unsigned)b << 16); }
__device__ __forceinline__ float bfs2f(short b) { return __uint_as_float(((unsigned)(unsigned short)b) << 16); }
__device__ __forceinline__ unsigned f2bf(float f) { unsigned u = __float_as_uint(f); return (u + 0x7fffu + ((u >> 16) & 1u)) >> 16; }
__device__ __forceinline__ unsigned pk2(float lo, float hi) { return f2bf(lo) | (f2bf(hi) << 16); }
__device__ __forceinline__ float wave_sum(float v) {
#pragma unroll
    for (int o = 32; o > 0; o >>= 1) v += __shfl_xor(v, o);
    return v;
}
__device__ __forceinline__ float wave_max(float v) {
#pragma unroll
    for (int o = 32; o > 0; o >>= 1) v = fmaxf(v, __shfl_xor(v, o));
    return v;
}
__device__ __forceinline__ unsigned wave_sum_u(unsigned v) {
#pragma unroll
    for (int o = 32; o > 0; o >>= 1) v += __shfl_xor(v, o);
    return v;
}
__device__ __forceinline__ float sigmoidf_(float x) { return 1.f / (1.f + expf(-x)); }

struct ConvJob { const float* src; bf16_t* dst; int K, Nsrc, Ndst, mode, srcoff, pad; };
__host__ __device__ __forceinline__ int win_srccol(int n) { int g = n >> 9, j = n & 511; if (g < 3) return n; if (g == 3) return j < 324 ? 1536 + j : -1; return 1860 + (g - 4) * 512 + j; }
__global__ __launch_bounds__(256) void k_convert(ConvJob jb) {
    __shared__ float tile[64][65];
    const int n0 = blockIdx.x * 64, k0 = blockIdx.y * 64, tx = threadIdx.x & 63, ty = threadIdx.x >> 6;
    const int n = n0 + tx; const int sc = (jb.mode == 1) ? win_srccol(n) : jb.srcoff + n;
    for (int i = ty; i < 64; i += 4) { float v = 0.f; if (sc >= 0) v = jb.src[(size_t)(k0 + i) * jb.Nsrc + sc]; tile[i][tx] = v; }
    __syncthreads();
    for (int c = threadIdx.x; c < 512; c += 256) {
        const int nn = c >> 3, ch = c & 7; u32x4 w;
        w.x = pk2(tile[ch * 8 + 0][nn], tile[ch * 8 + 1][nn]); w.y = pk2(tile[ch * 8 + 2][nn], tile[ch * 8 + 3][nn]);
        w.z = pk2(tile[ch * 8 + 4][nn], tile[ch * 8 + 5][nn]); w.w = pk2(tile[ch * 8 + 6][nn], tile[ch * 8 + 7][nn]);
        *(u32x4*)(jb.dst + (size_t)(n0 + nn) * jb.K + k0 + ch * 8) = w;
    }
}

__global__ __launch_bounds__(256) void k_rmsnorm(const float* x, float* xcopy, const float* g, bf16_t* out) {
    const int wave = threadIdx.x >> 6, lane = threadIdx.x & 63; const int m = blockIdx.x * 4 + wave;
    const f32x4* xr = (const f32x4*)(x + (size_t)m * DM) + lane; f32x4 v[4]; float s = 0.f;
#pragma unroll
    for (int j = 0; j < 4; ++j) { v[j] = xr[64 * j]; s += (v[j].x * v[j].x + v[j].y * v[j].y) + (v[j].z * v[j].z + v[j].w * v[j].w); }
    s = wave_sum(s); const float r = rsqrtf(s * (1.f / DM) + EPS);
    if (xcopy) {
#pragma unroll
        for (int j = 0; j < 4; ++j) ((f32x4*)(xcopy + (size_t)m * DM) + lane)[64 * j] = v[j];
    }
#pragma unroll
    for (int j = 0; j < 4; ++j) { const f32x4 gg = ((const f32x4*)g + lane)[64 * j]; u32x2 w; w.x = pk2(v[j].x * r * gg.x, v[j].y * r * gg.y); w.y = pk2(v[j].z * r * gg.z, v[j].w * r * gg.w);
        *(u32x2*)(out + (size_t)m * DM + (64 * j + lane) * 4) = w; }
}

__device__ __forceinline__ void store4bf(bf16_t* p, f32x4 v) { u32x2 w; w.x = pk2(v.x, v.y); w.y = pk2(v.z, v.w); *(u32x2*)p = w; }
__device__ __forceinline__ f32x4 load4bf(const bf16_t* p) { const u32x2 w = *(const u32x2*)p; f32x4 r; r.x = __uint_as_float(w.x << 16); r.y = __uint_as_float(w.x & 0xffff0000u); r.z = __uint_as_float(w.y << 16); r.w = __uint_as_float(w.y & 0xffff0000u); return r; }
struct EpiSplit { char* ws; size_t goff[12];
    __device__ __forceinline__ void operator()(int row, int col, f32x4 v) const { store4bf((bf16_t*)(ws + goff[col >> 9]) + (size_t)row * 512 + (col & 511), v); } };
struct EpiGates { bf16_t* G; const float* bias;
    __device__ __forceinline__ void operator()(int row, int col, f32x4 v) const { const f32x4 b = *(const f32x4*)(bias + col); f32x4 o; o.x = sigmoidf_(v.x + b.x); o.y = sigmoidf_(v.y + b.y); o.z = sigmoidf_(v.z + b.z); o.w = sigmoidf_(v.w + b.w);
        store4bf(G + (size_t)row * 4096 + col, o); } };
struct EpiOut { const bf16_t* G; bf16_t* Mg; int br, pad;
    __device__ __forceinline__ void operator()(int row, int col, f32x4 v) const { const f32x4 g = load4bf(G + (size_t)row * 4096 + br * 1024 + col); f32x4 p = (f32x4){0.f, 0.f, 0.f, 0.f};
        if (br) p = load4bf(Mg + (size_t)row * DM + col); store4bf(Mg + (size_t)row * DM + col, p + g * v); } };
struct EpiResid { float* x;
    __device__ __forceinline__ void operator()(int row, int col, f32x4 v) const { f32x4* p = (f32x4*)(x + (size_t)row * DM + col); *p = *p + v; } };
struct EpiStore { bf16_t* O; int ldc, pad;
    __device__ __forceinline__ void operator()(int row, int col, f32x4 v) const { store4bf(O + (size_t)row * ldc + col, v); } };
struct EpiFfnAct { const bf16_t* GP; const float* cw; bf16_t* ACT;
    __device__ __forceinline__ void operator()(int row, int col, f32x4 v) const {
        const int t = row & (SEQ - 1); const f32x4 z = (f32x4){0.f, 0.f, 0.f, 0.f};
        const f32x4 g2 = load4bf(GP + (size_t)row * DFF + col), g1 = t >= 1 ? load4bf(GP + (size_t)(row - 1) * DFF + col) : z, g0 = t >= 2 ? load4bf(GP + (size_t)(row - 2) * DFF + col) : z;
        const f32x4 w0 = *(const f32x4*)(cw + col), w1 = *(const f32x4*)(cw + DFF + col), w2 = *(const f32x4*)(cw + 2 * DFF + col);
        const f32x4 gt = w0 * g0 + w1 * g1 + w2 * g2; f32x4 o;
        o.x = gt.x * sigmoidf_(gt.x) * v.x; o.y = gt.y * sigmoidf_(gt.y) * v.y; o.z = gt.z * sigmoidf_(gt.z) * v.z; o.w = gt.w * sigmoidf_(gt.w) * v.w;
        store4bf(ACT + (size_t)row * DFF + col, o); } };

template <class Epi> struct GemmArgs { const bf16_t* A; const bf16_t* Bt; int lda, ldb, K, pad; Epi epi; };
template <class Epi>
__global__ __launch_bounds__(256) void k_gemm_simple(GemmArgs<Epi> ga) {
    const bf16_t* A = ga.A; const bf16_t* Bt = ga.Bt; const int lda = ga.lda, ldb = ga.ldb, K = ga.K; const Epi& epi = ga.epi;
    const int lane = threadIdx.x & 63, w = threadIdx.x >> 6, fr = lane & 15, fq = lane >> 4;
    const int row0 = blockIdx.y * 128 + (w >> 1) * 64, col0 = blockIdx.x * 128 + (w & 1) * 64;
    f32x4 acc[4][4];
#pragma unroll
    for (int i = 0; i < 4; ++i)
#pragma unroll
        for (int j = 0; j < 4; ++j) acc[i][j] = (f32x4){0.f, 0.f, 0.f, 0.f};
    const bf16_t* ap = A + (size_t)(row0 + fr) * lda + fq * 8; const bf16_t* bp = Bt + (size_t)(col0 + fr) * ldb + fq * 8;
    for (int k0 = 0; k0 < K; k0 += 32) {
        bf16x8 a[4], b[4];
#pragma unroll
        for (int i = 0; i < 4; ++i) { a[i] = *(const bf16x8*)(ap + (size_t)(i * 16) * lda + k0); b[i] = *(const bf16x8*)(bp + (size_t)(i * 16) * ldb + k0); }
#pragma unroll
        for (int i = 0; i < 4; ++i)
#pragma unroll
            for (int j = 0; j < 4; ++j) acc[i][j] = __builtin_amdgcn_mfma_f32_16x16x32_bf16(b[j], a[i], acc[i][j], 0, 0, 0);
    }
#pragma unroll
    for (int i = 0; i < 4; ++i)
#pragma unroll
        for (int j = 0; j < 4; ++j) epi(row0 + i * 16 + fr, col0 + j * 16 + fq * 4, acc[i][j]);
}

__global__ __launch_bounds__(256) void k_prepass(char* ws, const int* positions, const float* g_qa, const float* g_ka, const float* g_kidx) {
    const int m = blockIdx.x, tid = threadIdx.x, w = tid >> 6, lane = tid & 63;
    const float pos = (float)positions[m];
#pragma unroll
    for (int which = 0; which < 2; ++which) {
        bf16_t* p = (bf16_t*)(ws + (which ? WS_KA : WS_QA)) + (size_t)m * 512 + w * 128; const float* g = which ? g_ka : g_qa;
        const float v0 = bf2f(p[lane]), v1 = bf2f(p[lane + 64]);
        const float ss = wave_sum(v0 * v0 + v1 * v1); const float r = rsqrtf(ss * (1.f / 128.f) + EPS);
        float y0 = v0 * r * g[lane]; const float y1 = v1 * r * g[lane + 64];
        const float part = __shfl_xor(y0, 16);
        if (lane < 32) { const int i = lane & 15; const float inv = powf(500000.f, -((float)i * 2.0f) / 32.f); const float ang = pos * inv; const float c = cosf(ang), s = sinf(ang);
            y0 = (lane < 16) ? y0 * c - part * s : y0 * c + part * s; }
        const float sc = which ? 1.f : QSCALE;
        p[lane] = (bf16_t)f2bf(y0 * sc); p[lane + 64] = (bf16_t)f2bf(y1 * sc);
    }
    bf16_t* ix = (bf16_t*)(ws + WS_IDX) + (size_t)m * 512;
    const float wv = bf2f(ix[320 + w]);
    {
        float y = bf2f(ix[w * 64 + lane]); const float part = __shfl_xor(y, 8);
        if (lane < 16) { const int i = lane & 7; const float inv = powf(500000.f, -((float)i * 2.0f) / 16.f); const float ang = pos * inv; const float c = cosf(ang), s = sinf(ang);
            y = (lane < 8) ? y * c - part * s : y * c + part * s; }
        ix[w * 64 + lane] = (bf16_t)f2bf(y * wv * 0.0625f);
    }
    if (w == 0) {
        const float v = bf2f(ix[256 + lane]); const float ss = wave_sum(v * v); const float r = rsqrtf(ss * (1.f / 64.f) + EPS);
        float y = v * r * g_kidx[lane]; const float part = __shfl_xor(y, 8);
        if (lane < 16) { const int i = lane & 7; const float inv = powf(500000.f, -((float)i * 2.0f) / 16.f); const float ang = pos * inv; const float c = cosf(ang), s = sinf(ang);
            y = (lane < 8) ? y * c - part * s : y * c + part * s; }
        ix[256 + lane] = (bf16_t)f2bf(y);
    }
    bf16_t* ga = (bf16_t*)(ws + WS_GLUA) + (size_t)m * 512; const bf16_t* gb = (const bf16_t*)(ws + WS_GLUB) + (size_t)m * 512;
    bf16_t* gc = (bf16_t*)(ws + WS_GC) + (size_t)m * 512; const bf16_t* xc = (const bf16_t*)(ws + WS_XC) + (size_t)m * 512;
    bf16_t* sq = (bf16_t*)(ws + WS_SQ) + (size_t)m * 512;
#pragma unroll
    for (int e = 0; e < 2; ++e) { const int c = tid + e * 256;
        ga[c] = (bf16_t)f2bf(bf2f(ga[c]) * sigmoidf_(bf2f(gb[c])));
        gc[c] = (bf16_t)f2bf(bf2f(gc[c]) * bf2f(xc[c]));
        sq[c] = (bf16_t)f2bf(bf2f(sq[c]) * QSCALE); }
}

__global__ __launch_bounds__(256) void k_conv(char* ws, const float* cbw, const float* cbb, const float* lng, const float* lnb, const float* ccw) {
    const int wave = threadIdx.x >> 6, lane = threadIdx.x & 63; const int m = blockIdx.x * 4 + wave; const int t = m & (SEQ - 1); const int c0 = lane * 8;
    {
        const bf16_t* U = (const bf16_t*)(ws + WS_GLUA); float acc[8];
#pragma unroll
        for (int j = 0; j < 8; ++j) acc[j] = cbb[c0 + j];
        for (int k = 0; k < 31; ++k) { const int tt = t - 30 + k; if (tt < 0) continue;
            const bf16x8 u = *(const bf16x8*)(U + (size_t)(m - 30 + k) * 512 + c0);
#pragma unroll
            for (int j = 0; j < 8; ++j) acc[j] += cbw[k * 512 + c0 + j] * bfs2f(u[j]); }
        float s = 0.f;
#pragma unroll
        for (int j = 0; j < 8; ++j) s += acc[j];
        const float mean = wave_sum(s) * (1.f / 512.f); float q = 0.f;
#pragma unroll
        for (int j = 0; j < 8; ++j) { acc[j] -= mean; q += acc[j] * acc[j]; }
        const float r = rsqrtf(wave_sum(q) * (1.f / 512.f) + EPS); float o[8];
#pragma unroll
        for (int j = 0; j < 8; ++j) { const float y = acc[j] * r * lng[c0 + j] + lnb[c0 + j]; o[j] = y * sigmoidf_(y); }
        u32x4 wv; wv.x = pk2(o[0], o[1]); wv.y = pk2(o[2], o[3]); wv.z = pk2(o[4], o[5]); wv.w = pk2(o[6], o[7]);
        *(u32x4*)((bf16_t*)(ws + WS_GLUB) + (size_t)m * 512 + c0) = wv;
    }
    {
        const bf16_t* X = (const bf16_t*)(ws + WS_GC); float acc[8];
#pragma unroll
        for (int j = 0; j < 8; ++j) acc[j] = 0.f;
        for (int k = 0; k < 3; ++k) { const int tt = t - 2 + k; if (tt < 0) continue;
            const bf16x8 u = *(const bf16x8*)(X + (size_t)(m - 2 + k) * 512 + c0);
#pragma unroll
            for (int j = 0; j < 8; ++j) acc[j] += ccw[k * 512 + c0 + j] * bfs2f(u[j]); }
        const bf16x8 g = *(const bf16x8*)((const bf16_t*)(ws + WS_GB) + (size_t)m * 512 + c0); float o[8];
#pragma unroll
        for (int j = 0; j < 8; ++j) o[j] = acc[j] * bfs2f(g[j]);
        u32x4 wv; wv.x = pk2(o[0], o[1]); wv.y = pk2(o[2], o[3]); wv.z = pk2(o[4], o[5]); wv.w = pk2(o[6], o[7]);
        *(u32x4*)((bf16_t*)(ws + WS_XC) + (size_t)m * 512 + c0) = wv;
    }
}

__device__ __forceinline__ unsigned sortkey(float f) { const unsigned u = __float_as_uint(f); return (u & 0x80000000u) ? ~u : (u | 0x80000000u); }
__global__ __launch_bounds__(256) void k_topk_naive(const char* ws, unsigned* MASK) {
    __shared__ unsigned sc[SEQ]; __shared__ float qf[256]; __shared__ unsigned maskw[256]; __shared__ float wsg[4]; __shared__ unsigned cnt_s;
    const int m = blockIdx.x, b = m >> 13, t = m & (SEQ - 1), tid = threadIdx.x, lane = tid & 63;
    const bf16_t* IX = (const bf16_t*)(ws + WS_IDX);
    qf[tid] = bf2f(IX[(size_t)m * 512 + tid]); maskw[tid] = 0u; if (tid < 4) wsg[tid] = bf2f(IX[(size_t)m * 512 + 320 + tid]);
    __syncthreads();
    const int n = t + 1;
    for (int s = tid; s < n; s += 256) {
        const bf16x8* kp = (const bf16x8*)(IX + (size_t)(b * SEQ + s) * 512 + 256); float x0 = 0.f, x1 = 0.f, x2 = 0.f, x3 = 0.f;
#pragma unroll
        for (int c = 0; c < 8; ++c) { const bf16x8 kk = kp[c];
#pragma unroll
            for (int j = 0; j < 8; ++j) { const float kv = bfs2f(kk[j]); const int d = c * 8 + j; x0 += qf[d] * kv; x1 += qf[64 + d] * kv; x2 += qf[128 + d] * kv; x3 += qf[192 + d] * kv; } }
        float score = (wsg[0] >= 0.f ? fmaxf(x0, 0.f) : fminf(x0, 0.f));
        score += (wsg[1] >= 0.f ? fmaxf(x1, 0.f) : fminf(x1, 0.f));
        score += (wsg[2] >= 0.f ? fmaxf(x2, 0.f) : fminf(x2, 0.f));
        score += (wsg[3] >= 0.f ? fmaxf(x3, 0.f) : fminf(x3, 0.f));
        sc[s] = sortkey(score);
    }
    __syncthreads();
    if (n <= 256) { if (tid < n) atomicOr(&maskw[tid >> 5], 1u << (tid & 31)); }
    else {
        unsigned T = 0u;
        for (int bit = 31; bit >= 0; --bit) {
            const unsigned cand = T | (1u << bit);
            if (tid == 0) cnt_s = 0u;
            __syncthreads();
            unsigned c = 0u; for (int s = tid; s < n; s += 256) c += (sc[s] >= cand) ? 1u : 0u;
            c = wave_sum_u(c); if (lane == 0) atomicAdd(&cnt_s, c);
            __syncthreads();
            if (cnt_s >= 256u) T = cand;
            __syncthreads();
        }
        if (tid == 0) cnt_s = 0u;
        __syncthreads();
        { unsigned c = 0u; for (int s = tid; s < n; s += 256) c += (sc[s] > T) ? 1u : 0u; c = wave_sum_u(c); if (lane == 0) atomicAdd(&cnt_s, c); }
        __syncthreads();
        const int need = 256 - (int)cnt_s;
        for (int s = tid; s < n; s += 256) if (sc[s] > T) atomicOr(&maskw[s >> 5], 1u << (s & 31));
        if (tid < 64) { int taken = 0;
            for (int base = 0; base < n && taken < need; base += 64) { const int s = base + lane; const bool tie = (s < n) && (sc[s] == T);
                const unsigned long long bal = __ballot(tie); const int pre = __popcll(bal & ((1ull << lane) - 1ull));
                if (tie && taken + pre < need) atomicOr(&maskw[s >> 5], 1u << (s & 31));
                taken += __popcll(bal); } }
    }
    __syncthreads();
    MASK[(size_t)m * 256 + tid] = maskw[tid];
}

__device__ __forceinline__ float block_max256(float v, float* red) { v = wave_max(v); __syncthreads(); if ((threadIdx.x & 63) == 0) red[threadIdx.x >> 6] = v; __syncthreads(); return fmaxf(fmaxf(red[0], red[1]), fmaxf(red[2], red[3])); }
__device__ __forceinline__ float block_sum256(float v, float* red) { v = wave_sum(v); __syncthreads(); if ((threadIdx.x & 63) == 0) red[threadIdx.x >> 6] = v; __syncthreads(); return (red[0] + red[1]) + (red[2] + red[3]); }

__global__ __launch_bounds__(256) void k_attnA_naive(char* ws) {
    __shared__ int sel[256]; __shared__ float q[512]; __shared__ float p[256]; __shared__ float red[4]; __shared__ int pre[256]; __shared__ float osum[256];
    const int m = blockIdx.x, b = m >> 13, tid = threadIdx.x;
    const unsigned* MW = (const unsigned*)(ws + WS_MASK) + (size_t)m * 256; bf16_t* QA = (bf16_t*)(ws + WS_QA) + (size_t)m * 512;
    const bf16_t* KA = (const bf16_t*)(ws + WS_KA); const bf16_t* VA = (const bf16_t*)(ws + WS_VA);
    q[tid] = bf2f(QA[tid]); q[tid + 256] = bf2f(QA[tid + 256]);
    unsigned w = MW[tid]; const int c = __popc(w); pre[tid] = c; sel[tid] = 0;
    __syncthreads();
    for (int o = 1; o < 256; o <<= 1) { const int v = tid >= o ? pre[tid - o] : 0; __syncthreads(); pre[tid] += v; __syncthreads(); }
    int off = pre[tid] - c; int nsel = pre[255]; if (nsel > 256) nsel = 256;
    while (w) { const int bit = __ffs(w) - 1; w &= w - 1u; if (off < 256) sel[off] = tid * 32 + bit; ++off; }
    __syncthreads();
    for (int h = 0; h < 4; ++h) {
        float l = -INFINITY;
        if (tid < nsel) { const bf16x8* kp = (const bf16x8*)(KA + (size_t)(b * SEQ + sel[tid]) * 512 + h * 128); float a = 0.f;
#pragma unroll
            for (int cc = 0; cc < 16; ++cc) { const bf16x8 kk = kp[cc];
#pragma unroll
                for (int j = 0; j < 8; ++j) a += q[h * 128 + cc * 8 + j] * bfs2f(kk[j]); }
            l = a; }
        const float mx = block_max256(l, red); const float e = tid < nsel ? exp2f(l - mx) : 0.f; const float sum = block_sum256(e, red);
        p[tid] = e; __syncthreads();
        const int d = tid & 127, half = tid >> 7; float o = 0.f; const int j0 = half * 128, j1 = min(nsel, j0 + 128);
        for (int j = j0; j < j1; ++j) o += p[j] * bf2f(VA[(size_t)(b * SEQ + sel[j]) * 512 + h * 128 + d]);
        osum[tid] = o; __syncthreads();
        if (tid < 128) QA[h * 128 + tid] = (bf16_t)f2bf((osum[tid] + osum[tid + 128]) / sum);
        __syncthreads();
    }
}

__device__ __forceinline__ float softplus2(float z) { return fmaxf(z, 0.f) + log2f(1.f + exp2f(-fabsf(z))); }
__global__ __launch_bounds__(256) void k_sb_naive(char* ws) {
    __shared__ float q[128]; __shared__ float av[SEQ + 256]; __shared__ float csum[256]; __shared__ float osum[256];
    const int m = blockIdx.x >> 2, h = blockIdx.x & 3, b = m >> 13, t = m & (SEQ - 1), tid = threadIdx.x;
    bf16_t* SQ = (bf16_t*)(ws + WS_SQ) + (size_t)m * 512 + h * 128; const bf16_t* SK = (const bf16_t*)(ws + WS_SK); const bf16_t* SV = (const bf16_t*)(ws + WS_SV);
    if (tid < 128) q[tid] = bf2f(SQ[tid]);
    __syncthreads();
    for (int s = tid; s < t; s += 256) { const bf16x8* kp = (const bf16x8*)(SK + (size_t)(b * SEQ + s) * 512 + h * 128); float a = 0.f;
#pragma unroll
        for (int cc = 0; cc < 16; ++cc) { const bf16x8 kk = kp[cc];
#pragma unroll
            for (int j = 0; j < 8; ++j) a += q[cc * 8 + j] * bfs2f(kk[j]); }
        av[s + (s >> 5)] = a; }
    __syncthreads();
    float tot = 0.f;
    for (int i = 0; i < 32; ++i) { const int s = tid * 32 + i; if (s < t) tot -= softplus2(av[s + (s >> 5)]); }
    csum[tid] = tot; __syncthreads();
    float run = 0.f; for (int j = tid + 1; j < 256; ++j) run += csum[j];
    for (int i = 31; i >= 0; --i) { const int s = tid * 32 + i; const int ix = s + (s >> 5);
        if (s < t) { const float z = av[ix]; const float sp = softplus2(z); av[ix] = exp2f(z - sp + run); run -= sp; } else if (s < SEQ) av[ix] = 0.f; }
    __syncthreads();
    const int d = tid & 127, half = tid >> 7; const int hs = (t + 1) >> 1; const int s0 = half ? hs : 0, s1 = half ? t : hs; float o = 0.f;
    for (int s = s0; s < s1; ++s) o += av[s + (s >> 5)] * bf2f(SV[(size_t)(b * SEQ + s) * 512 + h * 128 + d]);
    osum[tid] = o; __syncthreads();
    if (tid < 128) SQ[tid] = (bf16_t)f2bf(osum[tid] + osum[tid + 128]);
}

template <class Epi> static void gemm_simple(hipStream_t st, const bf16_t* A, int lda, const bf16_t* Bt, int ldb, int M, int N, int K, Epi e) {
    GemmArgs<Epi> ga{}; ga.A = A; ga.Bt = Bt; ga.lda = lda; ga.ldb = ldb; ga.K = K; ga.pad = 0; ga.epi = e;
    hipLaunchKernelGGL(k_gemm_simple<Epi>, dim3(N / 128, M / 128), dim3(256), 0, st, ga);
}
static void convert(hipStream_t st, const float* src, bf16_t* dst, int K, int Nsrc, int Ndst, int mode, int srcoff) {
    ConvJob jb{src, dst, K, Nsrc, Ndst, mode, srcoff, 0};
    hipLaunchKernelGGL(k_convert, dim3(Ndst / 64, K / 64), dim3(256), 0, st, jb);
}

extern "C" void kernel_launch(void* const* d_in, const int* in_sizes, int n_in, void* d_out, int out_size, void* d_ws, size_t ws_size, hipStream_t stream) {
    if (n_in != 23 || ws_size < WS_END || out_size != MTOK * DM) { fprintf(stderr, "kernel_launch: unexpected shapes (n_in %d, ws %zu, out %d)\n", n_in, ws_size, out_size); return; }
    char* ws = (char*)d_ws; float* xo = (float*)d_out;
    const float* x_in = (const float*)d_in[0]; const int* positions = (const int*)d_in[1];
    auto F = [&](int i) { return (const float*)d_in[i]; };
    bf16_t* WIN = (bf16_t*)(ws + WS_WIN); bf16_t* WGATE = (bf16_t*)(ws + WS_WGATE); bf16_t* WO = (bf16_t*)(ws + WS_WO); bf16_t* WM = (bf16_t*)(ws + WS_WM);
    bf16_t* WFG = (bf16_t*)(ws + WS_WFG); bf16_t* WFU = (bf16_t*)(ws + WS_WFU); bf16_t* WFD = (bf16_t*)(ws + WS_WFD);
    bf16_t* H = (bf16_t*)(ws + WS_H); bf16_t* GATES = (bf16_t*)(ws + WS_GATES); bf16_t* BR = (bf16_t*)(ws + WS_BR); bf16_t* GP = (bf16_t*)(ws + WS_GP); bf16_t* ACT = (bf16_t*)(ws + WS_ACT);
    for (int l = 0; l < DEPTH; ++l) {
        const float* w_in = F(3) + (size_t)l * DM * NIN_SRC;
        convert(stream, w_in, WIN, DM, NIN_SRC, 6144, 1, 0);
        convert(stream, w_in, WGATE, DM, NIN_SRC, 4096, 0, 5956);
        convert(stream, F(8) + (size_t)l * 512 * DM, WO + 0 * (size_t)DM * 512, 512, DM, DM, 0, 0);
        convert(stream, F(13) + (size_t)l * 512 * DM, WO + 1 * (size_t)DM * 512, 512, DM, DM, 0, 0);
        convert(stream, F(15) + (size_t)l * 512 * DM, WO + 2 * (size_t)DM * 512, 512, DM, DM, 0, 0);
        convert(stream, F(16) + (size_t)l * 512 * DM, WO + 3 * (size_t)DM * 512, 512, DM, DM, 0, 0);
        convert(stream, F(17) + (size_t)l * DM * DM, WM, DM, DM, DM, 0, 0);
        convert(stream, F(19) + (size_t)l * DM * DFF, WFG, DM, DFF, DFF, 0, 0);
        convert(stream, F(20) + (size_t)l * DM * DFF, WFU, DM, DFF, DFF, 0, 0);
        convert(stream, F(22) + (size_t)l * DFF * DM, WFD, DFF, DM, DM, 0, 0);
        hipLaunchKernelGGL(k_rmsnorm, dim3(MTOK / 4), dim3(256), 0, stream, l == 0 ? x_in : (const float*)xo, l == 0 ? xo : (float*)nullptr, F(2) + (size_t)l * DM, H);
        EpiSplit es; es.ws = ws; { const size_t go[12] = {WS_QA, WS_KA, WS_VA, WS_IDX, WS_GLUA, WS_GLUB, WS_GB, WS_GC, WS_XC, WS_SQ, WS_SK, WS_SV}; for (int i = 0; i < 12; ++i) es.goff[i] = go[i]; }
        gemm_simple(stream, H, DM, WIN, DM, MTOK, 6144, DM, es);
        hipLaunchKernelGGL(k_prepass, dim3(MTOK), dim3(256), 0, stream, ws, positions, F(5) + l * 128, F(6) + l * 128, F(7) + l * 64);
        hipLaunchKernelGGL(k_conv, dim3(MTOK / 4), dim3(256), 0, stream, ws, F(9) + (size_t)l * 31 * 512, F(10) + l * 512, F(11) + l * 512, F(12) + l * 512, F(14) + (size_t)l * 3 * 512);
        hipLaunchKernelGGL(k_topk_naive, dim3(MTOK), dim3(256), 0, stream, (const char*)ws, (unsigned*)(ws + WS_MASK));
        hipLaunchKernelGGL(k_attnA_naive, dim3(MTOK), dim3(256), 0, stream, ws);
        hipLaunchKernelGGL(k_sb_naive, dim3(MTOK * 4), dim3(256), 0, stream, ws);
        gemm_simple(stream, H, DM, WGATE, DM, MTOK, 4096, DM, EpiGates{GATES, F(4) + (size_t)l * 4096});
        for (int br = 0; br < 4; ++br) gemm_simple(stream, BR + (size_t)br * MTOK * 512, 512, WO + (size_t)br * DM * 512, 512, MTOK, DM, 512, EpiOut{GATES, H, br, 0});
        gemm_simple(stream, H, DM, WM, DM, MTOK, DM, DM, EpiResid{xo});
        hipLaunchKernelGGL(k_rmsnorm, dim3(MTOK / 4), dim3(256), 0, stream, (const float*)xo, (float*)nullptr, F(18) + (size_t)l * DM, H);
        gemm_simple(stream, H, DM, WFG, DM, MTOK, DFF, DM, EpiStore{GP, DFF, 0});
        gemm_simple(stream, H, DM, WFU, DM, MTOK, DFF, DM, EpiFfnAct{GP, F(21) + (size_t)l * 3 * DFF, ACT});
        gemm_simple(stream, ACT, DFF, WFD, DFF, MTOK, DM, DFF, EpiResid{xo});
    }
}
```

```cpp
#include <hip/hip_runtime.h>
#include <hip/hip_cooperative_groups.h>
#include <cstdint>
#include <cstdio>
#include <cmath>

namespace cg = cooperative_groups;
typedef unsigned short bf16_t;
typedef short bf16x8 __attribute__((ext_vector_type(8)));
typedef float f32x4 __attribute__((ext_vector_type(4)));
typedef unsigned u32x4 __attribute__((ext_vector_type(4)));
typedef unsigned u32x2 __attribute__((ext_vector_type(2)));

#ifndef NAIVE_TOPK
#define NAIVE_TOPK 0
#endif
#ifndef NAIVE_A
#define NAIVE_A 0
#endif
#ifndef NAIVE_D
#define NAIVE_D 0
#endif
constexpr int SEQ = 8192, DM = 1024, MTOK = 2 * SEQ, DEPTH = 2, NIN_SRC = 10052, DFF = 2816;
constexpr float EPS = 1e-6f;
constexpr float QSCALE = 0.08838834764831845f * 1.4426950408889634f;

constexpr size_t MiB = 1u << 20;
constexpr size_t WS_WIN = 1 * MiB, WS_WGATE = 13 * MiB, WS_WO = 21 * MiB, WS_WM = 25 * MiB, WS_WFG = 27 * MiB, WS_WFU = WS_WFG + 5767168, WS_WFD = WS_WFU + 5767168;
constexpr size_t WS_H = 44 * MiB;
constexpr size_t WS_QA = 76 * MiB, WS_GLUB = 92 * MiB, WS_XC = 108 * MiB, WS_SQ = 124 * MiB;
constexpr size_t WS_KA = 140 * MiB, WS_VA = 156 * MiB, WS_IDX = 172 * MiB, WS_GLUA = 188 * MiB, WS_GB = 204 * MiB, WS_GC = 220 * MiB, WS_SK = 236 * MiB, WS_SV = 252 * MiB;
constexpr size_t WS_MASK = 268 * MiB, WS_END = 284 * MiB;
constexpr size_t WS_GATES = 140 * MiB;
constexpr size_t WS_GP = 76 * MiB, WS_ACT = 164 * MiB;
constexpr size_t WS_BR = WS_QA;

__host__ __device__ __forceinline__ size_t vt_index(int m, int h, int d) { return ((size_t)((m >> 6) * 4 + h) * 128 + d) * 64 + (m & 63); }
__device__ __forceinline__ float bf2f(bf16_t b) { return __uint_as_float((unsigned)b << 16); }
__device__ __forceinline__ float bfs2f(short b) { return __uint_as_float(((unsigned)(unsigned short)b) << 16); }
__device__ __forceinline__ unsigned f2bf(float f) { unsigned u = __float_as_uint(f); return (u + 0x7fffu + ((u >> 16) & 1u)) >> 16; }
__device__ __forceinline__ unsigned pk2(float lo, float hi) { return f2bf(lo) | (f2bf(hi) << 16); }
__device__ __forceinline__ float wave_sum(float v) {
#pragma unroll
    for (int o = 32; o > 0; o >>= 1) v += __shfl_xor(v, o);
    return v;
}
__device__ __forceinline__ float wave_max(float v) {
#pragma unroll
    for (int o = 32; o > 0; o >>= 1) v = fmaxf(v, __shfl_xor(v, o));
    return v;
}
__device__ __forceinline__ unsigned wave_sum_u(unsigned v) {
#pragma unroll
    for (int o = 32; o > 0; o >>= 1) v += __shfl_xor(v, o);
    return v;
}
__device__ __forceinline__ float sigmoidf_(float x) { return 1.f / (1.f + expf(-x)); }

struct ConvJob { const float* src; bf16_t* dst; int K, Nsrc, Ndst, mode, srcoff, pad; };
__host__ __device__ __forceinline__ int win_srccol(int n) { int g = n >> 9, j = n & 511; if (g < 3) return n; if (g == 3) return j < 324 ? 1536 + j : -1; return 1860 + (g - 4) * 512 + j; }
__global__ __launch_bounds__(256) void k_convert(ConvJob jb) {
    __shared__ float tile[64][65];
    const int n0 = blockIdx.x * 64, k0 = blockIdx.y * 64, tx = threadIdx.x & 63, ty = threadIdx.x >> 6;
    const int n = n0 + tx; const int sc = (jb.mode == 1) ? win_srccol(n) : jb.srcoff + n;
    for (int i = ty; i < 64; i += 4) { float v = 0.f; if (sc >= 0) v = jb.src[(size_t)(k0 + i) * jb.Nsrc + sc]; tile[i][tx] = v; }
    __syncthreads();
    for (int c = threadIdx.x; c < 512; c += 256) {
        const int nn = c >> 3, ch = c & 7; u32x4 w;
        w.x = pk2(tile[ch * 8 + 0][nn], tile[ch * 8 + 1][nn]); w.y = pk2(tile[ch * 8 + 2][nn], tile[ch * 8 + 3][nn]);
        w.z = pk2(tile[ch * 8 + 4][nn], tile[ch * 8 + 5][nn]); w.w = pk2(tile[ch * 8 + 6][nn], tile[ch * 8 + 7][nn]);
        *(u32x4*)(jb.dst + (size_t)(n0 + nn) * jb.K + k0 + ch * 8) = w;
    }
}

__global__ __launch_bounds__(256) void k_rmsnorm(const float* x, float* xcopy, const float* g, bf16_t* out) {
    const int wave = threadIdx.x >> 6, lane = threadIdx.x & 63; const int m = blockIdx.x * 4 + wave;
    const f32x4* xr = (const f32x4*)(x + (size_t)m * DM) + lane; f32x4 v[4]; float s = 0.f;
#pragma unroll
    for (int j = 0; j < 4; ++j) { v[j] = xr[64 * j]; s += (v[j].x * v[j].x + v[j].y * v[j].y) + (v[j].z * v[j].z + v[j].w * v[j].w); }
    s = wave_sum(s); const float r = rsqrtf(s * (1.f / DM) + EPS);
    if (xcopy) {
#pragma unroll
        for (int j = 0; j < 4; ++j) ((f32x4*)(xcopy + (size_t)m * DM) + lane)[64 * j] = v[j];
    }
#pragma unroll
    for (int j = 0; j < 4; ++j) { const f32x4 gg = ((const f32x4*)g + lane)[64 * j]; u32x2 w; w.x = pk2(v[j].x * r * gg.x, v[j].y * r * gg.y); w.y = pk2(v[j].z * r * gg.z, v[j].w * r * gg.w);
        *(u32x2*)(out + (size_t)m * DM + (64 * j + lane) * 4) = w; }
}

__device__ __forceinline__ void store4bf(bf16_t* p, f32x4 v) { u32x2 w; w.x = pk2(v.x, v.y); w.y = pk2(v.z, v.w); *(u32x2*)p = w; }
__device__ __forceinline__ f32x4 load4bf(const bf16_t* p) { const u32x2 w = *(const u32x2*)p; f32x4 r; r.x = __uint_as_float(w.x << 16); r.y = __uint_as_float(w.x & 0xffff0000u); r.z = __uint_as_float(w.y << 16); r.w = __uint_as_float(w.y & 0xffff0000u); return r; }
__host__ __device__ __forceinline__ size_t goff_of(int g) {
    switch (g) { case 0: return WS_QA; case 1: return WS_KA; case 2: return WS_VA; case 3: return WS_IDX; case 4: return WS_GLUA; case 5: return WS_GLUB;
                 case 6: return WS_GB; case 7: return WS_GC; case 8: return WS_XC; case 9: return WS_SQ; case 10: return WS_SK; default: return WS_SV; } }
struct EpiSplit { char* ws;
    __device__ __forceinline__ void operator()(int row, int col, f32x4 v, int aux) const { store4bf((bf16_t*)(ws + goff_of(col >> 9)) + (size_t)row * 512 + (col & 511), v); } };
struct EpiGates { bf16_t* G; const float* bias;
    __device__ __forceinline__ void operator()(int row, int col, f32x4 v, int aux) const { const f32x4 b = *(const f32x4*)(bias + col); f32x4 o; o.x = sigmoidf_(v.x + b.x); o.y = sigmoidf_(v.y + b.y); o.z = sigmoidf_(v.z + b.z); o.w = sigmoidf_(v.w + b.w);
        store4bf(G + (size_t)row * 4096 + col, o); } };
struct EpiOut { const bf16_t* G; bf16_t* Mg;
    __device__ __forceinline__ void operator()(int row, int col, f32x4 v, int aux) const { const int br = aux; const f32x4 g = load4bf(G + (size_t)row * 4096 + br * 1024 + col); f32x4 p = (f32x4){0.f, 0.f, 0.f, 0.f};
        if (br) p = load4bf(Mg + (size_t)row * DM + col); store4bf(Mg + (size_t)row * DM + col, p + g * v); } };
struct EpiResid { float* x;
    __device__ __forceinline__ void operator()(int row, int col, f32x4 v, int aux) const { f32x4* p = (f32x4*)(x + (size_t)row * DM + col); *p = *p + v; } };
struct EpiStore { bf16_t* O; int ldc, pad;
    __device__ __forceinline__ void operator()(int row, int col, f32x4 v, int aux) const { store4bf(O + (size_t)row * ldc + col, v); } };
struct EpiFfnAct { const bf16_t* GP; const float* cw; bf16_t* ACT;
    __device__ __forceinline__ void operator()(int row, int col, f32x4 v, int aux) const {
        const int t = row & (SEQ - 1); const f32x4 z = (f32x4){0.f, 0.f, 0.f, 0.f};
        const f32x4 g2 = load4bf(GP + (size_t)row * DFF + col), g1 = t >= 1 ? load4bf(GP + (size_t)(row - 1) * DFF + col) : z, g0 = t >= 2 ? load4bf(GP + (size_t)(row - 2) * DFF + col) : z;
        const f32x4 w0 = *(const f32x4*)(cw + col), w1 = *(const f32x4*)(cw + DFF + col), w2 = *(const f32x4*)(cw + 2 * DFF + col);
        const f32x4 gt = w0 * g0 + w1 * g1 + w2 * g2; f32x4 o;
        o.x = gt.x * sigmoidf_(gt.x) * v.x; o.y = gt.y * sigmoidf_(gt.y) * v.y; o.z = gt.z * sigmoidf_(gt.z) * v.z; o.w = gt.w * sigmoidf_(gt.w) * v.w;
        store4bf(ACT + (size_t)row * DFF + col, o); } };

template <class Epi> struct GemmArgs { const bf16_t* A; const bf16_t* Bt; int lda, ldb, K, aux; Epi epi; };
template <class Epi>
__global__ __launch_bounds__(256) void k_gemm_simple(GemmArgs<Epi> ga) {
    const bf16_t* A = ga.A; const bf16_t* Bt = ga.Bt; const int lda = ga.lda, ldb = ga.ldb, K = ga.K; const Epi& epi = ga.epi;
    const int lane = threadIdx.x & 63, w = threadIdx.x >> 6, fr = lane & 15, fq = lane >> 4;
    const int row0 = blockIdx.y * 128 + (w >> 1) * 64, col0 = blockIdx.x * 128 + (w & 1) * 64;
    f32x4 acc[4][4];
#pragma unroll
    for (int i = 0; i < 4; ++i)
#pragma unroll
        for (int j = 0; j < 4; ++j) acc[i][j] = (f32x4){0.f, 0.f, 0.f, 0.f};
    const bf16_t* ap = A + (size_t)(row0 + fr) * lda + fq * 8; const bf16_t* bp = Bt + (size_t)(col0 + fr) * ldb + fq * 8;
    for (int k0 = 0; k0 < K; k0 += 32) {
        bf16x8 a[4], b[4];
#pragma unroll
        for (int i = 0; i < 4; ++i) { a[i] = *(const bf16x8*)(ap + (size_t)(i * 16) * lda + k0); b[i] = *(const bf16x8*)(bp + (size_t)(i * 16) * ldb + k0); }
#pragma unroll
        for (int i = 0; i < 4; ++i)
#pragma unroll
            for (int j = 0; j < 4; ++j) acc[i][j] = __builtin_amdgcn_mfma_f32_16x16x32_bf16(b[j], a[i], acc[i][j], 0, 0, 0);
    }
#pragma unroll
    for (int i = 0; i < 4; ++i)
#pragma unroll
        for (int j = 0; j < 4; ++j) epi(row0 + i * 16 + fr, col0 + j * 16 + fq * 4, acc[i][j], ga.aux);
}

__global__ __launch_bounds__(256) void k_prepass(char* ws, const int* positions, const float* g_qa, const float* g_ka, const float* g_kidx) {
    const int m = blockIdx.x, tid = threadIdx.x, w = tid >> 6, lane = tid & 63;
    const float pos = (float)positions[m];
#pragma unroll
    for (int which = 0; which < 2; ++which) {
        bf16_t* p = (bf16_t*)(ws + (which ? WS_KA : WS_QA)) + (size_t)m * 512 + w * 128; const float* g = which ? g_ka : g_qa;
        const float v0 = bf2f(p[lane]), v1 = bf2f(p[lane + 64]);
        const float ss = wave_sum(v0 * v0 + v1 * v1); const float r = rsqrtf(ss * (1.f / 128.f) + EPS);
        float y0 = v0 * r * g[lane]; const float y1 = v1 * r * g[lane + 64];
        const float part = __shfl_xor(y0, 16);
        if (lane < 32) { const int i = lane & 15; const float inv = powf(500000.f, -((float)i * 2.0f) / 32.f); const float ang = pos * inv; const float c = cosf(ang), s = sinf(ang);
            y0 = (lane < 16) ? y0 * c - part * s : y0 * c + part * s; }
        const float sc = which ? 1.f : QSCALE;
        p[lane] = (bf16_t)f2bf(y0 * sc); p[lane + 64] = (bf16_t)f2bf(y1 * sc);
    }
    bf16_t* ix = (bf16_t*)(ws + WS_IDX) + (size_t)m * 512;
    const float wv = bf2f(ix[320 + w]);
    {
        float y = bf2f(ix[w * 64 + lane]); const float part = __shfl_xor(y, 8);
        if (lane < 16) { const int i = lane & 7; const float inv = powf(500000.f, -((float)i * 2.0f) / 16.f); const float ang = pos * inv; const float c = cosf(ang), s = sinf(ang);
            y = (lane < 8) ? y * c - part * s : y * c + part * s; }
        ix[w * 64 + lane] = (bf16_t)f2bf(y * wv * 0.0625f);
    }
    if (w == 0) {
        const float v = bf2f(ix[256 + lane]); const float ss = wave_sum(v * v); const float r = rsqrtf(ss * (1.f / 64.f) + EPS);
        float y = v * r * g_kidx[lane]; const float part = __shfl_xor(y, 8);
        if (lane < 16) { const int i = lane & 7; const float inv = powf(500000.f, -((float)i * 2.0f) / 16.f); const float ang = pos * inv; const float c = cosf(ang), s = sinf(ang);
            y = (lane < 8) ? y * c - part * s : y * c + part * s; }
        ix[256 + lane] = (bf16_t)f2bf(y);
    }
    bf16_t* ga = (bf16_t*)(ws + WS_GLUA) + (size_t)m * 512; const bf16_t* gb = (const bf16_t*)(ws + WS_GLUB) + (size_t)m * 512;
    bf16_t* gc = (bf16_t*)(ws + WS_GC) + (size_t)m * 512; const bf16_t* xc = (const bf16_t*)(ws + WS_XC) + (size_t)m * 512;
    bf16_t* sq = (bf16_t*)(ws + WS_SQ) + (size_t)m * 512;
#pragma unroll
    for (int e = 0; e < 2; ++e) { const int c = tid + e * 256;
        ga[c] = (bf16_t)f2bf(bf2f(ga[c]) * sigmoidf_(bf2f(gb[c])));
        gc[c] = (bf16_t)f2bf(bf2f(gc[c]) * bf2f(xc[c]));
        sq[c] = (bf16_t)f2bf(bf2f(sq[c]) * QSCALE); }
}

__global__ __launch_bounds__(256) void k_conv(char* ws, const float* cbw, const float* cbb, const float* lng, const float* lnb, const float* ccw) {
    const int wave = threadIdx.x >> 6, lane = threadIdx.x & 63; const int m = blockIdx.x * 4 + wave; const int t = m & (SEQ - 1); const int c0 = lane * 8;
    {
        const bf16_t* U = (const bf16_t*)(ws + WS_GLUA); float acc[8];
#pragma unroll
        for (int j = 0; j < 8; ++j) acc[j] = cbb[c0 + j];
        for (int k = 0; k < 31; ++k) { const int tt = t - 30 + k; if (tt < 0) continue;
            const bf16x8 u = *(const bf16x8*)(U + (size_t)(m - 30 + k) * 512 + c0);
#pragma unroll
            for (int j = 0; j < 8; ++j) acc[j] += cbw[k * 512 + c0 + j] * bfs2f(u[j]); }
        float s = 0.f;
#pragma unroll
        for (int j = 0; j < 8; ++j) s += acc[j];
        const float mean = wave_sum(s) * (1.f / 512.f); float q = 0.f;
#pragma unroll
        for (int j = 0; j < 8; ++j) { acc[j] -= mean; q += acc[j] * acc[j]; }
        const float r = rsqrtf(wave_sum(q) * (1.f / 512.f) + EPS); float o[8];
#pragma unroll
        for (int j = 0; j < 8; ++j) { const float y = acc[j] * r * lng[c0 + j] + lnb[c0 + j]; o[j] = y * sigmoidf_(y); }
        u32x4 wv; wv.x = pk2(o[0], o[1]); wv.y = pk2(o[2], o[3]); wv.z = pk2(o[4], o[5]); wv.w = pk2(o[6], o[7]);
        *(u32x4*)((bf16_t*)(ws + WS_GLUB) + (size_t)m * 512 + c0) = wv;
    }
    {
        const bf16_t* X = (const bf16_t*)(ws + WS_GC); float acc[8];
#pragma unroll
        for (int j = 0; j < 8; ++j) acc[j] = 0.f;
        for (int k = 0; k < 3; ++k) { const int tt = t - 2 + k; if (tt < 0) continue;
            const bf16x8 u = *(const bf16x8*)(X + (size_t)(m - 2 + k) * 512 + c0);
#pragma unroll
            for (int j = 0; j < 8; ++j) acc[j] += ccw[k * 512 + c0 + j] * bfs2f(u[j]); }
        const bf16x8 g = *(const bf16x8*)((const bf16_t*)(ws + WS_GB) + (size_t)m * 512 + c0); float o[8];
#pragma unroll
        for (int j = 0; j < 8; ++j) o[j] = acc[j] * bfs2f(g[j]);
        u32x4 wv; wv.x = pk2(o[0], o[1]); wv.y = pk2(o[2], o[3]); wv.z = pk2(o[4], o[5]); wv.w = pk2(o[6], o[7]);
        *(u32x4*)((bf16_t*)(ws + WS_XC) + (size_t)m * 512 + c0) = wv;
    }
}

__device__ __forceinline__ unsigned sortkey(float f) { const unsigned u = __float_as_uint(f); return (u & 0x80000000u) ? ~u : (u | 0x80000000u); }
__global__ __launch_bounds__(256) void k_topk_naive(const char* ws, unsigned* MASK) {
    __shared__ unsigned sc[SEQ]; __shared__ float qf[256]; __shared__ unsigned maskw[256]; __shared__ float wsg[4]; __shared__ unsigned cnt_s;
    const int m = blockIdx.x, b = m >> 13, t = m & (SEQ - 1), tid = threadIdx.x, lane = tid & 63;
    const bf16_t* IX = (const bf16_t*)(ws + WS_IDX);
    qf[tid] = bf2f(IX[(size_t)m * 512 + tid]); maskw[tid] = 0u; if (tid < 4) wsg[tid] = bf2f(IX[(size_t)m * 512 + 320 + tid]);
    __syncthreads();
    const int n = t + 1;
    for (int s = tid; s < n; s += 256) {
        const bf16x8* kp = (const bf16x8*)(IX + (size_t)(b * SEQ + s) * 512 + 256); float x0 = 0.f, x1 = 0.f, x2 = 0.f, x3 = 0.f;
#pragma unroll
        for (int c = 0; c < 8; ++c) { const bf16x8 kk = kp[c];
#pragma unroll
            for (int j = 0; j < 8; ++j) { const float kv = bfs2f(kk[j]); const int d = c * 8 + j; x0 += qf[d] * kv; x1 += qf[64 + d] * kv; x2 += qf[128 + d] * kv; x3 += qf[192 + d] * kv; } }
        float score = (wsg[0] >= 0.f ? fmaxf(x0, 0.f) : fminf(x0, 0.f));
        score += (wsg[1] >= 0.f ? fmaxf(x1, 0.f) : fminf(x1, 0.f));
        score += (wsg[2] >= 0.f ? fmaxf(x2, 0.f) : fminf(x2, 0.f));
        score += (wsg[3] >= 0.f ? fmaxf(x3, 0.f) : fminf(x3, 0.f));
        sc[s] = sortkey(score);
    }
    __syncthreads();
    if (n <= 256) { if (tid < n) atomicOr(&maskw[tid >> 5], 1u << (tid & 31)); }
    else {
        unsigned T = 0u;
        for (int bit = 31; bit >= 0; --bit) {
            const unsigned cand = T | (1u << bit);
            if (tid == 0) cnt_s = 0u;
            __syncthreads();
            unsigned c = 0u; for (int s = tid; s < n; s += 256) c += (sc[s] >= cand) ? 1u : 0u;
            c = wave_sum_u(c); if (lane == 0) atomicAdd(&cnt_s, c);
            __syncthreads();
            if (cnt_s >= 256u) T = cand;
            __syncthreads();
        }
        if (tid == 0) cnt_s = 0u;
        __syncthreads();
        { unsigned c = 0u; for (int s = tid; s < n; s += 256) c += (sc[s] > T) ? 1u : 0u; c = wave_sum_u(c); if (lane == 0) atomicAdd(&cnt_s, c); }
        __syncthreads();
        const int need = 256 - (int)cnt_s;
        for (int s = tid; s < n; s += 256) if (sc[s] > T) atomicOr(&maskw[s >> 5], 1u << (s & 31));
        if (tid < 64) { int taken = 0;
            for (int base = 0; base < n && taken < need; base += 64) { const int s = base + lane; const bool tie = (s < n) && (sc[s] == T);
                const unsigned long long bal = __ballot(tie); const int pre = __popcll(bal & ((1ull << lane) - 1ull));
                if (tie && taken + pre < need) atomicOr(&maskw[s >> 5], 1u << (s & 31));
                taken += __popcll(bal); } }
    }
    __syncthreads();
    MASK[(size_t)m * 256 + tid] = maskw[tid];
}

__device__ __forceinline__ float block_max256(float v, float* red) { v = wave_max(v); __syncthreads(); if ((threadIdx.x & 63) == 0) red[threadIdx.x >> 6] = v; __syncthreads(); return fmaxf(fmaxf(red[0], red[1]), fmaxf(red[2], red[3])); }
__device__ __forceinline__ float block_sum256(float v, float* red) { v = wave_sum(v); __syncthreads(); if ((threadIdx.x & 63) == 0) red[threadIdx.x >> 6] = v; __syncthreads(); return (red[0] + red[1]) + (red[2] + red[3]); }

__global__ __launch_bounds__(256) void k_attnA_naive(char* ws, bf16_t* outbase) {
    __shared__ int sel[256]; __shared__ float q[512]; __shared__ float p[256]; __shared__ float red[4]; __shared__ int pre[256]; __shared__ float osum[256];
    const int m = blockIdx.x, b = m >> 13, tid = threadIdx.x;
    const unsigned* MW = (const unsigned*)(ws + WS_MASK) + (size_t)m * 256; bf16_t* QA = (bf16_t*)(ws + WS_QA) + (size_t)m * 512;
    const bf16_t* KA = (const bf16_t*)(ws + WS_KA); const bf16_t* VA = (const bf16_t*)(ws + WS_VA);
    q[tid] = bf2f(QA[tid]); q[tid + 256] = bf2f(QA[tid + 256]);
    unsigned w = (tid <= ((m & (SEQ - 1)) >> 5)) ? MW[tid] : 0u; const int c = __popc(w); pre[tid] = c; sel[tid] = 0;
    __syncthreads();
    for (int o = 1; o < 256; o <<= 1) { const int v = tid >= o ? pre[tid - o] : 0; __syncthreads(); pre[tid] += v; __syncthreads(); }
    int off = pre[tid] - c; int nsel = pre[255]; if (nsel > 256) nsel = 256;
    while (w) { const int bit = __ffs(w) - 1; w &= w - 1u; if (off < 256) sel[off] = tid * 32 + bit; ++off; }
    __syncthreads();
    for (int h = 0; h < 4; ++h) {
        float l = -INFINITY;
        if (tid < nsel) { const bf16x8* kp = (const bf16x8*)(KA + (size_t)(b * SEQ + sel[tid]) * 512 + h * 128); float a = 0.f;
#pragma unroll
            for (int cc = 0; cc < 16; ++cc) { const bf16x8 kk = kp[cc];
#pragma unroll
                for (int j = 0; j < 8; ++j) a += q[h * 128 + cc * 8 + j] * bfs2f(kk[j]); }
            l = a; }
        const float mx = block_max256(l, red); const float e = tid < nsel ? exp2f(l - mx) : 0.f; const float sum = block_sum256(e, red);
        p[tid] = e; __syncthreads();
        const int d = tid & 127, half = tid >> 7; float o = 0.f; const int j0 = half * 128, j1 = min(nsel, j0 + 128);
        for (int j = j0; j < j1; ++j) o += p[j] * bf2f(VA[vt_index(b * SEQ + sel[j], h, d)]);
        osum[tid] = o; __syncthreads();
        if (tid < 128) outbase[(size_t)m * 512 + h * 128 + tid] = (bf16_t)f2bf((osum[tid] + osum[tid + 128]) / sum);
        __syncthreads();
    }
}

__device__ __forceinline__ float softplus2(float z) { return fmaxf(z, 0.f) + log2f(1.f + exp2f(-fabsf(z))); }
__global__ __launch_bounds__(256) void k_sb_naive(char* ws) {
    __shared__ float q[128]; __shared__ float av[SEQ + 256]; __shared__ float csum[256]; __shared__ float osum[256];
    const int m = blockIdx.x >> 2, h = blockIdx.x & 3, b = m >> 13, t = m & (SEQ - 1), tid = threadIdx.x;
    bf16_t* SQ = (bf16_t*)(ws + WS_SQ) + (size_t)m * 512 + h * 128; const bf16_t* SK = (const bf16_t*)(ws + WS_SK); const bf16_t* SV = (const bf16_t*)(ws + WS_SV);
    if (tid < 128) q[tid] = bf2f(SQ[tid]);
    __syncthreads();
    for (int s = tid; s < t; s += 256) { const bf16x8* kp = (const bf16x8*)(SK + (size_t)(b * SEQ + s) * 512 + h * 128); float a = 0.f;
#pragma unroll
        for (int cc = 0; cc < 16; ++cc) { const bf16x8 kk = kp[cc];
#pragma unroll
            for (int j = 0; j < 8; ++j) a += q[cc * 8 + j] * bfs2f(kk[j]); }
        av[s + (s >> 5)] = a; }
    __syncthreads();
    float tot = 0.f;
    for (int i = 0; i < 32; ++i) { const int s = tid * 32 + i; if (s < t) tot -= softplus2(av[s + (s >> 5)]); }
    csum[tid] = tot; __syncthreads();
    float run = 0.f; for (int j = tid + 1; j < 256; ++j) run += csum[j];
    for (int i = 31; i >= 0; --i) { const int s = tid * 32 + i; const int ix = s + (s >> 5);
        if (s < t) { const float z = av[ix]; const float sp = softplus2(z); av[ix] = exp2f(z - sp + run); run -= sp; } else if (s < SEQ) av[ix] = 0.f; }
    __syncthreads();
    const int d = tid & 127, half = tid >> 7; const int hs = (t + 1) >> 1; const int s0 = half ? hs : 0, s1 = half ? t : hs; float o = 0.f;
    for (int s = s0; s < s1; ++s) o += av[s + (s >> 5)] * bf2f(SV[vt_index(b * SEQ + s, h, d)]);
    osum[tid] = o; __syncthreads();
    if (tid < 128) SQ[tid] = (bf16_t)f2bf(osum[tid] + osum[tid + 128]);
}

namespace pg8 {
#define PG8_LAS __attribute__((address_space(3)))
typedef unsigned short bf16_t;
typedef short bf16x8 __attribute__((ext_vector_type(8)));
typedef float f32x4 __attribute__((ext_vector_type(4)));
typedef unsigned u32x4 __attribute__((ext_vector_type(4)));
constexpr int BM = 256, BK = 64, HALF = 128, HTB = HALF * BK * 2  , STAGE_BYTES = 8 * HTB, NXCD = 8, WGM = 8;

__host__ __device__ __forceinline__ int lds_byte(int r, int c) { const int st = (r >> 4) * 2 + (c >> 5), rr = r & 15, cc = c & 31, ob = rr * 64 + cc * 2; return st * 1024 + (ob ^ (((ob >> 9) & 1) << 5)); }
__host__ __device__ __forceinline__ void stage_rc(int b, int& R, int& C) { const int st = b / 1024, sb = b % 1024, swz = sb ^ (((sb >> 9) & 1) << 5); R = (st >> 1) * 16 + swz / 64; C = (st & 1) * 32 + (swz % 64) / 2; }
__host__ __device__ __forceinline__ int perm32(int rho) { const int n = rho >> 4, i = rho & 15; return 8 * (i >> 2) + 4 * n + (i & 3); }

struct Unit { int pm, pn; };
struct Gemm { const bf16_t* A; const bf16_t* Bt; int M, N, K; };

struct StaticOrder {
    int nM, nN, nwg, G, c;
    __host__ __device__ void init(int M, int N, int G_, int c_) { nM = M / BM; nN = N / BM; nwg = nM * nN; G = G_; c = c_; }
    __host__ __device__ bool next(int i, Unit& u) const {
        const long L = (long)i * G + c; if (L >= nwg) return false;
        int wgid = (int)L; { const int q = nwg / NXCD, r = nwg % NXCD, xcd = wgid % NXCD, off = wgid / NXCD; wgid = (xcd < r ? xcd * (q + 1) : r * (q + 1) + (xcd - r) * q) + off; }
        const int nig = WGM * nN, gid = wgid / nig, fm = gid * WGM, gsz = (nM - fm) < WGM ? (nM - fm) : WGM;
        u.pm = fm + ((wgid % nig) % gsz); u.pn = (wgid % nig) / gsz; return true;
    }
    __device__ __forceinline__ void a_ready(const Unit&) const {}
    __device__ __forceinline__ void done(const Unit&) const {}
};


template <class F, bool BRANCHED> struct EpiFn {
    static constexpr bool PERM = false, AFTER_DRAIN = false;
    F f;
    __device__ __forceinline__ void operator()(const f32x4 (&acc)[2][2][4][2], const Unit& u, int wr, int wc, int fr, int fq) const {
        int pm = u.pm, pn = u.pn, aux = 0;
        if (BRANCHED) { aux = u.pn >> 2; pn = u.pn & 3; pm = u.pm & 63; }
        const int row0 = pm * BM + wr * 64 + fr, col0 = pn * BM + wc * 32 + 4 * fq;
#pragma unroll
        for (int ai = 0; ai < 2; ++ai)
#pragma unroll
            for (int m = 0; m < 4; ++m)
#pragma unroll
                for (int bj = 0; bj < 2; ++bj)
#pragma unroll
                    for (int n = 0; n < 2; ++n) f(row0 + ai * HALF + m * 16, col0 + bj * HALF + n * 16, acc[ai][bj][m][n], aux);
    }
};
struct BranchOrder {
    StaticOrder S;
    __device__ void init(int G_, int c_) { S.init(16384, 1024, G_, c_); }
    __device__ bool next(int i, Unit& u) const { Unit t; if (!S.next(i >> 2, t)) return false; const int br = i & 3; u.pm = br * 64 + t.pm; u.pn = br * 4 + t.pn; return true; }
    __device__ __forceinline__ void a_ready(const Unit&) const {}
    __device__ __forceinline__ void done(const Unit&) const {}
};

template <class Epi, class Sched, bool ALIGN_EPI = false, bool SP2 = false>
__device__ __forceinline__ void gemm_phase(PG8_LAS unsigned char* lds, const Gemm g, const Sched& S, const Epi& E) {
    const int tid = threadIdx.x, wid = __builtin_amdgcn_readfirstlane(tid >> 6), lane = tid & 63, wr = wid >> 2, wc = wid & 3, fr = lane & 15, fq = lane >> 4;
    const int K = g.K, nt = K / BK;
    unsigned voffA[2], voffB[2];
#pragma unroll
    for (int i = 0; i < 2; ++i) { int R, C; stage_rc(tid * 16 + i * 8192, R, C); const int Rb = Epi::PERM ? ((R & ~31) + perm32(R & 31)) : R;
        voffA[i] = (unsigned)(R * K + C) * 2u; voffB[i] = (unsigned)(Rb * K + C) * 2u; }
    const size_t kstep = (size_t)(BK * 2);
    const size_t hstep = (size_t)HALF * K * 2;
    const size_t tstep = 2 * hstep;
    const unsigned ldsw = (unsigned)wid * 1024u;
    const int aoff = lds_byte(wr * 64 + fr, fq * 8), boff = lds_byte(wc * 32 + fr, fq * 8);
#define PG8_SA(b, h) (((b) * 2 + (h)) * HTB)
#define PG8_SB(b, h) ((4 + (b) * 2 + (h)) * HTB)
#define PG8_STAGE(bufoff, gbase, voff) do { _Pragma("unroll") for (int _i = 0; _i < 2; ++_i) \
        __builtin_amdgcn_global_load_lds((const unsigned*)((const char*)(gbase) + (voff)[_i]), (PG8_LAS unsigned*)(lds + (bufoff) + ldsw + _i * 8192), 16, 0, 0); } while (0)
#define PG8_LDA(dst, b, h) do { _Pragma("unroll") for (int m = 0; m < 4; ++m) _Pragma("unroll") for (int k = 0; k < 2; ++k) dst[m][k] = *(const PG8_LAS bf16x8*)(lds + PG8_SA(b, h) + aoff + m * 2048 + k * 1024); } while (0)
#define PG8_LDB(dst, b, h) do { _Pragma("unroll") for (int n = 0; n < 2; ++n) _Pragma("unroll") for (int k = 0; k < 2; ++k) dst[n][k] = *(const PG8_LAS bf16x8*)(lds + PG8_SB(b, h) + boff + n * 2048 + k * 1024); } while (0)
#define PG8_MMA(ai, bj, At, Bt) do { __builtin_amdgcn_s_setprio(1); _Pragma("unroll") for (int m = 0; m < 4; ++m) _Pragma("unroll") for (int n = 0; n < 2; ++n) _Pragma("unroll") for (int k = 0; k < 2; ++k) \
        acc[ai][bj][m][n] = __builtin_amdgcn_mfma_f32_16x16x32_bf16(Bt[n][k], At[m][k], acc[ai][bj][m][n], 0, 0, 0); __builtin_amdgcn_s_setprio(0); } while (0)
#define PG8_WAIT_V(n) asm volatile("s_waitcnt vmcnt(" #n ")" ::: "memory")
#define PG8_WAIT_L(n) asm volatile("s_waitcnt lgkmcnt(" #n ")" ::: "memory")
#define PG8_BAR __builtin_amdgcn_s_barrier()
#define PG8_SCHED __builtin_amdgcn_sched_barrier(0)
    Unit cur, nxt; int ui = 0;
    if (!S.next(0, cur)) return;
    f32x4 acc[2][2][4][2];
#pragma unroll
    for (int a = 0; a < 2; ++a)
#pragma unroll
        for (int b = 0; b < 2; ++b)
#pragma unroll
            for (int m = 0; m < 4; ++m)
#pragma unroll
                for (int n = 0; n < 2; ++n) acc[a][b][m][n] = (f32x4){0.f, 0.f, 0.f, 0.f};
    bf16x8 At[4][2], B0[2][2], B1[2][2];
    const char* cA = (const char*)g.A + (size_t)cur.pm * tstep; const char* cB = (const char*)g.Bt + (size_t)cur.pn * tstep;
    S.a_ready(cur);
    if constexpr (SP2) {
        PG8_STAGE(PG8_SB(0, 0), cB, voffB); PG8_STAGE(PG8_SB(0, 1), cB + hstep, voffB); PG8_STAGE(PG8_SA(0, 0), cA, voffA); PG8_STAGE(PG8_SA(0, 1), cA + hstep, voffA);
        if (wr == 1) PG8_BAR;
        PG8_WAIT_V(2); PG8_BAR;
        PG8_STAGE(PG8_SB(1, 0), cB + kstep, voffB); PG8_STAGE(PG8_SA(1, 0), cA + kstep, voffA); PG8_STAGE(PG8_SB(1, 1), cB + hstep + kstep, voffB);
        PG8_WAIT_V(6); PG8_BAR;
    } else {
        PG8_STAGE(PG8_SB(0, 0), cB, voffB); PG8_STAGE(PG8_SA(0, 0), cA, voffA); PG8_STAGE(PG8_SB(0, 1), cB + hstep, voffB); PG8_STAGE(PG8_SA(0, 1), cA + hstep, voffA);
        if (wr == 1) PG8_BAR;
        PG8_WAIT_V(4); PG8_BAR;
        PG8_STAGE(PG8_SB(1, 0), cB + kstep, voffB); PG8_STAGE(PG8_SA(1, 0), cA + kstep, voffA); PG8_STAGE(PG8_SB(1, 1), cB + hstep + kstep, voffB);
        PG8_WAIT_V(6); PG8_BAR;
    }
    for (;;) {
        const bool has_next = S.next(ui + 1, nxt);
        const char* nA = has_next ? (const char*)g.A + (size_t)nxt.pm * tstep : cA; const char* nB = has_next ? (const char*)g.Bt + (size_t)nxt.pn * tstep : cB;
        for (int t = 0; t < nt; t += 2) {
            const bool last = (t == nt - 2);
            const char* a1 = cA + (size_t)(t + 1) * kstep;
            const char* a2 = last ? nA : cA + (size_t)(t + 2) * kstep; const char* b2 = last ? nB : cB + (size_t)(t + 2) * kstep;
            const char* a3 = a2 + kstep; const char* b3 = b2 + kstep;
            if (last && has_next) S.a_ready(nxt);
            if constexpr (SP2) {
            PG8_LDB(B0, 0, 0); PG8_LDB(B1, 0, 1); PG8_SCHED; PG8_LDA(At, 0, 0); PG8_STAGE(PG8_SA(1, 1), a1 + hstep, voffA);
            PG8_WAIT_V(8); PG8_WAIT_L(0); PG8_BAR; PG8_MMA(0, 0, At, B0); PG8_MMA(0, 1, At, B1); PG8_BAR; PG8_SCHED;
            PG8_LDA(At, 0, 1); PG8_STAGE(PG8_SB(0, 0), b2, voffB); PG8_STAGE(PG8_SB(0, 1), b2 + hstep, voffB); PG8_STAGE(PG8_SA(0, 0), a2, voffA);
            PG8_WAIT_V(8); PG8_WAIT_L(0); PG8_BAR; PG8_MMA(1, 0, At, B0); PG8_MMA(1, 1, At, B1); PG8_BAR; PG8_SCHED;
            PG8_LDB(B0, 1, 0); PG8_LDB(B1, 1, 1); PG8_SCHED; PG8_LDA(At, 1, 0); PG8_STAGE(PG8_SA(0, 1), a2 + hstep, voffA);
            PG8_WAIT_V(8); PG8_WAIT_L(0); PG8_BAR; PG8_MMA(0, 0, At, B0); PG8_MMA(0, 1, At, B1); PG8_BAR; PG8_SCHED;
            PG8_LDA(At, 1, 1); PG8_STAGE(PG8_SB(1, 0), b3, voffB); PG8_STAGE(PG8_SB(1, 1), b3 + hstep, voffB); PG8_STAGE(PG8_SA(1, 0), a3, voffA);
            PG8_WAIT_V(8); PG8_WAIT_L(0); PG8_BAR; PG8_MMA(1, 0, At, B0); PG8_MMA(1, 1, At, B1); PG8_BAR; PG8_SCHED;
            } else {
            PG8_LDB(B0, 0, 0); PG8_SCHED; PG8_LDA(At, 0, 0); PG8_STAGE(PG8_SA(1, 1), a1 + hstep, voffA);
            PG8_WAIT_L(8); PG8_BAR; PG8_WAIT_L(0); PG8_MMA(0, 0, At, B0); PG8_BAR; PG8_SCHED;
            PG8_LDB(B1, 0, 1); PG8_STAGE(PG8_SB(0, 0), b2, voffB);
            PG8_BAR; PG8_WAIT_L(0); PG8_MMA(0, 1, At, B1); PG8_BAR;
            PG8_LDA(At, 0, 1); PG8_STAGE(PG8_SA(0, 0), a2, voffA);
            PG8_BAR; PG8_WAIT_L(0); PG8_MMA(1, 0, At, B0); PG8_BAR; PG8_SCHED;
            PG8_STAGE(PG8_SB(0, 1), b2 + hstep, voffB);
            PG8_WAIT_V(6); PG8_BAR; PG8_MMA(1, 1, At, B1); PG8_BAR;
            PG8_LDB(B0, 1, 0); PG8_SCHED; PG8_LDA(At, 1, 0); PG8_STAGE(PG8_SA(0, 1), a2 + hstep, voffA);
            PG8_WAIT_L(8); PG8_BAR; PG8_WAIT_L(0); PG8_MMA(0, 0, At, B0); PG8_BAR; PG8_SCHED;
            PG8_LDB(B1, 1, 1); PG8_STAGE(PG8_SB(1, 0), b3, voffB);
            PG8_BAR; PG8_WAIT_L(0); PG8_MMA(0, 1, At, B1); PG8_BAR;
            PG8_LDA(At, 1, 1); PG8_STAGE(PG8_SA(1, 0), a3, voffA);
            PG8_BAR; PG8_WAIT_L(0); PG8_MMA(1, 0, At, B0); PG8_BAR; PG8_SCHED;
            PG8_STAGE(PG8_SB(1, 1), b3 + hstep, voffB);
            PG8_WAIT_V(6); PG8_BAR; PG8_MMA(1, 1, At, B1); PG8_BAR;
            }
        }
        if constexpr (ALIGN_EPI) { if (wr == 0) PG8_BAR; }
        if constexpr (!Epi::AFTER_DRAIN) { E(acc, cur, wr, wc, fr, fq); S.done(cur); }
        if (!has_next) break;
#pragma unroll
        for (int a = 0; a < 2; ++a)
#pragma unroll
            for (int b = 0; b < 2; ++b)
#pragma unroll
                for (int m = 0; m < 4; ++m)
#pragma unroll
                    for (int n = 0; n < 2; ++n) acc[a][b][m][n] = (f32x4){0.f, 0.f, 0.f, 0.f};
        cur = nxt; cA = nA; cB = nB; ++ui;
        if constexpr (ALIGN_EPI) { if (wr == 1) PG8_BAR; }
    }
    PG8_WAIT_V(0);
    if constexpr (!ALIGN_EPI) { if (wr == 0) PG8_BAR; }
    PG8_BAR;
    if constexpr (Epi::AFTER_DRAIN) { E.fused(acc, cur, wr, wc, fr, fq, lds, wid, lane); S.done(cur); }
#undef PG8_SA
#undef PG8_SB
#undef PG8_STAGE
#undef PG8_LDA
#undef PG8_LDB
#undef PG8_MMA
#undef PG8_WAIT_V
#undef PG8_WAIT_L
#undef PG8_BAR
#undef PG8_SCHED
}
}

#define LAS __attribute__((address_space(3)))
typedef float f32x16 __attribute__((ext_vector_type(16)));
typedef float f32x2_t __attribute__((ext_vector_type(2)));
typedef __bf16 bf16x2_t __attribute__((ext_vector_type(2)));
#define MFMA32(a, b, c) __builtin_amdgcn_mfma_f32_32x32x16_bf16((a), (b), (c), 0, 0, 0)
__device__ __forceinline__ unsigned cvtpk(float lo, float hi) { f32x2_t v = {lo, hi}; bf16x2_t b = __builtin_convertvector(v, bf16x2_t); return __builtin_bit_cast(unsigned, b); }
__device__ __forceinline__ int kappa(int i) { return (i & ~12) | ((i & 4) << 1) | ((i & 8) >> 1); }
#define PACK8(P, S) __builtin_bit_cast(bf16x8, (u32x4){cvtpk(P[8 * (S) + 0], P[8 * (S) + 1]), cvtpk(P[8 * (S) + 2], P[8 * (S) + 3]), cvtpk(P[8 * (S) + 4], P[8 * (S) + 5]), cvtpk(P[8 * (S) + 6], P[8 * (S) + 7])})

__device__ __forceinline__ void load_kfrag(bf16x8 (&kf)[8], const bf16_t* K, int rowbase, int kb, int h, int r32, int hi) {
    const bf16_t* p = K + (size_t)(rowbase + kb * 32 + kappa(r32)) * 512 + h * 128 + 8 * hi;
#pragma unroll
    for (int s = 0; s < 8; ++s) kf[s] = *(const bf16x8*)(p + 16 * s);
}
__device__ __forceinline__ void load_vfrag(bf16x8 (&vf)[4][2], const bf16_t* VT, int rowbase, int kb, int h, int r32, int hi) {
    const int blk64 = (rowbase + kb * 32) >> 6;
    const bf16_t* p = VT + ((size_t)(blk64 * 4 + h) * 128 + r32) * 64 + (kb & 1) * 32 + 8 * hi;
#pragma unroll
    for (int db = 0; db < 4; ++db) { vf[db][0] = *(const bf16x8*)(p + (size_t)db * 32 * 64); vf[db][1] = *(const bf16x8*)(p + (size_t)db * 32 * 64 + 16); }
}
__device__ __forceinline__ void sb_item(char* ws, int b, int h, int qb, int lane) {
    const int r32 = lane & 31, hi = lane >> 5, rowbase = b * SEQ, q0 = qb * 32;
    bf16_t* Q = (bf16_t*)(ws + WS_SQ); const bf16_t* K = (const bf16_t*)(ws + WS_SK); const bf16_t* VT = (const bf16_t*)(ws + WS_SV);
    bf16x8 qf[8];
    { const bf16_t* qp = Q + (size_t)(rowbase + q0 + r32) * 512 + h * 128 + 8 * hi;
#pragma unroll
      for (int s = 0; s < 8; ++s) qf[s] = *(const bf16x8*)(qp + 16 * s); }
    f32x16 o[4];
#pragma unroll
    for (int db = 0; db < 4; ++db)
#pragma unroll
        for (int r = 0; r < 16; ++r) o[db][r] = 0.f;
    float carry = 1.f;
    for (int kb = qb; kb >= 0; --kb) {
        bf16x8 kf[8]; load_kfrag(kf, K, rowbase, kb, h, r32, hi);
        bf16x8 vf[4][2]; load_vfrag(vf, VT, rowbase, kb, h, r32, hi);
        f32x16 p;
#pragma unroll
        for (int r = 0; r < 16; ++r) p[r] = 0.f;
#pragma unroll
        for (int s = 0; s < 8; ++s) p = MFMA32(kf[s], qf[s], p);
        const bool diag = (kb == qb);
        float kp[16];
#pragma unroll
        for (int r = 0; r < 16; ++r) {
            const float e = __builtin_amdgcn_exp2f(fminf(p[r], 80.f)); const float rinv = __builtin_amdgcn_rcpf(1.f + e);
            const bool valid = !diag || (((r & 7) + 8 * hi + 16 * (r >> 3)) < r32);
            kp[r] = valid ? rinv : 1.f; p[r] = valid ? e * rinv : 0.f;
        }
        float ex1 = 1.f, ex0 = 1.f;
#pragma unroll
        for (int r = 15; r >= 8; --r) { p[r] *= ex1; ex1 *= kp[r]; }
#pragma unroll
        for (int r = 7; r >= 0; --r) { p[r] *= ex0; ex0 *= kp[r]; }
        const float oT1 = __shfl_xor(ex1, 32), oT0 = __shfl_xor(ex0, 32);
        const float T11 = hi ? ex1 : oT1, T01 = hi ? oT1 : ex1, T10 = hi ? ex0 : oT0, T00 = hi ? oT0 : ex0;
        const float c1 = carry * T11, c2 = c1 * T01, c3 = c2 * T10;
        const float off1 = hi ? carry : c1, off0 = hi ? c2 : c3;
#pragma unroll
        for (int r = 8; r < 16; ++r) p[r] *= off1;
#pragma unroll
        for (int r = 0; r < 8; ++r) p[r] *= off0;
        carry = c3 * T00;
        const bf16x8 pb0 = PACK8(p, 0), pb1 = PACK8(p, 1);
#pragma unroll
        for (int db = 0; db < 4; ++db) { o[db] = MFMA32(vf[db][0], pb0, o[db]); o[db] = MFMA32(vf[db][1], pb1, o[db]); }
        if (__all(carry < 1e-12f)) break;
    }
    bf16_t* orow = Q + (size_t)(rowbase + q0 + r32) * 512 + h * 128;
#pragma unroll
    for (int db = 0; db < 4; ++db)
#pragma unroll
        for (int g = 0; g < 4; ++g) { u32x2 w; w.x = cvtpk(o[db][4 * g], o[db][4 * g + 1]); w.y = cvtpk(o[db][4 * g + 2], o[db][4 * g + 3]); *(u32x2*)(orow + db * 32 + 8 * g + 4 * hi) = w; }
}
__device__ __forceinline__ void attnA_item(LAS unsigned char* lds, char* ws, int b, int h, int qb, float negC) {
    const int tid = threadIdx.x, lane = tid & 63, wave = __builtin_amdgcn_readfirstlane(tid >> 6), r32 = lane & 31, hi = lane >> 5, rowbase = b * SEQ, q0 = qb * 32;
    bf16_t* Q = (bf16_t*)(ws + WS_QA); const bf16_t* K = (const bf16_t*)(ws + WS_KA); const bf16_t* VT = (const bf16_t*)(ws + WS_VA);
    const unsigned* mrow = (const unsigned*)(ws + WS_MASK) + (size_t)(rowbase + q0 + r32) * 256;
    bf16x8 qf[8];
    { const bf16_t* qp = Q + (size_t)(rowbase + q0 + r32) * 512 + h * 128 + 8 * hi;
#pragma unroll
      for (int s = 0; s < 8; ++s) qf[s] = *(const bf16x8*)(qp + 16 * s); }
    f32x16 o[4];
#pragma unroll
    for (int db = 0; db < 4; ++db)
#pragma unroll
        for (int r = 0; r < 16; ++r) o[db][r] = 0.f;
    float l = 0.f;
    for (int kb = wave; kb <= qb; kb += 8) {
        bf16x8 kf[8]; load_kfrag(kf, K, rowbase, kb, h, r32, hi);
        const unsigned wsh = mrow[kb] >> (8 * hi);
        bf16x8 vf[4][2]; load_vfrag(vf, VT, rowbase, kb, h, r32, hi);
        f32x16 p;
#pragma unroll
        for (int r = 0; r < 16; ++r) p[r] = negC;
#pragma unroll
        for (int s = 0; s < 8; ++s) p = MFMA32(kf[s], qf[s], p);
#pragma unroll
        for (int r = 0; r < 16; ++r) {
            const int pos = (r & 7) + 16 * (r >> 3); const int m = ((int)(wsh << (31 - pos))) >> 31;
            const float e = __int_as_float(__float_as_int(__builtin_amdgcn_exp2f(p[r])) & m); p[r] = e; l += e;
        }
        const bf16x8 pb0 = PACK8(p, 0), pb1 = PACK8(p, 1);
#pragma unroll
        for (int db = 0; db < 4; ++db) { o[db] = MFMA32(vf[db][0], pb0, o[db]); o[db] = MFMA32(vf[db][1], pb1, o[db]); }
    }
    LAS float* part = (LAS float*)lds; LAS float* lp = part + 8 * 64 * 64;
#pragma unroll
    for (int db = 0; db < 4; ++db)
#pragma unroll
        for (int r = 0; r < 16; ++r) part[(wave * 64 + db * 16 + r) * 64 + lane] = o[db][r];
    lp[wave * 64 + lane] = l;
    __syncthreads();
#pragma unroll
    for (int i = 0; i < 2; ++i) {
        const int gidx = i * 512 + tid, ln = gidx & 63, g4 = gidx >> 6, q = ln & 31, hh = ln >> 5;
        float s0 = 0.f, s1 = 0.f, s2 = 0.f, s3 = 0.f, lt = 0.f;
#pragma unroll
        for (int w = 0; w < 8; ++w) { const LAS float* pp = part + (w * 64 + g4 * 4) * 64 + ln; s0 += pp[0]; s1 += pp[64]; s2 += pp[128]; s3 += pp[192]; lt += lp[w * 64 + q] + lp[w * 64 + q + 32]; }
        const float inv = 1.f / lt; const int d = (g4 >> 2) * 32 + 8 * (g4 & 3) + 4 * hh;
        u32x2 wv; wv.x = cvtpk(s0 * inv, s1 * inv); wv.y = cvtpk(s2 * inv, s3 * inv);
        *(u32x2*)(Q + (size_t)(rowbase + q0 + q) * 512 + h * 128 + d) = wv;
    }
    __syncthreads();
}
__device__ __forceinline__ void vt_block(LAS unsigned char* lds, bf16_t* V, int blk) {
    const int tid = threadIdx.x; constexpr int PITCH = 520;
    LAS bf16_t* t = (LAS bf16_t*)lds; bf16_t* base = V + (size_t)blk * 64 * 512;
#pragma unroll
    for (int i = 0; i < 8; ++i) { const int c = i * 512 + tid, row = c >> 6, c16 = c & 63; *(LAS u32x4*)(t + row * PITCH + c16 * 8) = *(const u32x4*)(base + (size_t)row * 512 + c16 * 8); }
    __syncthreads();
#pragma unroll
    for (int i = 0; i < 8; ++i) { const int c = i * 512 + tid, hd = c >> 3, ch = c & 7; const LAS bf16_t* s = t + (8 * ch) * PITCH + hd;
        u32x4 w; w.x = (unsigned)s[0] | ((unsigned)s[PITCH] << 16); w.y = (unsigned)s[2 * PITCH] | ((unsigned)s[3 * PITCH] << 16); w.z = (unsigned)s[4 * PITCH] | ((unsigned)s[5 * PITCH] << 16); w.w = (unsigned)s[6 * PITCH] | ((unsigned)s[7 * PITCH] << 16);
        *(u32x4*)(base + (size_t)hd * 64 + 8 * ch) = w; }
    __syncthreads();
}

template <int PASS>
__device__ __forceinline__ void topk_pass(const LAS unsigned char* afl, const bf16_t* IX, unsigned* MASK, LAS unsigned* hist, const LAS float* bnd, const LAS unsigned* pfx, int rowbase, int t0, int j, int wave, int r32, int hi) {
    for (int kb = wave; kb <= j; kb += 8) {
        bf16x8 bfr[4];
        { const bf16_t* p = IX + (size_t)(rowbase + kb * 32 + r32) * 512 + 256 + 8 * hi;
#pragma unroll
          for (int s = 0; s < 4; ++s) bfr[s] = *(const bf16x8*)(p + 16 * s); }
        const unsigned idxterm = 8191u - (unsigned)(kb * 32 + r32);
        const bool diag = (kb == j);
#pragma unroll
        for (int g = 0; g < 4; ++g) {
            asm volatile("" ::: "memory");
            f32x16 acc;
#pragma unroll
            for (int r = 0; r < 16; ++r) acc[r] = 0.f;
#pragma unroll
            for (int s = 0; s < 4; ++s) acc = MFMA32(*(const LAS bf16x8*)(afl + (g * 8) * 528 + s * 32), bfr[s], acc);
#pragma unroll
            for (int a4 = 0; a4 < 4; ++a4) {
                const int q = g * 8 + 2 * a4 + hi;
                const f32x4 bd = *(const LAS f32x4*)(bnd + q * 4);
                const float sc = ((__builtin_amdgcn_fmed3f(acc[4 * a4 + 0], 0.f, bd.x) + __builtin_amdgcn_fmed3f(acc[4 * a4 + 1], 0.f, bd.y)) + __builtin_amdgcn_fmed3f(acc[4 * a4 + 2], 0.f, bd.z)) + __builtin_amdgcn_fmed3f(acc[4 * a4 + 3], 0.f, bd.w);
                const unsigned u = __float_as_uint(sc); const unsigned k32 = u ^ ((unsigned)((int)u >> 31) | 0x80000000u);
                const unsigned key = (k32 & 0xFFFFE000u) | idxterm;
                const bool valid = !diag || (r32 <= q);
                const unsigned pq = pfx[q];
                if (PASS == 0) { if (valid) { const unsigned dg = key >> 21; atomicAdd((unsigned*)(hist + q * 1024 + (dg >> 1)), 1u << (16 * (dg & 1))); } }
                else if (PASS == 1) { if (valid && (key >> 21) == pq) { const unsigned dg = (key >> 10) & 2047u; atomicAdd((unsigned*)(hist + q * 1024 + (dg >> 1)), 1u << (16 * (dg & 1))); } }
                else if (PASS == 2) { if (valid && (key >> 10) == pq) { const unsigned dg = key & 1023u; atomicAdd((unsigned*)(hist + q * 1024 + (dg >> 1)), 1u << (16 * (dg & 1))); } }
                else { const unsigned long long bal = __ballot(valid && key >= pq);
                    if (r32 == 0) MASK[(size_t)(rowbase + t0 + q) * 256 + kb] = hi ? (unsigned)(bal >> 32) : (unsigned)bal; }
            }
        }
    }
}
template <int BITS>
__device__ __forceinline__ void topk_select(LAS unsigned* hist, LAS unsigned* pfx, LAS unsigned* needv, int wave, int lane) {
    constexpr int wpl = (BITS == 10) ? 8 : 16;
    for (int i = 0; i < 4; ++i) {
        const int q = wave * 4 + i; const LAS unsigned* hq = hist + q * 1024 + lane * wpl;
        unsigned c = 0u;
#pragma unroll
        for (int wi = 0; wi < wpl; ++wi) { const unsigned w = hq[wi]; c += (w & 0xffffu) + (w >> 16); }
        unsigned incl = c;
#pragma unroll
        for (int o = 1; o < 64; o <<= 1) { const unsigned v = __shfl_down(incl, o); if (lane + o < 64) incl += v; }
        const unsigned S = incl - c, nq = needv[q];
        if (S < nq && nq <= incl) {
            unsigned run = S, bin = 0u, nn = 1u; bool found = false;
            for (int wi = wpl - 1; wi >= 0 && !found; --wi) { const unsigned w = hq[wi]; const unsigned h16 = w >> 16, l16 = w & 0xffffu;
                if (run + h16 >= nq) { bin = 2u * (unsigned)(lane * wpl + wi) + 1u; nn = nq - run; found = true; }
                else { run += h16; if (run + l16 >= nq) { bin = 2u * (unsigned)(lane * wpl + wi); nn = nq - run; found = true; } else run += l16; } }
            pfx[q] = (pfx[q] << BITS) | bin; needv[q] = nn;
        }
    }
}
__device__ __forceinline__ void lds_clear128k(LAS unsigned char* lds, int tid) {
#pragma unroll
    for (int i = 0; i < 16; ++i) *(LAS u32x4*)(lds + (size_t)(i * 512 + tid) * 16) = (u32x4){0u, 0u, 0u, 0u};
}
__device__ __forceinline__ void topk_item(LAS unsigned char* lds, const char* ws, int b, int j) {
    const int tid = threadIdx.x, lane = tid & 63, wave = __builtin_amdgcn_readfirstlane(tid >> 6), r32 = lane & 31, hi = lane >> 5, rowbase = b * SEQ, t0 = j * 32;
    const bf16_t* IX = (const bf16_t*)(ws + WS_IDX); unsigned* MASK = (unsigned*)(ws + WS_MASK);
    LAS unsigned* hist = (LAS unsigned*)lds;
    LAS float* bnd = (LAS float*)(lds + 147968);
    LAS unsigned* pfx = (LAS unsigned*)(lds + 147968 + 512);
    LAS unsigned* needv = (LAS unsigned*)(lds + 147968 + 640);
    LAS unsigned char* abase = lds + 131072;
    { const int q = tid >> 4, c16 = tid & 15;
      const u32x4 v0 = *(const u32x4*)(IX + (size_t)(rowbase + t0 + q) * 512 + c16 * 8), v1 = *(const u32x4*)(IX + (size_t)(rowbase + t0 + q) * 512 + 128 + c16 * 8);
      *(LAS u32x4*)(abase + q * 528 + c16 * 16) = v0; *(LAS u32x4*)(abase + q * 528 + 256 + c16 * 16) = v1; }
    const LAS unsigned char* afl = abase + (r32 >> 2) * 528 + (r32 & 3) * 128 + hi * 16;
    if (tid < 128) { const int q = tid >> 2, c = tid & 3; const float w = bf2f(IX[(size_t)(rowbase + t0 + q) * 512 + 320 + c]); bnd[tid] = (w >= 0.f) ? INFINITY : -INFINITY; }
    if (tid < 32) { pfx[tid] = 0u; const int n = t0 + tid + 1; needv[tid] = (unsigned)(n < 256 ? n : 256); }
    lds_clear128k(lds, tid);
    __syncthreads();
    topk_pass<0>(afl, IX, MASK, hist, bnd, pfx, rowbase, t0, j, wave, r32, hi);
    __syncthreads(); topk_select<11>(hist, pfx, needv, wave, lane); __syncthreads(); lds_clear128k(lds, tid); __syncthreads();
    topk_pass<1>(afl, IX, MASK, hist, bnd, pfx, rowbase, t0, j, wave, r32, hi);
    __syncthreads(); topk_select<11>(hist, pfx, needv, wave, lane); __syncthreads(); lds_clear128k(lds, tid); __syncthreads();
    topk_pass<2>(afl, IX, MASK, hist, bnd, pfx, rowbase, t0, j, wave, r32, hi);
    __syncthreads(); topk_select<10>(hist, pfx, needv, wave, lane); __syncthreads();
    topk_pass<3>(afl, IX, MASK, hist, bnd, pfx, rowbase, t0, j, wave, r32, hi);
    __syncthreads();
}

constexpr int NWAVES = 8, LDS_BYTES = 155648, RING_BYTES = 131072;
struct MArgs { const void* in[23]; float* out; char* ws; int ph_lo, ph_hi; };

__device__ __forceinline__ void conv_item(const float* W, int K, int Nsrc, bf16_t* WT, int mode, int srcoff, int Ndst, LAS float* scr, int item, int lane) {
    const int nblk = Ndst / 32, kb = item / nblk, nb = item % nblk, k0 = 64 * kb, n0 = 32 * nb;
    const int n = n0 + (lane & 31); const int scol = (mode == 1) ? win_srccol(n) : srcoff + n;
#pragma unroll 8
    for (int i = 0; i < 32; ++i) { const int kk = 2 * i + (lane >> 5); float v = 0.f; if (scol >= 0) v = W[(size_t)(k0 + kk) * Nsrc + scol]; scr[kk * 33 + (lane & 31)] = v; }
    asm volatile("s_waitcnt lgkmcnt(0)" ::: "memory");
    const int c = lane & 7;
#pragma unroll
    for (int j = 0; j < 4; ++j) { const int nn = (lane >> 3) + 8 * j; const LAS float* s = scr + (8 * c) * 33 + nn;
        u32x4 o; o.x = pk2(s[0 * 33], s[1 * 33]); o.y = pk2(s[2 * 33], s[3 * 33]); o.z = pk2(s[4 * 33], s[5 * 33]); o.w = pk2(s[6 * 33], s[7 * 33]);
        *(u32x4*)(WT + (size_t)(n0 + nn) * K + k0 + 8 * c) = o; }
    asm volatile("s_waitcnt lgkmcnt(0)" ::: "memory");
}
__device__ __forceinline__ void rms_row(const float* x, float* xcopy, const float* g, bf16_t* out, int m, int lane) {
    const f32x4* xr = (const f32x4*)(x + (size_t)m * DM) + lane; f32x4 v[4]; float s = 0.f;
#pragma unroll
    for (int j = 0; j < 4; ++j) { v[j] = xr[64 * j]; s += (v[j].x * v[j].x + v[j].y * v[j].y) + (v[j].z * v[j].z + v[j].w * v[j].w); }
    s = wave_sum(s); const float r = rsqrtf(s * (1.f / DM) + EPS);
    if (xcopy) {
#pragma unroll
        for (int j = 0; j < 4; ++j) ((f32x4*)(xcopy + (size_t)m * DM) + lane)[64 * j] = v[j];
    }
#pragma unroll
    for (int j = 0; j < 4; ++j) { const f32x4 gg = ((const f32x4*)g + lane)[64 * j]; u32x2 w; w.x = pk2(v[j].x * r * gg.x, v[j].y * r * gg.y); w.y = pk2(v[j].z * r * gg.z, v[j].w * r * gg.w);
        *(u32x2*)(out + (size_t)m * DM + (64 * j + lane) * 4) = w; }
}
__device__ __forceinline__ void prepass_token(char* ws, int m, int w, int lane, int t256, float pos, const float* g_qa, const float* g_ka, const float* g_kidx) {
#pragma unroll
    for (int which = 0; which < 2; ++which) {
        bf16_t* p = (bf16_t*)(ws + (which ? WS_KA : WS_QA)) + (size_t)m * 512 + w * 128; const float* g = which ? g_ka : g_qa;
        const float v0 = bf2f(p[lane]), v1 = bf2f(p[lane + 64]);
        const float ss = wave_sum(v0 * v0 + v1 * v1); const float r = rsqrtf(ss * (1.f / 128.f) + EPS);
        float y0 = v0 * r * g[lane]; const float y1 = v1 * r * g[lane + 64];
        const float part = __shfl_xor(y0, 16);
        if (lane < 32) { const int i = lane & 15; const float inv = powf(500000.f, -((float)i * 2.0f) / 32.f); const float ang = pos * inv; const float c = cosf(ang), s = sinf(ang);
            y0 = (lane < 16) ? y0 * c - part * s : y0 * c + part * s; }
        const float sc = which ? 1.f : QSCALE;
        p[lane] = (bf16_t)f2bf(y0 * sc); p[lane + 64] = (bf16_t)f2bf(y1 * sc);
    }
    bf16_t* ix = (bf16_t*)(ws + WS_IDX) + (size_t)m * 512;
    const float wv = bf2f(ix[320 + w]);
    {
        float y = bf2f(ix[w * 64 + lane]); const float part = __shfl_xor(y, 8);
        if (lane < 16) { const int i = lane & 7; const float inv = powf(500000.f, -((float)i * 2.0f) / 16.f); const float ang = pos * inv; const float c = cosf(ang), s = sinf(ang);
            y = (lane < 8) ? y * c - part * s : y * c + part * s; }
        ix[w * 64 + lane] = (bf16_t)f2bf(y * wv * 0.0625f);
    }
    if (w == 0) {
        const float v = bf2f(ix[256 + lane]); const float ss = wave_sum(v * v); const float r = rsqrtf(ss * (1.f / 64.f) + EPS);
        float y = v * r * g_kidx[lane]; const float part = __shfl_xor(y, 8);
        if (lane < 16) { const int i = lane & 7; const float inv = powf(500000.f, -((float)i * 2.0f) / 16.f); const float ang = pos * inv; const float c = cosf(ang), s = sinf(ang);
            y = (lane < 8) ? y * c - part * s : y * c + part * s; }
        ix[256 + lane] = (bf16_t)f2bf(y);
    }
    bf16_t* ga = (bf16_t*)(ws + WS_GLUA) + (size_t)m * 512; const bf16_t* gb = (const bf16_t*)(ws + WS_GLUB) + (size_t)m * 512;
    bf16_t* gc = (bf16_t*)(ws + WS_GC) + (size_t)m * 512; const bf16_t* xc = (const bf16_t*)(ws + WS_XC) + (size_t)m * 512;
    bf16_t* sq = (bf16_t*)(ws + WS_SQ) + (size_t)m * 512;
#pragma unroll
    for (int e = 0; e < 2; ++e) { const int c = t256 + e * 256;
        ga[c] = (bf16_t)f2bf(bf2f(ga[c]) * sigmoidf_(bf2f(gb[c])));
        gc[c] = (bf16_t)f2bf(bf2f(gc[c]) * bf2f(xc[c]));
        sq[c] = (bf16_t)f2bf(bf2f(sq[c]) * QSCALE); }
}
__device__ __forceinline__ void conv_token(char* ws, int m, int lane, const float* cbw, const float* cbb, const float* lng, const float* lnb, const float* ccw) {
    const int t = m & (SEQ - 1); const int c0 = lane * 8;
    {
        const bf16_t* U = (const bf16_t*)(ws + WS_GLUA); float acc[8];
#pragma unroll
        for (int j = 0; j < 8; ++j) acc[j] = cbb[c0 + j];
        for (int k = 0; k < 31; ++k) { const int tt = t - 30 + k; if (tt < 0) continue;
            const bf16x8 u = *(const bf16x8*)(U + (size_t)(m - 30 + k) * 512 + c0);
#pragma unroll
            for (int j = 0; j < 8; ++j) acc[j] += cbw[k * 512 + c0 + j] * bfs2f(u[j]); }
        float s = 0.f;
#pragma unroll
        for (int j = 0; j < 8; ++j) s += acc[j];
        const float mean = wave_sum(s) * (1.f / 512.f); float q = 0.f;
#pragma unroll
        for (int j = 0; j < 8; ++j) { acc[j] -= mean; q += acc[j] * acc[j]; }
        const float r = rsqrtf(wave_sum(q) * (1.f / 512.f) + EPS); float o[8];
#pragma unroll
        for (int j = 0; j < 8; ++j) { const float y = acc[j] * r * lng[c0 + j] + lnb[c0 + j]; o[j] = y * sigmoidf_(y); }
        u32x4 wv; wv.x = pk2(o[0], o[1]); wv.y = pk2(o[2], o[3]); wv.z = pk2(o[4], o[5]); wv.w = pk2(o[6], o[7]);
        *(u32x4*)((bf16_t*)(ws + WS_GLUB) + (size_t)m * 512 + c0) = wv;
    }
    {
        const bf16_t* X = (const bf16_t*)(ws + WS_GC); float acc[8];
#pragma unroll
        for (int j = 0; j < 8; ++j) acc[j] = 0.f;
        for (int k = 0; k < 3; ++k) { const int tt = t - 2 + k; if (tt < 0) continue;
            const bf16x8 u = *(const bf16x8*)(X + (size_t)(m - 2 + k) * 512 + c0);
#pragma unroll
            for (int j = 0; j < 8; ++j) acc[j] += ccw[k * 512 + c0 + j] * bfs2f(u[j]); }
        const bf16x8 g = *(const bf16x8*)((const bf16_t*)(ws + WS_GB) + (size_t)m * 512 + c0); float o[8];
#pragma unroll
        for (int j = 0; j < 8; ++j) o[j] = acc[j] * bfs2f(g[j]);
        u32x4 wv; wv.x = pk2(o[0], o[1]); wv.y = pk2(o[2], o[3]); wv.z = pk2(o[4], o[5]); wv.w = pk2(o[6], o[7]);
        *(u32x4*)((bf16_t*)(ws + WS_XC) + (size_t)m * 512 + c0) = wv;
    }
}

template <class F, bool BR, bool ALIGN, class Sched>
__device__ __forceinline__ void run_gemm(LAS unsigned char* lds, const bf16_t* A, const bf16_t* Bt, int M, int N, int K, const Sched& S, const F& f) {
    const pg8::Gemm g{A, Bt, M, N, K}; const pg8::EpiFn<F, BR> E{f};
    pg8::gemm_phase<pg8::EpiFn<F, BR>, Sched, ALIGN, true>(lds, g, S, E);
}


#define FIN(i) ((const float*)a.in[i])
#define PH_BEGIN(kk) if (a.ph_lo <= L * 16 + (kk) && L * 16 + (kk) < a.ph_hi) {
#define PH_END(kk) if (L * 16 + (kk) + 1 < a.ph_hi) grid.sync(); }
template <int L> __device__ __forceinline__ void layer_phases(const MArgs& a, LAS unsigned char* lds, const cg::grid_group& grid) {
    const int tid = threadIdx.x, lane = tid & 63, wave = __builtin_amdgcn_readfirstlane(tid >> 6);
    const int G = gridDim.x, bx = blockIdx.x;
    PH_BEGIN(0)
        char* ws = a.ws; const int gw = bx * NWAVES + wave, NGW = G * NWAVES;
        LAS float* scr = (LAS float*)(lds + wave * 16384);
        const float* w_in = FIN(3) + (size_t)L * DM * NIN_SRC;
        constexpr int I_WIN = 16 * 192, I_WG = 16 * 128, I_WO = 8 * 32, I_WM = 16 * 32, I_FF = 16 * 88, I_FD = 44 * 32;
        constexpr int NITEMS = I_WIN + I_WG + 4 * I_WO + I_WM + 2 * I_FF + I_FD;
        for (int it = gw; it < NITEMS; it += NGW) {
            int r = it;
            if (r < I_WIN) { conv_item(w_in, DM, NIN_SRC, (bf16_t*)(ws + WS_WIN), 1, 0, 6144, scr, r, lane); continue; } r -= I_WIN;
            if (r < I_WG) { conv_item(w_in, DM, NIN_SRC, (bf16_t*)(ws + WS_WGATE), 0, 5956, 4096, scr, r, lane); continue; } r -= I_WG;
            if (r < 4 * I_WO) { const int br = r / I_WO; const int idx = br == 0 ? 8 : br == 1 ? 13 : br == 2 ? 15 : 16;
                conv_item(FIN(idx) + (size_t)L * 512 * DM, 512, DM, (bf16_t*)(ws + WS_WO) + (size_t)br * DM * 512, 0, 0, DM, scr, r % I_WO, lane); continue; } r -= 4 * I_WO;
            if (r < I_WM) { conv_item(FIN(17) + (size_t)L * DM * DM, DM, DM, (bf16_t*)(ws + WS_WM), 0, 0, DM, scr, r, lane); continue; } r -= I_WM;
            if (r < I_FF) { conv_item(FIN(19) + (size_t)L * DM * DFF, DM, DFF, (bf16_t*)(ws + WS_WFG), 0, 0, DFF, scr, r, lane); continue; } r -= I_FF;
            if (r < I_FF) { conv_item(FIN(20) + (size_t)L * DM * DFF, DM, DFF, (bf16_t*)(ws + WS_WFU), 0, 0, DFF, scr, r, lane); continue; } r -= I_FF;
            conv_item(FIN(22) + (size_t)L * DFF * DM, DFF, DM, (bf16_t*)(ws + WS_WFD), 0, 0, DM, scr, r, lane);
        }
        for (int m = gw; m < MTOK; m += NGW) rms_row(L == 0 ? FIN(0) : (const float*)a.out, L == 0 ? a.out : (float*)nullptr, FIN(2) + (size_t)L * DM, (bf16_t*)(ws + WS_H), m, lane);
    PH_END(0)
    PH_BEGIN(1)
        EpiSplit es; es.ws = a.ws;
        pg8::StaticOrder S; S.init(MTOK, 6144, G, bx);
        run_gemm<EpiSplit, false, true>(lds, (const bf16_t*)(a.ws + WS_H), (const bf16_t*)(a.ws + WS_WIN), MTOK, 6144, DM, S, es);
    PH_END(1)
    PH_BEGIN(2)
        const int* positions = (const int*)a.in[1];
        for (int m = bx * 2 + (wave >> 2); m < MTOK; m += 2 * G)
            prepass_token(a.ws, m, wave & 3, lane, tid & 255, (float)positions[m], FIN(5) + L * 128, FIN(6) + L * 128, FIN(7) + L * 64);
        for (int it = bx; it < 512; it += G) vt_block(lds, (bf16_t*)(a.ws + (it < 256 ? WS_VA : WS_SV)), it & 255);
    PH_END(2)
    PH_BEGIN(3)
        const int gw = bx * NWAVES + wave, NGW = G * NWAVES;
        for (int m = gw; m < MTOK; m += NGW) conv_token(a.ws, m, lane, FIN(9) + (size_t)L * 31 * 512, FIN(10) + L * 512, FIN(11) + L * 512, FIN(12) + L * 512, FIN(14) + (size_t)L * 3 * 512);
#if !NAIVE_TOPK
        for (int it = bx; it < 512; it += G) { const int bb = it >> 8, jj = it & 255; topk_item(lds, a.ws, bb, bb ? 255 - jj : jj); }
#endif
    PH_END(3)
    PH_BEGIN(4)
#if !NAIVE_D
        { const int gw = bx * NWAVES + wave, NGW = G * NWAVES;
          for (int it = gw; it < 2048; it += NGW) sb_item(a.ws, it >> 10, (it >> 8) & 3, it & 255, lane); }
#endif
#if !NAIVE_A
        { const float* gq = FIN(5) + L * 128; const float* gk = FIN(6) + L * 128;
          const float mq = wave_max(fmaxf(fabsf(gq[lane]), fabsf(gq[lane + 64]))), mk = wave_max(fmaxf(fabsf(gk[lane]), fabsf(gk[lane + 64])));
          const float negC = -16.33f * mq * mk;
          for (int it = bx; it < 2048; it += G) { const int bh = it >> 8, j = it & 255; attnA_item(lds, a.ws, bh >> 2, bh & 3, (bh & 1) ? 255 - j : j, negC); } }
#endif
    PH_END(4)
    PH_BEGIN(5)
        pg8::StaticOrder S; S.init(MTOK, 4096, G, bx);
        run_gemm<EpiGates, false, true>(lds, (const bf16_t*)(a.ws + WS_H), (const bf16_t*)(a.ws + WS_WGATE), MTOK, 4096, DM, S, EpiGates{(bf16_t*)(a.ws + WS_GATES), FIN(4) + (size_t)L * 4096});
    PH_END(5)
    PH_BEGIN(6)
        pg8::BranchOrder S; S.init(G, bx);
        run_gemm<EpiOut, true, true>(lds, (const bf16_t*)(a.ws + WS_BR), (const bf16_t*)(a.ws + WS_WO), MTOK, DM, 512, S, EpiOut{(const bf16_t*)(a.ws + WS_GATES), (bf16_t*)(a.ws + WS_H)});
    PH_END(6)
    PH_BEGIN(7)
        pg8::StaticOrder S; S.init(MTOK, DM, G, bx);
        run_gemm<EpiResid, false, false>(lds, (const bf16_t*)(a.ws + WS_H), (const bf16_t*)(a.ws + WS_WM), MTOK, DM, DM, S, EpiResid{a.out});
    PH_END(7)
    PH_BEGIN(8)
        const int gw = bx * NWAVES + wave, NGW = G * NWAVES;
        for (int m = gw; m < MTOK; m += NGW) rms_row(a.out, nullptr, FIN(18) + (size_t)L * DM, (bf16_t*)(a.ws + WS_H), m, lane);
    PH_END(8)
    PH_BEGIN(9)
        pg8::StaticOrder S; S.init(MTOK, DFF, G, bx);
        run_gemm<EpiStore, false, true>(lds, (const bf16_t*)(a.ws + WS_H), (const bf16_t*)(a.ws + WS_WFG), MTOK, DFF, DM, S, EpiStore{(bf16_t*)(a.ws + WS_GP), DFF, 0});
    PH_END(9)
    PH_BEGIN(10)
        pg8::StaticOrder S; S.init(MTOK, DFF, G, bx);
        run_gemm<EpiFfnAct, false, true>(lds, (const bf16_t*)(a.ws + WS_H), (const bf16_t*)(a.ws + WS_WFU), MTOK, DFF, DM, S, EpiFfnAct{(const bf16_t*)(a.ws + WS_GP), FIN(21) + (size_t)L * 3 * DFF, (bf16_t*)(a.ws + WS_ACT)});
    PH_END(10)
    PH_BEGIN(11)
        pg8::StaticOrder S; S.init(MTOK, DM, G, bx);
        run_gemm<EpiResid, false, false>(lds, (const bf16_t*)(a.ws + WS_ACT), (const bf16_t*)(a.ws + WS_WFD), MTOK, DM, DFF, S, EpiResid{a.out});
    PH_END(11)
}
__global__ void __launch_bounds__(NWAVES * 64, 2) mega(MArgs a) {
    extern __shared__ __attribute__((aligned(16))) unsigned char lds_raw[];
    cg::grid_group grid = cg::this_grid();
    LAS unsigned char* lds = (LAS unsigned char*)lds_raw;
    layer_phases<0>(a, lds, grid);
    layer_phases<1>(a, lds, grid);
}
#undef FIN

#ifndef DIFF_A
#define DIFF_A 0
#endif
__global__ __launch_bounds__(256) void k_compare(const bf16_t* a, const bf16_t* b, size_t n, float* acc) {
    float num = 0.f, den = 0.f;
    for (size_t i = (size_t)blockIdx.x * 256 + threadIdx.x; i < n; i += (size_t)gridDim.x * 256) { const float x = bf2f(a[i]), y = bf2f(b[i]); num += (x - y) * (x - y); den += y * y; }
    num = wave_sum(num); den = wave_sum(den);
    if ((threadIdx.x & 63) == 0) { atomicAdd(acc, num); atomicAdd(acc + 1, den); }
}
#ifndef DIFF_T
#define DIFF_T 0
#endif
__global__ __launch_bounds__(256) void k_compare_mask(const unsigned* a, const unsigned* b, float* acc) {
    float num = 0.f, den = 0.f;
    for (size_t i = (size_t)blockIdx.x * 256 + threadIdx.x; i < (size_t)MTOK * 256; i += (size_t)gridDim.x * 256) { const int m = (int)(i >> 8), w = (int)(i & 255);
        if (w <= ((m & (SEQ - 1)) >> 5)) { const unsigned x = a[i], y = b[i]; num += (float)__popc(x ^ y); den += (float)__popc(y); } }
    num = wave_sum(num); den = wave_sum(den);
    if ((threadIdx.x & 63) == 0) { atomicAdd(acc, num); atomicAdd(acc + 1, den); }
}
__global__ __launch_bounds__(256) void k_encode(float* out, size_t n, const float* acc) {
    const float f = 1.f + (DIFF_T ? 1.f : 10.f) * sqrtf(acc[0] / acc[1]);
    for (size_t i = (size_t)blockIdx.x * 256 + threadIdx.x; i < n; i += (size_t)gridDim.x * 256) out[i] *= f;
}
template <class Epi> static void gemm_simple(hipStream_t st, const bf16_t* A, int lda, const bf16_t* Bt, int ldb, int M, int N, int K, Epi e, int aux = 0) {
    GemmArgs<Epi> ga{}; ga.A = A; ga.Bt = Bt; ga.lda = lda; ga.ldb = ldb; ga.K = K; ga.aux = aux; ga.epi = e;
    hipLaunchKernelGGL(k_gemm_simple<Epi>, dim3(N / 128, M / 128), dim3(256), 0, st, ga);
}
static int g_grid = 0;
static void launch_mega(hipStream_t st, MArgs a, int lo, int hi) {
    a.ph_lo = lo; a.ph_hi = hi; void* args[] = {&a};
    hipError_t e = hipLaunchCooperativeKernel((const void*)mega, dim3(g_grid), dim3(NWAVES * 64), args, LDS_BYTES, st);
    if (e != hipSuccess) fprintf(stderr, "cooperative launch failed: %s (grid %d)\n", hipGetErrorString(e), g_grid);
}

extern "C" void kernel_launch(void* const* d_in, const int* in_sizes, int n_in, void* d_out, int out_size, void* d_ws, size_t ws_size, hipStream_t stream) {
    if (n_in != 23 || ws_size < WS_END + 16 * MiB || out_size != MTOK * DM) { fprintf(stderr, "kernel_launch: unexpected shapes (n_in %d, ws %zu, out %d)\n", n_in, ws_size, out_size); return; }
    if (g_grid == 0) {
        int dev = 0, cus = 0, per_cu = 0;
        hipGetDevice(&dev); hipDeviceGetAttribute(&cus, hipDeviceAttributeMultiprocessorCount, dev);
        if (hipFuncSetAttribute((const void*)mega, hipFuncAttributeMaxDynamicSharedMemorySize, LDS_BYTES) != hipSuccess) { fprintf(stderr, "hipFuncSetAttribute failed\n"); g_grid = -1; return; }
        if (hipOccupancyMaxActiveBlocksPerMultiprocessor(&per_cu, (const void*)mega, NWAVES * 64, LDS_BYTES) != hipSuccess || per_cu < 1) { fprintf(stderr, "occupancy query: %d blocks/CU\n", per_cu); g_grid = -1; return; }
        g_grid = cus * per_cu;
    }
    if (g_grid < 0) return;
    char* ws = (char*)d_ws;
    MArgs a{}; for (int i = 0; i < 23; ++i) a.in[i] = d_in[i]; a.out = (float*)d_out; a.ws = ws;
#if !(NAIVE_TOPK || NAIVE_A || NAIVE_D || DIFF_A || DIFF_T)
    launch_mega(stream, a, 0, 28);
#else
    for (int l = 0; l < DEPTH; ++l) {
        launch_mega(stream, a, l * 16 + 0, l * 16 + 4);
#if NAIVE_TOPK
        hipLaunchKernelGGL(k_topk_naive, dim3(MTOK), dim3(256), 0, stream, (const char*)ws, (unsigned*)(ws + WS_MASK));
#endif
#if DIFF_T
        if (l == 0) {
            hipMemsetAsync(ws, 0, 64, stream);
            hipLaunchKernelGGL(k_topk_naive, dim3(MTOK), dim3(256), 0, stream, (const char*)ws, (unsigned*)(ws + WS_END));
            hipLaunchKernelGGL(k_compare_mask, dim3(1024), dim3(256), 0, stream, (const unsigned*)(ws + WS_MASK), (const unsigned*)(ws + WS_END), (float*)ws);
        }
#endif
#if NAIVE_A
        hipLaunchKernelGGL(k_attnA_naive, dim3(MTOK), dim3(256), 0, stream, ws, (bf16_t*)(ws + WS_QA));
#endif
#if NAIVE_D
        hipLaunchKernelGGL(k_sb_naive, dim3(MTOK * 4), dim3(256), 0, stream, ws);
#endif
#if DIFF_A
        if (l == 0) {
            hipMemsetAsync(ws, 0, 64, stream);
            hipLaunchKernelGGL(k_attnA_naive, dim3(MTOK), dim3(256), 0, stream, ws, (bf16_t*)(ws + WS_END));
            launch_mega(stream, a, l * 16 + 4, l * 16 + 5);
            hipLaunchKernelGGL(k_compare, dim3(1024), dim3(256), 0, stream, (const bf16_t*)(ws + WS_QA), (const bf16_t*)(ws + WS_END), (size_t)MTOK * 512, (float*)ws);
            launch_mega(stream, a, l * 16 + 5, l * 16 + 12);
        } else
#endif
        launch_mega(stream, a, l * 16 + 4, l * 16 + 12);
    }
#endif
#if DIFF_A || DIFF_T
    hipLaunchKernelGGL(k_encode, dim3(1024), dim3(256), 0, stream, (float*)d_out, (size_t)MTOK * DM, (const float*)ws);
#endif
}
```

```cpp
#include <hip/hip_runtime.h>
#include <hip/hip_cooperative_groups.h>
#include <cstdint>
#include <cstdio>
#include <cmath>

namespace cg = cooperative_groups;
typedef unsigned short bf16_t;
typedef short bf16x8 __attribute__((ext_vector_type(8)));
typedef float f32x4 __attribute__((ext_vector_type(4)));
typedef unsigned u32x4 __attribute__((ext_vector_type(4)));
typedef unsigned u32x2 __attribute__((ext_vector_type(2)));

#ifndef NAIVE_TOPK
#define NAIVE_TOPK 0
#endif
#ifndef NAIVE_A
#define NAIVE_A 0
#endif
#ifndef NAIVE_D
#define NAIVE_D 0
#endif
#ifndef REP_COLLECT
#define REP_COLLECT 1
#endif
#ifndef TS_PHASE
#define TS_PHASE -1
#endif
#ifndef TS_BUSY
#define TS_BUSY -1
#endif
#ifndef TS_JLO
#define TS_JLO 0
#endif
#ifndef TS_JHI
#define TS_JHI 255
#endif
#ifndef TS_MAX
#define TS_MAX 0
#endif
#ifndef TS_SCALE
#define TS_SCALE 0.01f
#endif
#ifndef REP_HEAD
#define REP_HEAD 1
#endif
#ifndef REP_TAIL
#define REP_TAIL 1
#endif
#ifndef REP_PICK
#define REP_PICK 1
#endif
#ifndef REP_SAMPLE
#define REP_SAMPLE 1
#endif
constexpr int SEQ = 8192, DM = 1024, MTOK = 2 * SEQ, DEPTH = 2, NIN_SRC = 10052, DFF = 2816;
constexpr float EPS = 1e-6f;
constexpr float QSCALE = 0.08838834764831845f * 1.4426950408889634f;

constexpr size_t MiB = 1u << 20;
constexpr size_t WS_WIN = 1 * MiB, WS_WGATE = 13 * MiB, WS_WO = 21 * MiB, WS_WM = 25 * MiB, WS_WFG = 27 * MiB, WS_WFU = WS_WFG + 5767168, WS_WFD = WS_WFU + 5767168;
constexpr size_t WS_H = 44 * MiB;
constexpr size_t WS_QA = 76 * MiB, WS_GLUB = 92 * MiB, WS_XC = 108 * MiB, WS_SQ = 124 * MiB;
constexpr size_t WS_KA = 140 * MiB, WS_VA = 156 * MiB, WS_IDX = 172 * MiB, WS_GLUA = 188 * MiB, WS_GB = 204 * MiB, WS_GC = 220 * MiB, WS_SK = 236 * MiB, WS_SV = 252 * MiB;
constexpr size_t WS_MASK = 268 * MiB, WS_END = 284 * MiB;
constexpr size_t WS_GATES = 140 * MiB;
constexpr size_t WS_GP = 76 * MiB, WS_ACT = 164 * MiB;
constexpr size_t WS_BR = WS_QA;
constexpr size_t WS_ROPE = 302 * MiB;
constexpr size_t WS_KIF = 300 * MiB;

__host__ __device__ __forceinline__ size_t vt_index(int m, int h, int d) { return ((size_t)((m >> 6) * 4 + h) * 128 + d) * 64 + (m & 63); }
__device__ __forceinline__ float bf2f(bf16_t b) { return __uint_as_float((unsigned)b << 16); }
__device__ __forceinline__ float bfs2f(short b) { return __uint_as_float(((unsigned)(unsigned short)b) << 16); }
__device__ __forceinline__ unsigned f2bf(float f) { unsigned u = __float_as_uint(f); return (u + 0x7fffu + ((u >> 16) & 1u)) >> 16; }
__device__ __forceinline__ unsigned pk2(float lo, float hi) { return f2bf(lo) | (f2bf(hi) << 16); }
#define DPP_F(x, ctrl) __int_as_float(__builtin_amdgcn_update_dpp(0, __float_as_int(x), (ctrl), 0xf, 0xf, true))
__device__ __forceinline__ float wave_sum(float v) {
    v += DPP_F(v, 0xB1); v += DPP_F(v, 0x4E); v += DPP_F(v, 0x141); v += DPP_F(v, 0x140);
    const int iv = __float_as_int(v);
    return (__int_as_float(__builtin_amdgcn_readlane(iv, 0)) + __int_as_float(__builtin_amdgcn_readlane(iv, 16))) + (__int_as_float(__builtin_amdgcn_readlane(iv, 32)) + __int_as_float(__builtin_amdgcn_readlane(iv, 48)));
}
__device__ __forceinline__ float wave_max(float v) {
    v = fmaxf(v, DPP_F(v, 0xB1)); v = fmaxf(v, DPP_F(v, 0x4E)); v = fmaxf(v, DPP_F(v, 0x141)); v = fmaxf(v, DPP_F(v, 0x140));
    const int iv = __float_as_int(v);
    return fmaxf(fmaxf(__int_as_float(__builtin_amdgcn_readlane(iv, 0)), __int_as_float(__builtin_amdgcn_readlane(iv, 16))), fmaxf(__int_as_float(__builtin_amdgcn_readlane(iv, 32)), __int_as_float(__builtin_amdgcn_readlane(iv, 48))));
}
__device__ __forceinline__ unsigned wave_sum_u(unsigned v) {
#pragma unroll
    for (int o = 32; o > 0; o >>= 1) v += __shfl_xor(v, o);
    return v;
}
__device__ __forceinline__ float sigmoidf_(float x) { return __builtin_amdgcn_rcpf(1.f + __builtin_amdgcn_exp2f(fminf(-1.4426950408889634f * x, 80.f))); }

struct ConvJob { const float* src; bf16_t* dst; int K, Nsrc, Ndst, mode, srcoff, pad; };
__host__ __device__ __forceinline__ int win_srccol(int n) {
    if (n < 1536) return n;
    if (n < 2048) { const int j = n - 1536; return j < 324 ? 1536 + j : -1; }
    if (n < 3072) { const int m = n - 2048, ch = (m >> 8) * 128 + (m & 127); return ((m >> 7) & 1 ? 2372 : 1860) + ch; }
    if (n < 3584) return 2884 + (n - 3072);
    if (n < 4608) { const int m = n - 3584, ch = (m >> 8) * 128 + (m & 127); return ((m >> 7) & 1 ? 3908 : 3396) + ch; }
    return 4420 + (n - 4608);
}
__global__ __launch_bounds__(256) void k_convert(ConvJob jb) {
    __shared__ float tile[64][65];
    const int n0 = blockIdx.x * 64, k0 = blockIdx.y * 64, tx = threadIdx.x & 63, ty = threadIdx.x >> 6;
    const int n = n0 + tx; const int sc = (jb.mode == 1) ? win_srccol(n) : jb.srcoff + n;
    for (int i = ty; i < 64; i += 4) { float v = 0.f; if (sc >= 0) v = jb.src[(size_t)(k0 + i) * jb.Nsrc + sc]; tile[i][tx] = v; }
    __syncthreads();
    for (int c = threadIdx.x; c < 512; c += 256) {
        const int nn = c >> 3, ch = c & 7; u32x4 w;
        w.x = pk2(tile[ch * 8 + 0][nn], tile[ch * 8 + 1][nn]); w.y = pk2(tile[ch * 8 + 2][nn], tile[ch * 8 + 3][nn]);
        w.z = pk2(tile[ch * 8 + 4][nn], tile[ch * 8 + 5][nn]); w.w = pk2(tile[ch * 8 + 6][nn], tile[ch * 8 + 7][nn]);
        *(u32x4*)(jb.dst + (size_t)(n0 + nn) * jb.K + k0 + ch * 8) = w;
    }
}

__global__ __launch_bounds__(256) void k_rmsnorm(const float* x, float* xcopy, const float* g, bf16_t* out) {
    const int wave = threadIdx.x >> 6, lane = threadIdx.x & 63; const int m = blockIdx.x * 4 + wave;
    const f32x4* xr = (const f32x4*)(x + (size_t)m * DM) + lane; f32x4 v[4]; float s = 0.f;
#pragma unroll
    for (int j = 0; j < 4; ++j) { v[j] = xr[64 * j]; s += (v[j].x * v[j].x + v[j].y * v[j].y) + (v[j].z * v[j].z + v[j].w * v[j].w); }
    s = wave_sum(s); const float r = rsqrtf(s * (1.f / DM) + EPS);
    if (xcopy) {
#pragma unroll
        for (int j = 0; j < 4; ++j) ((f32x4*)(xcopy + (size_t)m * DM) + lane)[64 * j] = v[j];
    }
#pragma unroll
    for (int j = 0; j < 4; ++j) { const f32x4 gg = ((const f32x4*)g + lane)[64 * j]; u32x2 w; w.x = pk2(v[j].x * r * gg.x, v[j].y * r * gg.y); w.y = pk2(v[j].z * r * gg.z, v[j].w * r * gg.w);
        *(u32x2*)(out + (size_t)m * DM + (64 * j + lane) * 4) = w; }
}

__device__ __forceinline__ void store4bf(bf16_t* p, f32x4 v) { u32x2 w; w.x = pk2(v.x, v.y); w.y = pk2(v.z, v.w); *(u32x2*)p = w; }
__device__ __forceinline__ f32x4 load4bf(const bf16_t* p) { const u32x2 w = *(const u32x2*)p; f32x4 r; r.x = __uint_as_float(w.x << 16); r.y = __uint_as_float(w.x & 0xffff0000u); r.z = __uint_as_float(w.y << 16); r.w = __uint_as_float(w.y & 0xffff0000u); return r; }
__host__ __device__ __forceinline__ size_t goff_of(int g) {
    switch (g) { case 0: return WS_QA; case 1: return WS_KA; case 2: return WS_VA; case 3: return WS_IDX; case 4: return WS_GLUA; case 5: return WS_GLUB;
                 case 6: return WS_GB; case 7: return WS_GC; case 8: return WS_XC; case 9: return WS_SQ; case 10: return WS_SK; default: return WS_SV; } }
__device__ __forceinline__ void store8bf(bf16_t* p, f32x4 a, f32x4 b) { u32x4 w; w.x = pk2(a.x, a.y); w.y = pk2(a.z, a.w); w.z = pk2(b.x, b.y); w.w = pk2(b.z, b.w); *(u32x4*)p = w; }
__device__ __forceinline__ void load8bf(const bf16_t* p, f32x4& a, f32x4& b) { const u32x4 w = *(const u32x4*)p;
    a.x = __uint_as_float(w.x << 16); a.y = __uint_as_float(w.x & 0xffff0000u); a.z = __uint_as_float(w.y << 16); a.w = __uint_as_float(w.y & 0xffff0000u);
    b.x = __uint_as_float(w.z << 16); b.y = __uint_as_float(w.z & 0xffff0000u); b.z = __uint_as_float(w.w << 16); b.w = __uint_as_float(w.w & 0xffff0000u); }
__device__ __forceinline__ f32x4 sig4(f32x4 v) { f32x4 o; o.x = sigmoidf_(v.x); o.y = sigmoidf_(v.y); o.z = sigmoidf_(v.z); o.w = sigmoidf_(v.w); return o; }
struct EpiSplit { char* ws;
    __device__ __forceinline__ void operator()(int row, int col, f32x4 v, int aux) const { store4bf((bf16_t*)(ws + goff_of(col >> 9)) + (size_t)row * 512 + (col & 511), v); }
    struct Prep { int d; }; __device__ __forceinline__ void prep(Prep& p, int col) const { p.d = 0; }
    __device__ __forceinline__ void op8(const Prep&, int row, int col, f32x4 a, f32x4 b, int aux) const { store8bf((bf16_t*)(ws + goff_of(col >> 9)) + (size_t)row * 512 + (col & 511), a, b); } };
struct EpiGates { bf16_t* G; const float* bias;
    __device__ __forceinline__ void operator()(int row, int col, f32x4 v, int aux) const { const f32x4 b = *(const f32x4*)(bias + col); f32x4 o; o.x = sigmoidf_(v.x + b.x); o.y = sigmoidf_(v.y + b.y); o.z = sigmoidf_(v.z + b.z); o.w = sigmoidf_(v.w + b.w);
        store4bf(G + (size_t)row * 4096 + col, o); }
    struct Prep { f32x4 b0, b1; }; __device__ __forceinline__ void prep(Prep& p, int col) const { p.b0 = *(const f32x4*)(bias + col); p.b1 = *(const f32x4*)(bias + col + 4); }
    __device__ __forceinline__ void op8(const Prep& p, int row, int col, f32x4 a, f32x4 b, int aux) const { store8bf(G + (size_t)row * 4096 + col, sig4(a + p.b0), sig4(b + p.b1)); } };
struct EpiOut { struct Prep { int dummy; };
    const bf16_t* G; bf16_t* Mg;
    __device__ __forceinline__ void operator()(int row, int col, f32x4 v, int aux) const { const int br = aux; const f32x4 g = load4bf(G + (size_t)row * 4096 + br * 1024 + col); f32x4 p = (f32x4){0.f, 0.f, 0.f, 0.f};
        if (br) p = load4bf(Mg + (size_t)row * DM + col); store4bf(Mg + (size_t)row * DM + col, p + g * v); }
    __device__ __forceinline__ void prep(Prep& pr, int col0) const { pr.dummy = 0; }
    __device__ __forceinline__ void op8(const Prep&, int row, int col, f32x4 a, f32x4 b, int aux) const { f32x4 g0, g1; load8bf(G + (size_t)row * 4096 + aux * 1024 + col, g0, g1); f32x4 p0 = (f32x4){0.f, 0.f, 0.f, 0.f}, p1 = p0;
        if (aux) load8bf(Mg + (size_t)row * DM + col, p0, p1); store8bf(Mg + (size_t)row * DM + col, p0 + g0 * a, p1 + g1 * b); } };
struct EpiResid { float* x; float scale; int pad;
    __device__ __forceinline__ void operator()(int row, int col, f32x4 v, int aux) const { f32x4* p = (f32x4*)(x + (size_t)row * DM + col); *p = *p + v * scale; }
    struct Prep { int d; }; __device__ __forceinline__ void prep(Prep& p, int col) const { p.d = 0; }
    __device__ __forceinline__ void op8(const Prep&, int row, int col, f32x4 a, f32x4 b, int aux) const { f32x4* p = (f32x4*)(x + (size_t)row * DM + col); const f32x4 x0 = p[0], x1 = p[1]; p[0] = x0 + a * scale; p[1] = x1 + b * scale; } };
struct EpiStore { bf16_t* O; int ldc, pad;
    __device__ __forceinline__ void operator()(int row, int col, f32x4 v, int aux) const { store4bf(O + (size_t)row * ldc + col, v); }
    struct Prep { int d; }; __device__ __forceinline__ void prep(Prep& p, int col) const { p.d = 0; }
    __device__ __forceinline__ void op8(const Prep&, int row, int col, f32x4 a, f32x4 b, int aux) const { store8bf(O + (size_t)row * ldc + col, a, b); } };
struct EpiFfnAct {
    const bf16_t* GP; const float* cw; bf16_t* ACT;
    __device__ __forceinline__ void operator()(int row, int col, f32x4 v, int aux) const {
        const int t = row & (SEQ - 1); const f32x4 z = (f32x4){0.f, 0.f, 0.f, 0.f};
        const f32x4 g2 = load4bf(GP + (size_t)row * DFF + col), g1 = t >= 1 ? load4bf(GP + (size_t)(row - 1) * DFF + col) : z, g0 = t >= 2 ? load4bf(GP + (size_t)(row - 2) * DFF + col) : z;
        const f32x4 w0 = *(const f32x4*)(cw + col), w1 = *(const f32x4*)(cw + DFF + col), w2 = *(const f32x4*)(cw + 2 * DFF + col);
        const f32x4 gt = w0 * g0 + w1 * g1 + w2 * g2; f32x4 o;
        o.x = gt.x * sigmoidf_(gt.x) * v.x; o.y = gt.y * sigmoidf_(gt.y) * v.y; o.z = gt.z * sigmoidf_(gt.z) * v.z; o.w = gt.w * sigmoidf_(gt.w) * v.w;
        store4bf(ACT + (size_t)row * DFF + col, o); }
    struct Prep8 { f32x4 w[3][2]; }; typedef Prep8 Prep;
    __device__ __forceinline__ void prep(Prep8& p, int col) const {
#pragma unroll
        for (int k = 0; k < 3; ++k) { p.w[k][0] = *(const f32x4*)(cw + k * DFF + col); p.w[k][1] = *(const f32x4*)(cw + k * DFF + col + 4); } }
    __device__ __forceinline__ void op8(const Prep8& pw, int row, int col, f32x4 a, f32x4 b, int aux) const {
        const int t = row & (SEQ - 1); const bf16_t* p2 = GP + (size_t)row * DFF + col; const bf16_t* p1 = p2 - (t >= 1 ? DFF : 0); const bf16_t* p0 = p2 - (t >= 2 ? 2 * DFF : 0);
        f32x4 g00, g01, g10, g11, g20, g21; load8bf(p0, g00, g01); load8bf(p1, g10, g11); load8bf(p2, g20, g21);
        const float m0 = t >= 2 ? 1.f : 0.f, m1 = t >= 1 ? 1.f : 0.f;
        const f32x4 t0 = pw.w[0][0] * (g00 * m0) + pw.w[1][0] * (g10 * m1) + pw.w[2][0] * g20, t1 = pw.w[0][1] * (g01 * m0) + pw.w[1][1] * (g11 * m1) + pw.w[2][1] * g21;
        store8bf(ACT + (size_t)row * DFF + col, t0 * sig4(t0) * a, t1 * sig4(t1) * b); } };

template <class Epi> struct GemmArgs { const bf16_t* A; const bf16_t* Bt; int lda, ldb, K, aux; Epi epi; };
template <class Epi>
__global__ __launch_bounds__(256) void k_gemm_simple(GemmArgs<Epi> ga) {
    const bf16_t* A = ga.A; const bf16_t* Bt = ga.Bt; const int lda = ga.lda, ldb = ga.ldb, K = ga.K; const Epi& epi = ga.epi;
    const int lane = threadIdx.x & 63, w = threadIdx.x >> 6, fr = lane & 15, fq = lane >> 4;
    const int row0 = blockIdx.y * 128 + (w >> 1) * 64, col0 = blockIdx.x * 128 + (w & 1) * 64;
    f32x4 acc[4][4];
#pragma unroll
    for (int i = 0; i < 4; ++i)
#pragma unroll
        for (int j = 0; j < 4; ++j) acc[i][j] = (f32x4){0.f, 0.f, 0.f, 0.f};
    const bf16_t* ap = A + (size_t)(row0 + fr) * lda + fq * 8; const bf16_t* bp = Bt + (size_t)(col0 + fr) * ldb + fq * 8;
    for (int k0 = 0; k0 < K; k0 += 32) {
        bf16x8 a[4], b[4];
#pragma unroll
        for (int i = 0; i < 4; ++i) { a[i] = *(const bf16x8*)(ap + (size_t)(i * 16) * lda + k0); b[i] = *(const bf16x8*)(bp + (size_t)(i * 16) * ldb + k0); }
#pragma unroll
        for (int i = 0; i < 4; ++i)
#pragma unroll
            for (int j = 0; j < 4; ++j) acc[i][j] = __builtin_amdgcn_mfma_f32_16x16x32_bf16(b[j], a[i], acc[i][j], 0, 0, 0);
    }
#pragma unroll
    for (int i = 0; i < 4; ++i)
#pragma unroll
        for (int j = 0; j < 4; ++j) epi(row0 + i * 16 + fr, col0 + j * 16 + fq * 4, acc[i][j], ga.aux);
}

__global__ __launch_bounds__(256) void k_prepass(char* ws, const int* positions, const float* g_qa, const float* g_ka, const float* g_kidx) {
    const int m = blockIdx.x, tid = threadIdx.x, w = tid >> 6, lane = tid & 63;
    const float pos = (float)positions[m];
#pragma unroll
    for (int which = 0; which < 2; ++which) {
        bf16_t* p = (bf16_t*)(ws + (which ? WS_KA : WS_QA)) + (size_t)m * 512 + w * 128; const float* g = which ? g_ka : g_qa;
        const float v0 = bf2f(p[lane]), v1 = bf2f(p[lane + 64]);
        const float ss = wave_sum(v0 * v0 + v1 * v1); const float r = rsqrtf(ss * (1.f / 128.f) + EPS);
        float y0 = v0 * r * g[lane]; const float y1 = v1 * r * g[lane + 64];
        const float part = __shfl_xor(y0, 16);
        if (lane < 32) { const int i = lane & 15; const float inv = powf(500000.f, -((float)i * 2.0f) / 32.f); const float ang = pos * inv; const float c = cosf(ang), s = sinf(ang);
            y0 = (lane < 16) ? y0 * c - part * s : y0 * c + part * s; }
        const float sc = which ? 1.f : QSCALE;
        p[lane] = (bf16_t)f2bf(y0 * sc); p[lane + 64] = (bf16_t)f2bf(y1 * sc);
    }
    bf16_t* ix = (bf16_t*)(ws + WS_IDX) + (size_t)m * 512;
    const float wv = bf2f(ix[320 + w]);
    {
        float y = bf2f(ix[w * 64 + lane]); const float part = __shfl_xor(y, 8);
        if (lane < 16) { const int i = lane & 7; const float inv = powf(500000.f, -((float)i * 2.0f) / 16.f); const float ang = pos * inv; const float c = cosf(ang), s = sinf(ang);
            y = (lane < 8) ? y * c - part * s : y * c + part * s; }
        ix[w * 64 + lane] = (bf16_t)f2bf(y * wv * 0.0625f);
    }
    if (w == 0) {
        const float v = bf2f(ix[256 + lane]); const float ss = wave_sum(v * v); const float r = rsqrtf(ss * (1.f / 64.f) + EPS);
        float y = v * r * g_kidx[lane]; const float part = __shfl_xor(y, 8);
        if (lane < 16) { const int i = lane & 7; const float inv = powf(500000.f, -((float)i * 2.0f) / 16.f); const float ang = pos * inv; const float c = cosf(ang), s = sinf(ang);
            y = (lane < 8) ? y * c - part * s : y * c + part * s; }
        ix[256 + lane] = (bf16_t)f2bf(y);
    }
    bf16_t* ga = (bf16_t*)(ws + WS_GLUA) + (size_t)m * 512; const bf16_t* gb = (const bf16_t*)(ws + WS_GLUB) + (size_t)m * 512;
    bf16_t* gc = (bf16_t*)(ws + WS_GC) + (size_t)m * 512; const bf16_t* xc = (const bf16_t*)(ws + WS_XC) + (size_t)m * 512;
    bf16_t* sq = (bf16_t*)(ws + WS_SQ) + (size_t)m * 512;
#pragma unroll
    for (int e = 0; e < 2; ++e) { const int c = tid + e * 256;
        ga[c] = (bf16_t)f2bf(bf2f(ga[c]) * sigmoidf_(bf2f(gb[c])));
        gc[c] = (bf16_t)f2bf(bf2f(gc[c]) * bf2f(xc[c]));
        sq[c] = (bf16_t)f2bf(bf2f(sq[c]) * QSCALE); }
}

__global__ __launch_bounds__(256) void k_conv(char* ws, const float* cbw, const float* cbb, const float* lng, const float* lnb, const float* ccw) {
    const int wave = threadIdx.x >> 6, lane = threadIdx.x & 63; const int m = blockIdx.x * 4 + wave; const int t = m & (SEQ - 1); const int c0 = lane * 8;
    {
        const bf16_t* U = (const bf16_t*)(ws + WS_GLUA); float acc[8];
#pragma unroll
        for (int j = 0; j < 8; ++j) acc[j] = cbb[c0 + j];
        for (int k = 0; k < 31; ++k) { const int tt = t - 30 + k; if (tt < 0) continue;
            const bf16x8 u = *(const bf16x8*)(U + (size_t)(m - 30 + k) * 512 + c0);
#pragma unroll
            for (int j = 0; j < 8; ++j) acc[j] += cbw[k * 512 + c0 + j] * bfs2f(u[j]); }
        float s = 0.f;
#pragma unroll
        for (int j = 0; j < 8; ++j) s += acc[j];
        const float mean = wave_sum(s) * (1.f / 512.f); float q = 0.f;
#pragma unroll
        for (int j = 0; j < 8; ++j) { acc[j] -= mean; q += acc[j] * acc[j]; }
        const float r = rsqrtf(wave_sum(q) * (1.f / 512.f) + EPS); float o[8];
#pragma unroll
        for (int j = 0; j < 8; ++j) { const float y = acc[j] * r * lng[c0 + j] + lnb[c0 + j]; o[j] = y * sigmoidf_(y); }
        u32x4 wv; wv.x = pk2(o[0], o[1]); wv.y = pk2(o[2], o[3]); wv.z = pk2(o[4], o[5]); wv.w = pk2(o[6], o[7]);
        *(u32x4*)((bf16_t*)(ws + WS_GLUB) + (size_t)m * 512 + c0) = wv;
    }
    {
        const bf16_t* X = (const bf16_t*)(ws + WS_GC); float acc[8];
#pragma unroll
        for (int j = 0; j < 8; ++j) acc[j] = 0.f;
        for (int k = 0; k < 3; ++k) { const int tt = t - 2 + k; if (tt < 0) continue;
            const bf16x8 u = *(const bf16x8*)(X + (size_t)(m - 2 + k) * 512 + c0);
#pragma unroll
            for (int j = 0; j < 8; ++j) acc[j] += ccw[k * 512 + c0 + j] * bfs2f(u[j]); }
        const bf16x8 g = *(const bf16x8*)((const bf16_t*)(ws + WS_GB) + (size_t)m * 512 + c0); float o[8];
#pragma unroll
        for (int j = 0; j < 8; ++j) o[j] = acc[j] * bfs2f(g[j]);
        u32x4 wv; wv.x = pk2(o[0], o[1]); wv.y = pk2(o[2], o[3]); wv.z = pk2(o[4], o[5]); wv.w = pk2(o[6], o[7]);
        *(u32x4*)((bf16_t*)(ws + WS_XC) + (size_t)m * 512 + c0) = wv;
    }
}

__device__ __forceinline__ unsigned sortkey(float f) { const unsigned u = __float_as_uint(f); return (u & 0x80000000u) ? ~u : (u | 0x80000000u); }
__global__ __launch_bounds__(256) void k_topk_naive(const char* ws, unsigned* MASK) {
    __shared__ unsigned sc[SEQ]; __shared__ float qf[256]; __shared__ unsigned maskw[256]; __shared__ float wsg[4]; __shared__ unsigned cnt_s;
    const int m = blockIdx.x, b = m >> 13, t = m & (SEQ - 1), tid = threadIdx.x, lane = tid & 63;
    const bf16_t* IX = (const bf16_t*)(ws + WS_IDX);
    qf[tid] = bf2f(IX[(size_t)m * 512 + tid]); maskw[tid] = 0u; if (tid < 4) wsg[tid] = bf2f(IX[(size_t)m * 512 + 320 + tid]);
    __syncthreads();
    const int n = t + 1;
    for (int s = tid; s < n; s += 256) {
        const bf16x8* kp = (const bf16x8*)(IX + (size_t)(b * SEQ + s) * 512 + 256); float x0 = 0.f, x1 = 0.f, x2 = 0.f, x3 = 0.f;
#pragma unroll
        for (int c = 0; c < 8; ++c) { const bf16x8 kk = kp[c];
#pragma unroll
            for (int j = 0; j < 8; ++j) { const float kv = bfs2f(kk[j]); const int d = c * 8 + j; x0 += qf[d] * kv; x1 += qf[64 + d] * kv; x2 += qf[128 + d] * kv; x3 += qf[192 + d] * kv; } }
        float score = (wsg[0] >= 0.f ? fmaxf(x0, 0.f) : fminf(x0, 0.f));
        score += (wsg[1] >= 0.f ? fmaxf(x1, 0.f) : fminf(x1, 0.f));
        score += (wsg[2] >= 0.f ? fmaxf(x2, 0.f) : fminf(x2, 0.f));
        score += (wsg[3] >= 0.f ? fmaxf(x3, 0.f) : fminf(x3, 0.f));
        sc[s] = sortkey(score);
    }
    __syncthreads();
    if (n <= 256) { if (tid < n) atomicOr(&maskw[tid >> 5], 1u << (tid & 31)); }
    else {
        unsigned T = 0u;
        for (int bit = 31; bit >= 0; --bit) {
            const unsigned cand = T | (1u << bit);
            if (tid == 0) cnt_s = 0u;
            __syncthreads();
            unsigned c = 0u; for (int s = tid; s < n; s += 256) c += (sc[s] >= cand) ? 1u : 0u;
            c = wave_sum_u(c); if (lane == 0) atomicAdd(&cnt_s, c);
            __syncthreads();
            if (cnt_s >= 256u) T = cand;
            __syncthreads();
        }
        if (tid == 0) cnt_s = 0u;
        __syncthreads();
        { unsigned c = 0u; for (int s = tid; s < n; s += 256) c += (sc[s] > T) ? 1u : 0u; c = wave_sum_u(c); if (lane == 0) atomicAdd(&cnt_s, c); }
        __syncthreads();
        const int need = 256 - (int)cnt_s;
        for (int s = tid; s < n; s += 256) if (sc[s] > T) atomicOr(&maskw[s >> 5], 1u << (s & 31));
        if (tid < 64) { int taken = 0;
            for (int base = 0; base < n && taken < need; base += 64) { const int s = base + lane; const bool tie = (s < n) && (sc[s] == T);
                const unsigned long long bal = __ballot(tie); const int pre = __popcll(bal & ((1ull << lane) - 1ull));
                if (tie && taken + pre < need) atomicOr(&maskw[s >> 5], 1u << (s & 31));
                taken += __popcll(bal); } }
    }
    __syncthreads();
    MASK[(size_t)m * 256 + tid] = maskw[tid];
}

__device__ __forceinline__ float block_max256(float v, float* red) { v = wave_max(v); __syncthreads(); if ((threadIdx.x & 63) == 0) red[threadIdx.x >> 6] = v; __syncthreads(); return fmaxf(fmaxf(red[0], red[1]), fmaxf(red[2], red[3])); }
__device__ __forceinline__ float block_sum256(float v, float* red) { v = wave_sum(v); __syncthreads(); if ((threadIdx.x & 63) == 0) red[threadIdx.x >> 6] = v; __syncthreads(); return (red[0] + red[1]) + (red[2] + red[3]); }

__global__ __launch_bounds__(256) void k_attnA_naive(char* ws, bf16_t* outbase) {
    __shared__ int sel[256]; __shared__ float q[512]; __shared__ float p[256]; __shared__ float red[4]; __shared__ int pre[256]; __shared__ float osum[256];
    const int m = blockIdx.x, b = m >> 13, tid = threadIdx.x;
    const unsigned* MW = (const unsigned*)(ws + WS_MASK) + (size_t)m * 256; bf16_t* QA = (bf16_t*)(ws + WS_QA) + (size_t)m * 512;
    const bf16_t* KA = (const bf16_t*)(ws + WS_KA); const bf16_t* VA = (const bf16_t*)(ws + WS_VA);
    q[tid] = bf2f(QA[tid]); q[tid + 256] = bf2f(QA[tid + 256]);
    unsigned w = (tid <= ((m & (SEQ - 1)) >> 5)) ? MW[tid] : 0u; const int c = __popc(w); pre[tid] = c; sel[tid] = 0;
    __syncthreads();
    for (int o = 1; o < 256; o <<= 1) { const int v = tid >= o ? pre[tid - o] : 0; __syncthreads(); pre[tid] += v; __syncthreads(); }
    int off = pre[tid] - c; int nsel = pre[255]; if (nsel > 256) nsel = 256;
    while (w) { const int bit = __ffs(w) - 1; w &= w - 1u; if (off < 256) sel[off] = tid * 32 + bit; ++off; }
    __syncthreads();
    for (int h = 0; h < 4; ++h) {
        float l = -INFINITY;
        if (tid < nsel) { const bf16x8* kp = (const bf16x8*)(KA + (size_t)(b * SEQ + sel[tid]) * 512 + h * 128); float a = 0.f;
#pragma unroll
            for (int cc = 0; cc < 16; ++cc) { const bf16x8 kk = kp[cc];
#pragma unroll
                for (int j = 0; j < 8; ++j) a += q[h * 128 + cc * 8 + j] * bfs2f(kk[j]); }
            l = a; }
        const float mx = block_max256(l, red); const float e = tid < nsel ? exp2f(l - mx) : 0.f; const float sum = block_sum256(e, red);
        p[tid] = e; __syncthreads();
        const int d = tid & 127, half = tid >> 7; float o = 0.f; const int j0 = half * 128, j1 = min(nsel, j0 + 128);
        for (int j = j0; j < j1; ++j) o += p[j] * bf2f(VA[vt_index(b * SEQ + sel[j], h, d)]);
        osum[tid] = o; __syncthreads();
        if (tid < 128) outbase[(size_t)m * 512 + h * 128 + tid] = (bf16_t)f2bf((osum[tid] + osum[tid + 128]) / sum);
        __syncthreads();
    }
}

__device__ __forceinline__ float softplus2(float z) { return fmaxf(z, 0.f) + log2f(1.f + exp2f(-fabsf(z))); }
__global__ __launch_bounds__(256) void k_sb_naive(char* ws) {
    __shared__ float q[128]; __shared__ float av[SEQ + 256]; __shared__ float csum[256]; __shared__ float osum[256];
    const int m = blockIdx.x >> 2, h = blockIdx.x & 3, b = m >> 13, t = m & (SEQ - 1), tid = threadIdx.x;
    bf16_t* SQ = (bf16_t*)(ws + WS_SQ) + (size_t)m * 512 + h * 128; const bf16_t* SK = (const bf16_t*)(ws + WS_SK); const bf16_t* SV = (const bf16_t*)(ws + WS_SV);
    if (tid < 128) q[tid] = bf2f(SQ[tid]);
    __syncthreads();
    for (int s = tid; s < t; s += 256) { const bf16x8* kp = (const bf16x8*)(SK + (size_t)(b * SEQ + s) * 512 + h * 128); float a = 0.f;
#pragma unroll
        for (int cc = 0; cc < 16; ++cc) { const bf16x8 kk = kp[cc];
#pragma unroll
            for (int j = 0; j < 8; ++j) a += q[cc * 8 + j] * bfs2f(kk[j]); }
        av[s + (s >> 5)] = a; }
    __syncthreads();
    float tot = 0.f;
    for (int i = 0; i < 32; ++i) { const int s = tid * 32 + i; if (s < t) tot -= softplus2(av[s + (s >> 5)]); }
    csum[tid] = tot; __syncthreads();
    float run = 0.f; for (int j = tid + 1; j < 256; ++j) run += csum[j];
    for (int i = 31; i >= 0; --i) { const int s = tid * 32 + i; const int ix = s + (s >> 5);
        if (s < t) { const float z = av[ix]; const float sp = softplus2(z); av[ix] = exp2f(z - sp + run); run -= sp; } else if (s < SEQ) av[ix] = 0.f; }
    __syncthreads();
    const int d = tid & 127, half = tid >> 7; const int hs = (t + 1) >> 1; const int s0 = half ? hs : 0, s1 = half ? t : hs; float o = 0.f;
    for (int s = s0; s < s1; ++s) o += av[s + (s >> 5)] * bf2f(SV[vt_index(b * SEQ + s, h, d)]);
    osum[tid] = o; __syncthreads();
    if (tid < 128) SQ[tid] = (bf16_t)f2bf(osum[tid] + osum[tid + 128]);
}

#ifndef TS_EPI
#define TS_EPI -1
#endif
__device__ unsigned long long g_dbg[4];
__device__ int g_phase;
namespace pg8 {
#define PG8_LAS __attribute__((address_space(3)))
typedef unsigned short bf16_t;
typedef short bf16x8 __attribute__((ext_vector_type(8)));
typedef float f32x4 __attribute__((ext_vector_type(4)));
typedef unsigned u32x4 __attribute__((ext_vector_type(4)));
constexpr int BM = 256, BK = 64, HALF = 128, HTB = HALF * BK * 2  , STAGE_BYTES = 8 * HTB, NXCD = 8, WGM = 8;

__host__ __device__ __forceinline__ int lds_byte(int r, int c) { const int st = (r >> 4) * 2 + (c >> 5), rr = r & 15, cc = c & 31, ob = rr * 64 + cc * 2; return st * 1024 + (ob ^ (((ob >> 9) & 1) << 5)); }
__host__ __device__ __forceinline__ void stage_rc(int b, int& R, int& C) { const int st = b / 1024, sb = b % 1024, swz = sb ^ (((sb >> 9) & 1) << 5); R = (st >> 1) * 16 + swz / 64; C = (st & 1) * 32 + (swz % 64) / 2; }
__host__ __device__ __forceinline__ int perm32(int rho) { const int n = rho >> 4, i = rho & 15; return 8 * (i >> 2) + 4 * n + (i & 3); }

struct Unit { int pm, pn; };
struct Gemm { const bf16_t* A; const bf16_t* Bt; int M, N, K; };

struct StaticOrder {
    int nM, nN, nwg, G, c;
    __host__ __device__ void init(int M, int N, int G_, int c_) { nM = M / BM; nN = N / BM; nwg = nM * nN; G = G_; c = c_; }
    __host__ __device__ bool next(int i, Unit& u) const {
        const long L = (long)i * G + c; if (L >= nwg) return false;
        int wgid = (int)L; { const int q = nwg / NXCD, r = nwg % NXCD, xcd = wgid % NXCD, off = wgid / NXCD; wgid = (xcd < r ? xcd * (q + 1) : r * (q + 1) + (xcd - r) * q) + off; }
        const int nig = WGM * nN, gid = wgid / nig, fm = gid * WGM, gsz = (nM - fm) < WGM ? (nM - fm) : WGM;
        u.pm = fm + ((wgid % nig) % gsz); u.pn = (wgid % nig) / gsz; return true;
    }
    __device__ __forceinline__ void a_ready(const Unit&) const {}
    __device__ __forceinline__ void done(const Unit&) const {}
};


template <class F, bool BRANCHED> struct EpiFn {
    static constexpr bool PERM = true, AFTER_DRAIN = false;
    F f;
    __device__ __forceinline__ void operator()(const f32x4 (&acc)[2][2][4][2], const Unit& u, int wr, int wc, int fr, int fq) const {
        int pm = u.pm, pn = u.pn, aux = 0;
        if (BRANCHED) { aux = u.pn >> 2; pn = u.pn & 3; pm = u.pm & 63; }
        const int row0 = pm * BM + wr * 64 + fr, col0 = pn * BM + wc * 32 + 8 * fq;
#pragma unroll
        for (int bj = 0; bj < 2; ++bj) {
            typename F::Prep pr; f.prep(pr, col0 + bj * HALF);
#pragma unroll
            for (int ai = 0; ai < 2; ++ai)
#pragma unroll
                for (int m = 0; m < 4; ++m) f.op8(pr, row0 + ai * HALF + m * 16, col0 + bj * HALF, acc[ai][bj][m][0], acc[ai][bj][m][1], aux);
        }
    }
};
struct EpiInProj {
    static constexpr bool PERM = true, AFTER_DRAIN = false;
    char* ws; PG8_LAS unsigned char* lds; const float* g_qa; const float* g_ka; const float* g_kidx;
    __device__ __forceinline__ void operator()(const f32x4 (&acc)[2][2][4][2], const Unit& u, int wr, int wc, int fr_, int fq_) const {
        int fr = fr_, fq = fq_; asm volatile("" : "+v"(fr), "+v"(fq));
        const int pn = u.pn, row0 = u.pm * BM + wr * 64 + fr, cw = wc * 32 + 8 * fq;
        const float* rope = (const float*)(ws + WS_ROPE);
        if ((pn >= 8 && pn < 12) || (pn >= 14 && pn < 18)) {
            const bool glu = pn < 12; bf16_t* dst = (bf16_t*)(ws + (glu ? WS_GLUA : WS_GC)) + (glu ? pn - 8 : pn - 14) * 128 + cw;
#pragma unroll
            for (int ai = 0; ai < 2; ++ai)
#pragma unroll
                for (int m = 0; m < 4; ++m) { const int row = row0 + ai * HALF + m * 16;
                    const f32x4 a0 = acc[ai][0][m][0], a1 = acc[ai][0][m][1], b0 = acc[ai][1][m][0], b1 = acc[ai][1][m][1];
                    if (glu) store8bf(dst + (size_t)row * 512, a0 * sig4(b0), a1 * sig4(b1)); else store8bf(dst + (size_t)row * 512, a0 * b0, a1 * b1); }
        } else if (pn < 4) {
            const bool isq = pn < 2; const float* gain = isq ? g_qa : g_ka; const float osc = isq ? QSCALE : 1.f;
            const f32x4 gA = *(const f32x4*)(gain + cw), gB = *(const f32x4*)(gain + cw + 4);
            PG8_LAS float* P = (PG8_LAS float*)(lds + 131072);
#pragma unroll
            for (int ai = 0; ai < 2; ++ai)
#pragma unroll
                for (int m = 0; m < 4; ++m)
#pragma unroll
                    for (int bj = 0; bj < 2; ++bj) { const f32x4 a = acc[ai][bj][m][0], b = acc[ai][bj][m][1];
                        float ss = (a.x * a.x + a.y * a.y) + (a.z * a.z + a.w * a.w) + (b.x * b.x + b.y * b.y) + (b.z * b.z + b.w * b.w);
                        ss += __shfl_xor(ss, 16); ss += __shfl_xor(ss, 32);
                        if (fq == 0) P[((ai * HALF + wr * 64 + m * 16 + fr) * 2 + bj) * 4 + wc] = ss; }
            asm volatile("s_waitcnt lgkmcnt(0)" ::: "memory"); __builtin_amdgcn_s_barrier(); asm volatile("" ::: "memory");
            bf16_t* dst = (bf16_t*)(ws + (isq ? WS_QA : WS_KA)) + (pn & 1) * 256 + cw;
            const float sg = (fq < 2) ? -1.f : 1.f;
#pragma unroll
            for (int ai = 0; ai < 2; ++ai)
#pragma unroll
                for (int m = 0; m < 4; ++m) { const int rl = ai * HALF + wr * 64 + m * 16 + fr, row = u.pm * BM + rl;
                    const float* rt = rope + (size_t)row * 48 + 8 * (fq & 1);
#pragma unroll
                    for (int bj = 0; bj < 2; ++bj) { const f32x4 p4 = *(const PG8_LAS f32x4*)(P + (rl * 2 + bj) * 4);
                        const float r = rsqrtf(((p4.x + p4.y) + (p4.z + p4.w)) * (1.f / 128.f) + EPS);
                        f32x4 yy[2];
#pragma unroll
                        for (int hh = 0; hh < 2; ++hh) {
                            f32x4 y = acc[ai][bj][m][hh] * r * (hh ? gB : gA);
                            if (wc == 0) {
                                const f32x4 c = *(const f32x4*)(rt + 4 * hh), sn = *(const f32x4*)(rt + 16 + 4 * hh);
                                f32x4 q; q.x = __shfl_xor(y.x, 32); q.y = __shfl_xor(y.y, 32); q.z = __shfl_xor(y.z, 32); q.w = __shfl_xor(y.w, 32);
                                y = y * c + q * sn * sg; }
                            yy[hh] = y * osc; }
                        store8bf(dst + (size_t)row * 512 + bj * HALF, yy[0], yy[1]); }
                    asm volatile("" ::: "memory"); }
        } else if (pn == 6) {
            bf16_t* dst = (bf16_t*)(ws + WS_IDX) + cw;
#pragma unroll
            for (int ai = 0; ai < 2; ++ai)
#pragma unroll
                for (int m = 0; m < 4; ++m) { const int row = row0 + ai * HALF + m * 16;
                    f32x4 c0 = (f32x4){1.f, 1.f, 1.f, 1.f}, c1 = c0, s0 = (f32x4){0.f, 0.f, 0.f, 0.f}, s1 = s0;
                    if ((wc & 1) == 0) { const float* rt = rope + (size_t)row * 48 + 32; c0 = *(const f32x4*)rt; c1 = *(const f32x4*)(rt + 4); s0 = *(const f32x4*)(rt + 8); s1 = *(const f32x4*)(rt + 12); }
#pragma unroll
                    for (int bj = 0; bj < 2; ++bj) { f32x4 y0 = acc[ai][bj][m][0], y1 = acc[ai][bj][m][1];
                        if ((wc & 1) == 0) {
                            f32x4 q0, q1; q0.x = __shfl_xor(y0.x, 16); q0.y = __shfl_xor(y0.y, 16); q0.z = __shfl_xor(y0.z, 16); q0.w = __shfl_xor(y0.w, 16);
                            q1.x = __shfl_xor(y1.x, 16); q1.y = __shfl_xor(y1.y, 16); q1.z = __shfl_xor(y1.z, 16); q1.w = __shfl_xor(y1.w, 16);
                            if (fq < 2) { const float sg = (fq == 0) ? -1.f : 1.f; y0 = y0 * c0 + q0 * s0 * sg; y1 = y1 * c1 + q1 * s1 * sg; } }
                        store8bf(dst + (size_t)row * 512 + bj * HALF, y0, y1); }
                    asm volatile("" ::: "memory"); __builtin_amdgcn_sched_barrier(0); }
        } else if (pn == 7) {
            PG8_LAS float* P = (PG8_LAS float*)(lds + 131072);
#pragma unroll
            for (int ai = 0; ai < 2; ++ai)
#pragma unroll
                for (int m = 0; m < 4; ++m) { const f32x4 a = acc[ai][0][m][0], b = acc[ai][0][m][1];
                    float ss = (a.x * a.x + a.y * a.y) + (a.z * a.z + a.w * a.w) + (b.x * b.x + b.y * b.y) + (b.z * b.z + b.w * b.w);
                    ss += __shfl_xor(ss, 16); ss += __shfl_xor(ss, 32);
                    if (fq == 0 && wc < 2) P[(ai * HALF + wr * 64 + m * 16 + fr) * 2 + wc] = ss; }
            asm volatile("s_waitcnt lgkmcnt(0)" ::: "memory"); __builtin_amdgcn_s_barrier(); asm volatile("" ::: "memory");
            bf16_t* dst = (bf16_t*)(ws + WS_IDX) + 256 + cw;
            const f32x4 gA = (wc < 2) ? *(const f32x4*)(g_kidx + cw) : (f32x4){1.f, 1.f, 1.f, 1.f}, gB = (wc < 2) ? *(const f32x4*)(g_kidx + cw + 4) : (f32x4){1.f, 1.f, 1.f, 1.f};
#pragma unroll
            for (int ai = 0; ai < 2; ++ai)
#pragma unroll
                for (int m = 0; m < 4; ++m) { const int rl = ai * HALF + wr * 64 + m * 16 + fr, row = u.pm * BM + rl;
                    f32x4 y0 = acc[ai][0][m][0], y1 = acc[ai][0][m][1];
                    if (wc < 2) { const float r = rsqrtf((P[rl * 2] + P[rl * 2 + 1]) * (1.f / 64.f) + EPS); y0 = y0 * r * gA; y1 = y1 * r * gB; }
                    if (wc == 0) { const float* rt = rope + (size_t)row * 48 + 32; const f32x4 c0 = *(const f32x4*)rt, c1 = *(const f32x4*)(rt + 4), s0 = *(const f32x4*)(rt + 8), s1 = *(const f32x4*)(rt + 12);
                        f32x4 q0, q1; q0.x = __shfl_xor(y0.x, 16); q0.y = __shfl_xor(y0.y, 16); q0.z = __shfl_xor(y0.z, 16); q0.w = __shfl_xor(y0.w, 16);
                        q1.x = __shfl_xor(y1.x, 16); q1.y = __shfl_xor(y1.y, 16); q1.z = __shfl_xor(y1.z, 16); q1.w = __shfl_xor(y1.w, 16);
                        if (fq < 2) { const float sg = (fq == 0) ? -1.f : 1.f; y0 = y0 * c0 + q0 * s0 * sg; y1 = y1 * c1 + q1 * s1 * sg; } }
                    store8bf(dst + (size_t)row * 512, y0, y1);
                    if (wc < 2) store8bf((bf16_t*)(ws + WS_KIF) + (((size_t)(row >> 5) * 4 + 2 * wc + (fq >> 1)) * 64 + (row & 31) + 32 * (fq & 1)) * 8, y0, y1);
                    store8bf(dst + (size_t)row * 512 + HALF, acc[ai][1][m][0], acc[ai][1][m][1]);
                    asm volatile("" ::: "memory"); __builtin_amdgcn_sched_barrier(0); }
        } else {
            const size_t off = pn < 6 ? WS_VA : pn < 14 ? WS_GB : pn < 20 ? WS_SQ : pn < 22 ? WS_SK : WS_SV;
            const float sc = (pn == 18 || pn == 19) ? QSCALE : 1.f;
            bf16_t* dst = (bf16_t*)(ws + off) + (pn & 1) * 256 + cw;
#pragma unroll
            for (int ai = 0; ai < 2; ++ai)
#pragma unroll
                for (int m = 0; m < 4; ++m)
#pragma unroll
                    for (int bj = 0; bj < 2; ++bj) store8bf(dst + (size_t)(row0 + ai * HALF + m * 16) * 512 + bj * HALF, acc[ai][bj][m][0] * sc, acc[ai][bj][m][1] * sc);
        }
    }
};
struct BranchOrder {
    StaticOrder S;
    __device__ void init(int G_, int c_) { S.init(16384, 1024, G_, c_); }
    __device__ bool next(int i, Unit& u) const { Unit t; if (!S.next(i >> 2, t)) return false; const int br = i & 3; u.pm = br * 64 + t.pm; u.pn = br * 4 + t.pn; return true; }
    __device__ __forceinline__ void a_ready(const Unit&) const {}
    __device__ __forceinline__ void done(const Unit&) const {}
};

template <class Epi, class Sched, bool ALIGN_EPI = false, bool SP2 = false>
__device__ __forceinline__ void gemm_phase(PG8_LAS unsigned char* lds, const Gemm g, const Sched& S, const Epi& E) {
    const int tid = threadIdx.x, wid = __builtin_amdgcn_readfirstlane(tid >> 6), lane = tid & 63, wr = wid >> 2, wc = wid & 3, fr = lane & 15, fq = lane >> 4;
    const int K = g.K, nt = K / BK;
    unsigned voffA[2], voffB[2];
#pragma unroll
    for (int i = 0; i < 2; ++i) { int R, C; stage_rc(tid * 16 + i * 8192, R, C); const int Rb = Epi::PERM ? ((R & ~31) + perm32(R & 31)) : R;
        voffA[i] = (unsigned)(R * K + C) * 2u; voffB[i] = (unsigned)(Rb * K + C) * 2u; }
    const size_t kstep = (size_t)(BK * 2);
    const size_t hstep = (size_t)HALF * K * 2;
    const size_t tstep = 2 * hstep;
    const unsigned ldsw = (unsigned)wid * 1024u;
    const int aoff = lds_byte(wr * 64 + fr, fq * 8), boff = lds_byte(wc * 32 + fr, fq * 8);
#define PG8_SA(b, h) (((b) * 2 + (h)) * HTB)
#define PG8_SB(b, h) ((4 + (b) * 2 + (h)) * HTB)
#define PG8_STAGE(bufoff, gbase, voff) do { _Pragma("unroll") for (int _i = 0; _i < 2; ++_i) \
        __builtin_amdgcn_global_load_lds((const unsigned*)((const char*)(gbase) + (voff)[_i]), (PG8_LAS unsigned*)(lds + (bufoff) + ldsw + _i * 8192), 16, 0, 0); } while (0)
#define PG8_LDA(dst, b, h) do { _Pragma("unroll") for (int m = 0; m < 4; ++m) _Pragma("unroll") for (int k = 0; k < 2; ++k) dst[m][k] = *(const PG8_LAS bf16x8*)(lds + PG8_SA(b, h) + aoff + m * 2048 + k * 1024); } while (0)
#define PG8_LDB(dst, b, h) do { _Pragma("unroll") for (int n = 0; n < 2; ++n) _Pragma("unroll") for (int k = 0; k < 2; ++k) dst[n][k] = *(const PG8_LAS bf16x8*)(lds + PG8_SB(b, h) + boff + n * 2048 + k * 1024); } while (0)
#define PG8_MMA(ai, bj, At, Bt) do { __builtin_amdgcn_s_setprio(1); _Pragma("unroll") for (int m = 0; m < 4; ++m) _Pragma("unroll") for (int n = 0; n < 2; ++n) _Pragma("unroll") for (int k = 0; k < 2; ++k) \
        acc[ai][bj][m][n] = __builtin_amdgcn_mfma_f32_16x16x32_bf16(Bt[n][k], At[m][k], acc[ai][bj][m][n], 0, 0, 0); __builtin_amdgcn_s_setprio(0); } while (0)
#define PG8_WAIT_V(n) asm volatile("s_waitcnt vmcnt(" #n ")" ::: "memory")
#define PG8_WAIT_L(n) asm volatile("s_waitcnt lgkmcnt(" #n ")" ::: "memory")
#define PG8_BAR __builtin_amdgcn_s_barrier()
#define PG8_SCHED __builtin_amdgcn_sched_barrier(0)
    Unit cur, nxt; int ui = 0;
    if (!S.next(0, cur)) return;
    f32x4 acc[2][2][4][2];
#pragma unroll
    for (int a = 0; a < 2; ++a)
#pragma unroll
        for (int b = 0; b < 2; ++b)
#pragma unroll
            for (int m = 0; m < 4; ++m)
#pragma unroll
                for (int n = 0; n < 2; ++n) acc[a][b][m][n] = (f32x4){0.f, 0.f, 0.f, 0.f};
    bf16x8 At[4][2], B0[2][2], B1[2][2];
    const char* cA = (const char*)g.A + (size_t)cur.pm * tstep; const char* cB = (const char*)g.Bt + (size_t)cur.pn * tstep;
    S.a_ready(cur);
    if constexpr (SP2) {
        PG8_STAGE(PG8_SB(0, 0), cB, voffB); PG8_STAGE(PG8_SB(0, 1), cB + hstep, voffB); PG8_STAGE(PG8_SA(0, 0), cA, voffA); PG8_STAGE(PG8_SA(0, 1), cA + hstep, voffA);
        if (wr == 1) PG8_BAR;
        PG8_WAIT_V(2); PG8_BAR;
        PG8_STAGE(PG8_SB(1, 0), cB + kstep, voffB); PG8_STAGE(PG8_SA(1, 0), cA + kstep, voffA); PG8_STAGE(PG8_SB(1, 1), cB + hstep + kstep, voffB);
        PG8_WAIT_V(6); PG8_BAR;
    } else {
        PG8_STAGE(PG8_SB(0, 0), cB, voffB); PG8_STAGE(PG8_SA(0, 0), cA, voffA); PG8_STAGE(PG8_SB(0, 1), cB + hstep, voffB); PG8_STAGE(PG8_SA(0, 1), cA + hstep, voffA);
        if (wr == 1) PG8_BAR;
        PG8_WAIT_V(4); PG8_BAR;
        PG8_STAGE(PG8_SB(1, 0), cB + kstep, voffB); PG8_STAGE(PG8_SA(1, 0), cA + kstep, voffA); PG8_STAGE(PG8_SB(1, 1), cB + hstep + kstep, voffB);
        PG8_WAIT_V(6); PG8_BAR;
    }
    for (;;) {
        const bool has_next = S.next(ui + 1, nxt);
        const char* nA = has_next ? (const char*)g.A + (size_t)nxt.pm * tstep : cA; const char* nB = has_next ? (const char*)g.Bt + (size_t)nxt.pn * tstep : cB;
        for (int t = 0; t < nt; t += 2) {
            const bool last = (t == nt - 2);
            const char* a1 = cA + (size_t)(t + 1) * kstep;
            const char* a2 = last ? nA : cA + (size_t)(t + 2) * kstep; const char* b2 = last ? nB : cB + (size_t)(t + 2) * kstep;
            const char* a3 = a2 + kstep; const char* b3 = b2 + kstep;
            if (last && has_next) S.a_ready(nxt);
            if constexpr (SP2) {
            PG8_LDB(B0, 0, 0); PG8_LDB(B1, 0, 1); PG8_SCHED; PG8_LDA(At, 0, 0); PG8_STAGE(PG8_SA(1, 1), a1 + hstep, voffA);
            PG8_WAIT_V(8); PG8_WAIT_L(0); PG8_BAR; PG8_MMA(0, 0, At, B0); PG8_MMA(0, 1, At, B1); PG8_BAR; PG8_SCHED;
            PG8_LDA(At, 0, 1); PG8_STAGE(PG8_SB(0, 0), b2, voffB); PG8_STAGE(PG8_SB(0, 1), b2 + hstep, voffB); PG8_STAGE(PG8_SA(0, 0), a2, voffA);
            PG8_WAIT_V(8); PG8_WAIT_L(0); PG8_BAR; PG8_MMA(1, 0, At, B0); PG8_MMA(1, 1, At, B1); PG8_BAR; PG8_SCHED;
            PG8_LDB(B0, 1, 0); PG8_LDB(B1, 1, 1); PG8_SCHED; PG8_LDA(At, 1, 0); PG8_STAGE(PG8_SA(0, 1), a2 + hstep, voffA);
            PG8_WAIT_V(8); PG8_WAIT_L(0); PG8_BAR; PG8_MMA(0, 0, At, B0); PG8_MMA(0, 1, At, B1); PG8_BAR; PG8_SCHED;
            PG8_LDA(At, 1, 1); PG8_STAGE(PG8_SB(1, 0), b3, voffB); PG8_STAGE(PG8_SB(1, 1), b3 + hstep, voffB); PG8_STAGE(PG8_SA(1, 0), a3, voffA);
            PG8_WAIT_V(8); PG8_WAIT_L(0); PG8_BAR; PG8_MMA(1, 0, At, B0); PG8_MMA(1, 1, At, B1); PG8_BAR; PG8_SCHED;
            } else {
            PG8_LDB(B0, 0, 0); PG8_SCHED; PG8_LDA(At, 0, 0); PG8_STAGE(PG8_SA(1, 1), a1 + hstep, voffA);
            PG8_WAIT_L(8); PG8_BAR; PG8_WAIT_L(0); PG8_MMA(0, 0, At, B0); PG8_BAR; PG8_SCHED;
            PG8_LDB(B1, 0, 1); PG8_STAGE(PG8_SB(0, 0), b2, voffB);
            PG8_BAR; PG8_WAIT_L(0); PG8_MMA(0, 1, At, B1); PG8_BAR;
            PG8_LDA(At, 0, 1); PG8_STAGE(PG8_SA(0, 0), a2, voffA);
            PG8_BAR; PG8_WAIT_L(0); PG8_MMA(1, 0, At, B0); PG8_BAR; PG8_SCHED;
            PG8_STAGE(PG8_SB(0, 1), b2 + hstep, voffB);
            PG8_WAIT_V(6); PG8_BAR; PG8_MMA(1, 1, At, B1); PG8_BAR;
            PG8_LDB(B0, 1, 0); PG8_SCHED; PG8_LDA(At, 1, 0); PG8_STAGE(PG8_SA(0, 1), a2 + hstep, voffA);
            PG8_WAIT_L(8); PG8_BAR; PG8_WAIT_L(0); PG8_MMA(0, 0, At, B0); PG8_BAR; PG8_SCHED;
            PG8_LDB(B1, 1, 1); PG8_STAGE(PG8_SB(1, 0), b3, voffB);
            PG8_BAR; PG8_WAIT_L(0); PG8_MMA(0, 1, At, B1); PG8_BAR;
            PG8_LDA(At, 1, 1); PG8_STAGE(PG8_SA(1, 0), a3, voffA);
            PG8_BAR; PG8_WAIT_L(0); PG8_MMA(1, 0, At, B0); PG8_BAR; PG8_SCHED;
            PG8_STAGE(PG8_SB(1, 1), b3 + hstep, voffB);
            PG8_WAIT_V(6); PG8_BAR; PG8_MMA(1, 1, At, B1); PG8_BAR;
            }
        }
        if constexpr (ALIGN_EPI) { if (wr == 0) PG8_BAR; }
        if constexpr (!Epi::AFTER_DRAIN) {
#if TS_EPI >= 0
            unsigned long long te0 = 0ull; const bool stamp = (blockIdx.x == 0 && threadIdx.x == 0 && g_phase == TS_EPI); if (stamp) te0 = __builtin_amdgcn_s_memrealtime();
#endif
            E(acc, cur, wr, wc, fr, fq); S.done(cur);
#if TS_EPI >= 0
            if (stamp) { asm volatile("s_waitcnt vmcnt(0)" ::: "memory"); g_dbg[0] += __builtin_amdgcn_s_memrealtime() - te0; g_dbg[1] += 1ull; }
#endif
        }
        if (!has_next) break;
#pragma unroll
        for (int a = 0; a < 2; ++a)
#pragma unroll
            for (int b = 0; b < 2; ++b)
#pragma unroll
                for (int m = 0; m < 4; ++m)
#pragma unroll
                    for (int n = 0; n < 2; ++n) acc[a][b][m][n] = (f32x4){0.f, 0.f, 0.f, 0.f};
        cur = nxt; cA = nA; cB = nB; ++ui;
        if constexpr (ALIGN_EPI) { if (wr == 1) PG8_BAR; }
    }
    PG8_WAIT_V(0);
    if constexpr (!ALIGN_EPI) { if (wr == 0) PG8_BAR; }
    PG8_BAR;
    if constexpr (Epi::AFTER_DRAIN) { E.fused(acc, cur, wr, wc, fr, fq, lds, wid, lane); S.done(cur); }
#undef PG8_SA
#undef PG8_SB
#undef PG8_STAGE
#undef PG8_LDA
#undef PG8_LDB
#undef PG8_MMA
#undef PG8_WAIT_V
#undef PG8_WAIT_L
#undef PG8_BAR
#undef PG8_SCHED
}
}

#define LAS __attribute__((address_space(3)))
typedef float f32x16 __attribute__((ext_vector_type(16)));
typedef float f32x2_t __attribute__((ext_vector_type(2)));
typedef __bf16 bf16x2_t __attribute__((ext_vector_type(2)));
#define MFMA32(a, b, c) __builtin_amdgcn_mfma_f32_32x32x16_bf16((a), (b), (c), 0, 0, 0)
__device__ __forceinline__ unsigned cvtpk(float lo, float hi) { f32x2_t v = {lo, hi}; bf16x2_t b = __builtin_convertvector(v, bf16x2_t); return __builtin_bit_cast(unsigned, b); }
__device__ __forceinline__ int kappa(int i) { return (i & ~12) | ((i & 4) << 1) | ((i & 8) >> 1); }
#define PACK8(P, S) __builtin_bit_cast(bf16x8, (u32x4){cvtpk(P[8 * (S) + 0], P[8 * (S) + 1]), cvtpk(P[8 * (S) + 2], P[8 * (S) + 3]), cvtpk(P[8 * (S) + 4], P[8 * (S) + 5]), cvtpk(P[8 * (S) + 6], P[8 * (S) + 7])})

__device__ __forceinline__ void load_kfrag(bf16x8 (&kf)[8], const bf16_t* K, int rowbase, int kb, int h, int r32, int hi) {
    const bf16_t* p = K + (size_t)(rowbase + kb * 32 + kappa(r32)) * 512 + h * 128 + 8 * hi;
#pragma unroll
    for (int s = 0; s < 8; ++s) kf[s] = *(const bf16x8*)(p + 16 * s);
}
__device__ __forceinline__ void load_vfrag(bf16x8 (&vf)[4][2], const bf16_t* VT, int rowbase, int kb, int h, int r32, int hi) {
    const int blk64 = (rowbase + kb * 32) >> 6;
    const bf16_t* p = VT + ((size_t)(blk64 * 4 + h) * 128 + r32) * 64 + (kb & 1) * 32 + 8 * hi;
#pragma unroll
    for (int db = 0; db < 4; ++db) { vf[db][0] = *(const bf16x8*)(p + (size_t)db * 32 * 64); vf[db][1] = *(const bf16x8*)(p + (size_t)db * 32 * 64 + 16); }
}
__device__ __forceinline__ void sb_item(char* ws, bf16_t* Ob, int b, int h, int qb, int lane) {
    const int r32 = lane & 31, hi = lane >> 5, rowbase = b * SEQ, q0 = qb * 32;
    bf16_t* Q = (bf16_t*)(ws + WS_SQ); const bf16_t* K = (const bf16_t*)(ws + WS_SK); const bf16_t* VT = (const bf16_t*)(ws + WS_SV);
    bf16x8 qf[8];
    { const bf16_t* qp = Q + (size_t)(rowbase + q0 + r32) * 512 + h * 128 + 8 * hi;
#pragma unroll
      for (int s = 0; s < 8; ++s) qf[s] = *(const bf16x8*)(qp + 16 * s); }
    f32x16 o[4];
#pragma unroll
    for (int db = 0; db < 4; ++db)
#pragma unroll
        for (int r = 0; r < 16; ++r) o[db][r] = 0.f;
    float carry = 1.f;
    for (int kb = qb; kb >= 0; --kb) {
        bf16x8 kf[8]; load_kfrag(kf, K, rowbase, kb, h, r32, hi);
        bf16x8 vf[4][2]; load_vfrag(vf, VT, rowbase, kb, h, r32, hi);
        f32x16 p;
#pragma unroll
        for (int r = 0; r < 16; ++r) p[r] = 0.f;
#pragma unroll
        for (int s = 0; s < 8; ++s) p = MFMA32(kf[s], qf[s], p);
        const bool diag = (kb == qb);
        float kp[16];
#pragma unroll
        for (int r = 0; r < 16; ++r) {
            const float e = __builtin_amdgcn_exp2f(fminf(p[r], 80.f)); const float rinv = __builtin_amdgcn_rcpf(1.f + e);
            const bool valid = !diag || (((r & 7) + 8 * hi + 16 * (r >> 3)) < r32);
            kp[r] = valid ? rinv : 1.f; p[r] = valid ? e * rinv : 0.f;
        }
        float ex1 = 1.f, ex0 = 1.f;
#pragma unroll
        for (int r = 15; r >= 8; --r) { p[r] *= ex1; ex1 *= kp[r]; }
#pragma unroll
        for (int r = 7; r >= 0; --r) { p[r] *= ex0; ex0 *= kp[r]; }
        const float oT1 = __shfl_xor(ex1, 32), oT0 = __shfl_xor(ex0, 32);
        const float T11 = hi ? ex1 : oT1, T01 = hi ? oT1 : ex1, T10 = hi ? ex0 : oT0, T00 = hi ? oT0 : ex0;
        const float c1 = carry * T11, c2 = c1 * T01, c3 = c2 * T10;
        const float off1 = hi ? carry : c1, off0 = hi ? c2 : c3;
#pragma unroll
        for (int r = 8; r < 16; ++r) p[r] *= off1;
#pragma unroll
        for (int r = 0; r < 8; ++r) p[r] *= off0;
        carry = c3 * T00;
        const bf16x8 pb0 = PACK8(p, 0), pb1 = PACK8(p, 1);
#pragma unroll
        for (int db = 0; db < 4; ++db) { o[db] = MFMA32(vf[db][0], pb0, o[db]); o[db] = MFMA32(vf[db][1], pb1, o[db]); }
        if (__all(carry < 1e-12f)) break;
    }
    bf16_t* orow = Ob + (size_t)(rowbase + q0 + r32) * 512 + h * 128;
#pragma unroll
    for (int db = 0; db < 4; ++db)
#pragma unroll
        for (int g = 0; g < 4; ++g) { u32x2 w; w.x = cvtpk(o[db][4 * g], o[db][4 * g + 1]); w.y = cvtpk(o[db][4 * g + 2], o[db][4 * g + 3]); *(u32x2*)(orow + db * 32 + 8 * g + 4 * hi) = w; }
}
__device__ __forceinline__ void attnA_unit(LAS unsigned char* lds, char* ws, bf16_t* Ob, int b, int h, int qblk, float negC) {
    constexpr int KP = 272, VP = 144, KBYTES = 64 * KP, BUF = KBYTES + 128 * VP;
    const int tid = threadIdx.x, lane = tid & 63, wave = __builtin_amdgcn_readfirstlane(tid >> 6), r32 = lane & 31, hi = lane >> 5, rowbase = b * SEQ;
    const int qsub = wave & 3, kpar = wave >> 2, qb = qblk * 4 + qsub, q0 = qb * 32, ntiles = 2 * qblk + 2;
    const bf16_t* Q = (const bf16_t*)(ws + WS_QA); const bf16_t* Kg = (const bf16_t*)(ws + WS_KA) + (size_t)rowbase * 512 + h * 128;
    const bf16_t* Vg = (const bf16_t*)(ws + WS_VA) + ((size_t)(rowbase >> 6) * 4 + h) * 8192;
    const unsigned* mrow = (const unsigned*)(ws + WS_MASK) + (size_t)(rowbase + q0 + r32) * 256;
    const int kr0 = tid >> 4, kc = tid & 15, vd0 = tid >> 3, vc = tid & 7;
    const bf16_t* kg0 = Kg + (size_t)kr0 * 512 + kc * 8; const bf16_t* vg0 = Vg + (size_t)vd0 * 64 + vc * 8;
    const int klds0 = kr0 * KP + kc * 16, vlds0 = KBYTES + vd0 * VP + vc * 16;
    bf16x8 qf[8];
    { const bf16_t* qp = Q + (size_t)(rowbase + q0 + r32) * 512 + h * 128 + 8 * hi;
#pragma unroll
      for (int s = 0; s < 8; ++s) qf[s] = *(const bf16x8*)(qp + 16 * s); }
    u32x4 sk0 = *(const u32x4*)(kg0), sk1 = *(const u32x4*)(kg0 + (size_t)32 * 512), sv0 = *(const u32x4*)(vg0), sv1 = *(const u32x4*)(vg0 + 64 * 64);
    *(LAS u32x4*)(lds + klds0) = sk0; *(LAS u32x4*)(lds + klds0 + 32 * KP) = sk1; *(LAS u32x4*)(lds + vlds0) = sv0; *(LAS u32x4*)(lds + vlds0 + 64 * VP) = sv1;
    { const bf16_t* kg = kg0 + (size_t)64 * 512; const bf16_t* vg = vg0 + (size_t)4 * 8192;
      sk0 = *(const u32x4*)(kg); sk1 = *(const u32x4*)(kg + (size_t)32 * 512); sv0 = *(const u32x4*)(vg); sv1 = *(const u32x4*)(vg + 64 * 64); }
    unsigned mw = (kpar <= qb) ? mrow[kpar] : 0u;
    f32x16 o[4];
#pragma unroll
    for (int db = 0; db < 4; ++db)
#pragma unroll
        for (int r = 0; r < 16; ++r) o[db][r] = 0.f;
    float l = 0.f;
    const int kfo = (32 * kpar + kappa(r32)) * KP + 16 * hi, vfo = KBYTES + r32 * VP + kpar * 64 + 16 * hi;
    __syncthreads();
    for (int kt = 0; kt < ntiles; ++kt) {
        const bool more = kt + 1 < ntiles; unsigned mwn = 0u;
        if (more) { LAS unsigned char* nb = lds + ((kt + 1) & 1) * BUF;
            *(LAS u32x4*)(nb + klds0) = sk0; *(LAS u32x4*)(nb + klds0 + 32 * KP) = sk1; *(LAS u32x4*)(nb + vlds0) = sv0; *(LAS u32x4*)(nb + vlds0 + 64 * VP) = sv1;
            const int kbn = 2 * (kt + 1) + kpar; if (kbn <= qb) mwn = mrow[kbn]; }
        if (kt + 2 < ntiles) { const bf16_t* kg = kg0 + (size_t)(kt + 2) * 64 * 512; const bf16_t* vg = vg0 + (size_t)(kt + 2) * 4 * 8192;
            sk0 = *(const u32x4*)(kg); sk1 = *(const u32x4*)(kg + (size_t)32 * 512); sv0 = *(const u32x4*)(vg); sv1 = *(const u32x4*)(vg + 64 * 64); }
        const int kb = 2 * kt + kpar;
        if (kb <= qb) {
            const LAS unsigned char* buf = lds + (kt & 1) * BUF;
            bf16x8 kf[8];
#pragma unroll
            for (int s = 0; s < 8; ++s) kf[s] = *(const LAS bf16x8*)(buf + kfo + 32 * s);
            f32x16 p;
#pragma unroll
            for (int r = 0; r < 16; ++r) p[r] = negC;
#pragma unroll
            for (int s = 0; s < 8; ++s) p = MFMA32(kf[s], qf[s], p);
            bf16x8 vf[4][2];
#pragma unroll
            for (int db = 0; db < 4; ++db) { vf[db][0] = *(const LAS bf16x8*)(buf + vfo + db * 32 * VP); vf[db][1] = *(const LAS bf16x8*)(buf + vfo + db * 32 * VP + 32); }
            const unsigned wsh = mw >> (8 * hi);
#pragma unroll
            for (int r = 0; r < 16; ++r) {
                const int pos = (r & 7) + 16 * (r >> 3); const int m = ((int)(wsh << (31 - pos))) >> 31;
                const float e = __int_as_float(__float_as_int(__builtin_amdgcn_exp2f(p[r])) & m); p[r] = e; l += e;
            }
            const bf16x8 pb0 = PACK8(p, 0), pb1 = PACK8(p, 1);
#pragma unroll
            for (int db = 0; db < 4; ++db) { o[db] = MFMA32(vf[db][0], pb0, o[db]); o[db] = MFMA32(vf[db][1], pb1, o[db]); }
        }
        mw = mwn;
        __syncthreads();
    }
    LAS float* part = (LAS float*)lds; LAS float* lp = part + 4 * 64 * 64;
    if (kpar == 1) {
#pragma unroll
        for (int db = 0; db < 4; ++db)
#pragma unroll
            for (int r = 0; r < 16; ++r) part[(qsub * 64 + db * 16 + r) * 64 + lane] = o[db][r];
        lp[qsub * 64 + lane] = l;
    }
    __syncthreads();
    if (kpar == 0) {
        float lt = l + lp[qsub * 64 + lane]; lt += __shfl_xor(lt, 32);
        const float inv = 1.f / lt;
        bf16_t* orow = Ob + (size_t)(rowbase + q0 + r32) * 512 + h * 128;
#pragma unroll
        for (int db = 0; db < 4; ++db)
#pragma unroll
            for (int g = 0; g < 4; ++g) { const LAS float* pp = part + (qsub * 64 + db * 16 + 4 * g) * 64 + lane;
                u32x2 w; w.x = cvtpk((o[db][4 * g] + pp[0]) * inv, (o[db][4 * g + 1] + pp[64]) * inv); w.y = cvtpk((o[db][4 * g + 2] + pp[128]) * inv, (o[db][4 * g + 3] + pp[192]) * inv);
                *(u32x2*)(orow + db * 32 + 8 * g + 4 * hi) = w; }
    }
    __syncthreads();
}
__device__ __forceinline__ void vt_block(LAS unsigned char* lds, bf16_t* V, int blk) {
    const int tid = threadIdx.x; constexpr int PITCH = 520;
    LAS bf16_t* t = (LAS bf16_t*)lds; bf16_t* base = V + (size_t)blk * 64 * 512;
#pragma unroll
    for (int i = 0; i < 8; ++i) { const int c = i * 512 + tid, row = c >> 6, c16 = c & 63; *(LAS u32x4*)(t + row * PITCH + c16 * 8) = *(const u32x4*)(base + (size_t)row * 512 + c16 * 8); }
    __syncthreads();
#pragma unroll
    for (int i = 0; i < 8; ++i) { const int c = i * 512 + tid, hd = c >> 3, ch = c & 7; const LAS bf16_t* s = t + (8 * ch) * PITCH + hd;
        u32x4 w; w.x = (unsigned)s[0] | ((unsigned)s[PITCH] << 16); w.y = (unsigned)s[2 * PITCH] | ((unsigned)s[3 * PITCH] << 16); w.z = (unsigned)s[4 * PITCH] | ((unsigned)s[5 * PITCH] << 16); w.w = (unsigned)s[6 * PITCH] | ((unsigned)s[7 * PITCH] << 16);
        *(u32x4*)(base + (size_t)hd * 64 + 8 * ch) = w; }
    __syncthreads();
}

template <int PASS>
__device__ __forceinline__ void topk_pass(const LAS unsigned char* afl, const bf16_t* IX, unsigned* MASK, LAS unsigned* hist, const LAS float* bnd, const LAS unsigned* pfx, const LAS unsigned* lov, int rowbase, int t0, int j, int wave, int r32, int hi, int g0, int g1) {
    constexpr int STRIDE = (PASS == 4) ? 64 : 8;
    const int kb0 = (PASS == 4) ? 8 * wave : wave;
    const bf16_t* kif = (const bf16_t*)((const char*)IX - WS_IDX + WS_KIF) + (size_t)(rowbase >> 5) * 2048 + (r32 + 32 * hi) * 8;
#pragma unroll 1
    for (int g = g0; g < g1; ++g) {
        bf16x8 afr[4]; f32x4 bd[4]; unsigned pq[4], lo[4];
#pragma unroll
        for (int s = 0; s < 4; ++s) afr[s] = *(const LAS bf16x8*)(afl + (g * 8) * 528 + s * 32);
#pragma unroll
        for (int a4 = 0; a4 < 4; ++a4) { const int q = g * 8 + 2 * a4 + hi; bd[a4] = *(const LAS f32x4*)(bnd + q * 4); pq[a4] = pfx[q]; lo[a4] = lov[q]; }
        bf16x8 bfr[4];
        if (kb0 <= j) {
#pragma unroll
            for (int s = 0; s < 4; ++s) bfr[s] = *(const bf16x8*)(kif + (size_t)kb0 * 2048 + 512 * s); }
        for (int kb = kb0; kb <= j; kb += STRIDE) {
            bf16x8 bn[4];
            { const int kn = (kb + STRIDE <= j) ? kb + STRIDE : kb;
#pragma unroll
              for (int s = 0; s < 4; ++s) bn[s] = *(const bf16x8*)(kif + (size_t)kn * 2048 + 512 * s); }
            const unsigned idxterm = 8191u - (unsigned)(kb * 32 + r32);
            const bool diag = (kb == j);
            f32x16 acc;
#pragma unroll
            for (int r = 0; r < 16; ++r) acc[r] = 0.f;
#pragma unroll
            for (int s = 0; s < 4; ++s) acc = MFMA32(afr[s], bfr[s], acc);
#pragma unroll
            for (int a4 = 0; a4 < 4; ++a4) {
                const int q = g * 8 + 2 * a4 + hi;
                const float sc = ((__builtin_amdgcn_fmed3f(acc[4 * a4 + 0], 0.f, bd[a4].x) + __builtin_amdgcn_fmed3f(acc[4 * a4 + 1], 0.f, bd[a4].y)) + __builtin_amdgcn_fmed3f(acc[4 * a4 + 2], 0.f, bd[a4].z)) + __builtin_amdgcn_fmed3f(acc[4 * a4 + 3], 0.f, bd[a4].w);
                const unsigned u = __float_as_uint(sc); const unsigned k32 = u ^ ((unsigned)((int)u >> 31) | 0x80000000u);
                const unsigned key = (k32 & 0xFFFFE000u) | idxterm;
                const bool valid = !diag || (r32 <= q);
                if (PASS == 4) { hist[q * 1024 + (kb >> 3) * 32 + r32] = valid ? key : 0u; }
                else if (PASS == 3) { const unsigned long long bal = __ballot(valid && key >= pq[a4]);
                    if (r32 == 0) MASK[(size_t)(rowbase + t0 + q) * 256 + kb] = hi ? (unsigned)(bal >> 32) : (unsigned)bal; }
                else {
                    const bool live = valid && key >= lo[a4];
                    if (PASS == 0) { if (live) { const unsigned dg = key >> 21; atomicAdd((unsigned*)(hist + q * 1024 + (dg >> 1)), 1u << (16 * (dg & 1))); } }
                    else if (PASS == 1) { if (live && (key >> 21) == pq[a4]) { const unsigned dg = (key >> 10) & 2047u; atomicAdd((unsigned*)(hist + q * 1024 + (dg >> 1)), 1u << (16 * (dg & 1))); } }
                    else { if (live && (key >> 10) == pq[a4]) { const unsigned dg = key & 1023u; atomicAdd((unsigned*)(hist + q * 1024 + (dg >> 1)), 1u << (16 * (dg & 1))); } }
                }
            }
#pragma unroll
            for (int s = 0; s < 4; ++s) bfr[s] = bn[s];
        }
    }
}
template <int BITS>
__device__ __forceinline__ void topk_select(LAS unsigned* hist, LAS unsigned* pfx, LAS unsigned* needv, LAS unsigned* flag, int wave, int lane) {
    constexpr int wpl = (BITS == 10) ? 8 : 16;
    for (int i = 0; i < 4; ++i) {
        const int q = wave * 4 + i; const LAS unsigned* hq = hist + q * 1024 + lane * wpl;
        unsigned c = 0u;
#pragma unroll
        for (int wi = 0; wi < wpl; ++wi) { const unsigned w = hq[wi]; c += (w & 0xffffu) + (w >> 16); }
        unsigned incl = c;
#pragma unroll
        for (int o = 1; o < 64; o <<= 1) { const unsigned v = __shfl_down(incl, o); if (lane + o < 64) incl += v; }
        const unsigned S = incl - c, nq = needv[q];
        if (lane == 0 && incl < nq) *flag = 1u;
        if (S < nq && nq <= incl) {
            unsigned run = S, bin = 0u, nn = 1u; bool found = false;
            for (int wi = wpl - 1; wi >= 0 && !found; --wi) { const unsigned w = hq[wi]; const unsigned h16 = w >> 16, l16 = w & 0xffffu;
                if (run + h16 >= nq) { bin = 2u * (unsigned)(lane * wpl + wi) + 1u; nn = nq - run; found = true; }
                else { run += h16; if (run + l16 >= nq) { bin = 2u * (unsigned)(lane * wpl + wi); nn = nq - run; found = true; } else run += l16; } }
            pfx[q] = (pfx[q] << BITS) | bin; needv[q] = nn;
        }
    }
}
template <int NQW>
__device__ __forceinline__ void topk_sample_bound(const LAS unsigned* samp, LAS float* lof, int qb, int lane) {
    unsigned v[NQW][16];
#pragma unroll
    for (int i = 0; i < NQW; ++i)
#pragma unroll
        for (int e = 0; e < 16; ++e) v[i][e] = samp[(qb + i) * 1024 + e * 64 + lane];
    unsigned T[NQW];
#pragma unroll
    for (int i = 0; i < NQW; ++i) T[i] = 0u;
    for (int bit = 31; bit >= 13; --bit) {
        unsigned c[NQW];
#pragma unroll
        for (int i = 0; i < NQW; ++i) { const unsigned cd = T[i] | (1u << bit); c[i] = 0u;
#pragma unroll
            for (int e = 0; e < 16; ++e) c[i] += (unsigned)__popcll(__ballot(v[i][e] >= cd)); }
#pragma unroll
        for (int i = 0; i < NQW; ++i) if (c[i] >= 80u) T[i] |= (1u << bit);
    }
#pragma unroll
    for (int i = 0; i < NQW; ++i) { const unsigned ub = (T[i] & 0x80000000u) ? (T[i] ^ 0x80000000u) : ~T[i];
        if (lane == 0) lof[qb + i] = (T[i] == 0u) ? -INFINITY : __uint_as_float(ub); }
}
constexpr int TK_CAP = 128;
__device__ __forceinline__ void topk_collect(const LAS unsigned char* afl, const bf16_t* IX, LAS unsigned* cand, const LAS float* bnd, const LAS float* lof, LAS unsigned* cntw, int rowbase, int j, int wave, int r32, int hi, int lane, int rotseed, int g0, int g1) {
    const bf16_t* kif = (const bf16_t*)((const char*)IX - WS_IDX + WS_KIF) + (size_t)(rowbase >> 5) * 2048 + (r32 + 32 * hi) * 8;
    const unsigned lanemask = (1u << r32) - 1u;
#pragma unroll 1
    for (int g = g0; g < g1; ++g) {
        bf16x8 afr[4]; f32x4 bd[4]; float lf[4]; unsigned cnt[4];
#pragma unroll
        for (int s = 0; s < 4; ++s) afr[s] = *(const LAS bf16x8*)(afl + (g * 8) * 528 + s * 32);
#pragma unroll
        for (int a4 = 0; a4 < 4; ++a4) { const int q = g * 8 + 2 * a4 + hi; bd[a4] = *(const LAS f32x4*)(bnd + q * 4); lf[a4] = lof[q]; cnt[a4] = 0u; }
        const int nit = (wave <= j) ? ((j - wave) >> 3) + 1 : 0;
        int ii = nit ? (rotseed + 5 * g) % nit : 0;
        bf16x8 bfr[4], bn1[4];
        { const int i1 = (ii + 1 < nit) ? ii + 1 : 0;
#pragma unroll
          for (int s = 0; s < 4; ++s) { bfr[s] = *(const bf16x8*)(kif + (size_t)(wave + 8 * ii) * 2048 + 512 * s); bn1[s] = *(const bf16x8*)(kif + (size_t)(wave + 8 * i1) * 2048 + 512 * s); } }
        for (int it = 0; it < nit; ++it) {
            const int kb = wave + 8 * ii;
            ii = (ii + 1 < nit) ? ii + 1 : 0;
            bf16x8 bn2[4];
            { const int i2 = (ii + 1 < nit) ? ii + 1 : 0;
#pragma unroll
              for (int s = 0; s < 4; ++s) bn2[s] = *(const bf16x8*)(kif + (size_t)(wave + 8 * i2) * 2048 + 512 * s); }
            const unsigned idxterm = 8191u - (unsigned)(kb * 32 + r32);
            const bool diag = (kb == j);
            f32x16 acc;
#pragma unroll
            for (int r = 0; r < 16; ++r) acc[r] = 0.f;
#pragma unroll
            for (int s = 0; s < 4; ++s) acc = MFMA32(afr[s], bfr[s], acc);
            float sc[4]; bool live[4]; unsigned mine[4];
#pragma unroll
            for (int a4 = 0; a4 < 4; ++a4) sc[a4] = ((__builtin_amdgcn_fmed3f(acc[4 * a4 + 0], 0.f, bd[a4].x) + __builtin_amdgcn_fmed3f(acc[4 * a4 + 1], 0.f, bd[a4].y)) + __builtin_amdgcn_fmed3f(acc[4 * a4 + 2], 0.f, bd[a4].z)) + __builtin_amdgcn_fmed3f(acc[4 * a4 + 3], 0.f, bd[a4].w);
#pragma unroll
            for (int a4 = 0; a4 < 4; ++a4) { live[a4] = (sc[a4] >= lf[a4]) && (!diag || (r32 <= g * 8 + 2 * a4 + hi)); const unsigned long long bal = __ballot(live[a4]); mine[a4] = hi ? (unsigned)(bal >> 32) : (unsigned)bal; }
#pragma unroll
            for (int a4 = 0; a4 < 4; ++a4) {
                const int q = g * 8 + 2 * a4 + hi;
                const unsigned u = __float_as_uint(sc[a4]); const unsigned k32 = u ^ ((unsigned)((int)u >> 31) | 0x80000000u);
                const unsigned key = (k32 & 0xFFFFE000u) | idxterm;
                const unsigned pos = cnt[a4] + (unsigned)__popc(mine[a4] & lanemask);
                if (live[a4] && pos < (unsigned)TK_CAP) cand[(q * 8 + wave) * TK_CAP + pos] = key;
                cnt[a4] += (unsigned)__popc(mine[a4]);
            }
#pragma unroll
            for (int s = 0; s < 4; ++s) { bfr[s] = bn1[s]; bn1[s] = bn2[s]; }
        }
        if (r32 == 0) {
#pragma unroll
            for (int a4 = 0; a4 < 4; ++a4) cntw[wave * 32 + g * 8 + 2 * a4 + hi] = cnt[a4];
        }
    }
}
template <int NQW>
__device__ __forceinline__ void topk_pick_t(const LAS unsigned* cand, const LAS unsigned* cntw, LAS unsigned* rowbuf, LAS unsigned* flag, unsigned* MASK, int rowbase, int t0, int j, int wave, int lane, int qb) {
    LAS unsigned* row = rowbuf + wave * 256;
    unsigned v[NQW][16]; unsigned need[NQW]; bool ok[NQW];
#pragma unroll
    for (int i = 0; i < NQW; ++i) {
        const int q = qb + i; unsigned ntot = 0u; bool over = false;
#pragma unroll
        for (int e = 0; e < 16; ++e) { const int slot = e * 64 + lane, w = slot >> 7, p = slot & 127; const unsigned c = cntw[w * 32 + q]; v[i][e] = ((unsigned)p < c) ? cand[q * 1024 + slot] : 0u; }
#pragma unroll
        for (int w = 0; w < 8; ++w) { const unsigned c = cntw[w * 32 + q]; ntot += c; over |= (c > (unsigned)TK_CAP); }
        const int n = t0 + q + 1; need[i] = (unsigned)(n < 256 ? n : 256);
        ok[i] = !(over || ntot < need[i]);
        if (!ok[i] && lane == 0) *flag = 1u;
    }
    unsigned T[NQW];
#pragma unroll
    for (int i = 0; i < NQW; ++i) T[i] = 0u;
    for (int bit = 31; bit >= 0; --bit) {
        unsigned c[NQW];
#pragma unroll
        for (int i = 0; i < NQW; ++i) { const unsigned cd = T[i] | (1u << bit); c[i] = 0u;
#pragma unroll
            for (int e = 0; e < 16; ++e) c[i] += (unsigned)__popcll(__ballot(v[i][e] >= cd)); }
#pragma unroll
        for (int i = 0; i < NQW; ++i) if (c[i] >= need[i]) T[i] |= (1u << bit);
    }
#pragma unroll
    for (int i = 0; i < NQW; ++i) {
        if (!ok[i]) continue;
        const int q = qb + i;
#pragma unroll
        for (int e = 0; e < 4; ++e) row[e * 64 + lane] = 0u;
#pragma unroll
        for (int e = 0; e < 16; ++e) if (v[i][e] != 0u && v[i][e] >= T[i]) { const unsigned sidx = 8191u - (v[i][e] & 8191u); atomicOr((unsigned*)(row + (sidx >> 5)), 1u << (sidx & 31u)); }
        for (int w = lane; w <= j; w += 64) MASK[(size_t)(rowbase + t0 + q) * 256 + w] = row[w];
    }
}
__device__ __forceinline__ void lds_clear128k(LAS unsigned char* lds, int tid) {
#pragma unroll
    for (int i = 0; i < 16; ++i) *(LAS u32x4*)(lds + (size_t)(i * 512 + tid) * 16) = (u32x4){0u, 0u, 0u, 0u};
}
__device__ __forceinline__ void topk_item(LAS unsigned char* lds, char* ws, int b, int j, int g0, int g1) {
    const int tid = threadIdx.x, lane = tid & 63, wave = __builtin_amdgcn_readfirstlane(tid >> 6), r32 = lane & 31, hi = lane >> 5, rowbase = b * SEQ, t0 = j * 32;
    const bf16_t* IX = (const bf16_t*)(ws + WS_IDX); unsigned* MASK = (unsigned*)(ws + WS_MASK);
    LAS unsigned* hist = (LAS unsigned*)lds;
    LAS unsigned* rowbuf = (LAS unsigned*)(lds + 150528);
    LAS float* bnd = (LAS float*)(lds + 147968);
    LAS unsigned* pfx = (LAS unsigned*)(lds + 147968 + 512);
    LAS unsigned* needv = (LAS unsigned*)(lds + 147968 + 640);
    LAS unsigned* lov = (LAS unsigned*)(lds + 147968 + 768);
    LAS unsigned* flag = (LAS unsigned*)(lds + 147968 + 896);
    LAS float* lof = (LAS float*)(lds + 147968 + 1024);
    LAS unsigned* cntw = (LAS unsigned*)(lds + 147968 + 1152);
    LAS unsigned char* abase = lds + 131072;
#pragma unroll 1
    for (int rr = 0; rr < REP_HEAD; ++rr) {
    { const int q = tid >> 4, c16 = tid & 15;
      const bf16_t* rowp = IX + (size_t)(rowbase + t0 + q) * 512;
      const u32x4 v0 = *(const u32x4*)(rowp + c16 * 8), v1 = *(const u32x4*)(rowp + 128 + c16 * 8);
      const float w0 = bf2f(rowp[320 + (c16 >> 3)]) * 0.0625f, w1 = bf2f(rowp[322 + (c16 >> 3)]) * 0.0625f;
      u32x4 o0, o1;
#define FOLD2(X, W) pk2(__uint_as_float((X) << 16) * (W), __uint_as_float((X) & 0xffff0000u) * (W))
      o0.x = FOLD2(v0.x, w0); o0.y = FOLD2(v0.y, w0); o0.z = FOLD2(v0.z, w0); o0.w = FOLD2(v0.w, w0);
      o1.x = FOLD2(v1.x, w1); o1.y = FOLD2(v1.y, w1); o1.z = FOLD2(v1.z, w1); o1.w = FOLD2(v1.w, w1);
#undef FOLD2
      *(LAS u32x4*)(abase + q * 528 + c16 * 16) = o0; *(LAS u32x4*)(abase + q * 528 + 256 + c16 * 16) = o1; }
    if (tid < 128) { const int q = tid >> 2, c = tid & 3; const float w = bf2f(IX[(size_t)(rowbase + t0 + q) * 512 + 320 + c]); bnd[tid] = (w >= 0.f) ? INFINITY : -INFINITY; }
    if (tid < 32) { pfx[tid] = 0u; const int n = t0 + tid + 1; needv[tid] = (unsigned)(n < 256 ? n : 256); lov[tid] = 0u; lof[tid] = -INFINITY; }
    if (tid == 0) *flag = 0u;
    if (j >= 32) {
        const int nrow16 = (g1 - g0) * 8 * 256;
        for (int i = tid; i < nrow16; i += 512) *(LAS u32x4*)(lds + (size_t)g0 * 8 * 4096 + (size_t)i * 16) = (u32x4){0u, 0u, 0u, 0u}; }
    __syncthreads(); }
    const LAS unsigned char* afl = abase + (r32 >> 2) * 528 + (r32 & 3) * 128 + hi * 16;
    if (j >= 32) {
#pragma unroll 1
        for (int rr = 0; rr < REP_SAMPLE; ++rr) {
        topk_pass<4>(afl, IX, MASK, hist, bnd, pfx, lov, rowbase, t0, j, wave, r32, hi, g0, g1);
        __syncthreads(); if (g1 - g0 == 4) topk_sample_bound<4>(hist, lof, wave * 4, lane); else if (g1 - g0 == 2) topk_sample_bound<2>(hist, lof, g0 * 8 + wave * 2, lane); else topk_sample_bound<1>(hist, lof, g0 * 8 + wave, lane); __syncthreads(); }
    }
#pragma unroll 1
    for (int rr = 0; rr < REP_COLLECT; ++rr) { topk_collect(afl, IX, hist, bnd, lof, cntw, rowbase, j, wave, r32, hi, lane, (j * 2 + b) * 29, g0, g1); __syncthreads(); }
#pragma unroll 1
    for (int rr = 0; rr < REP_PICK; ++rr) { if (g1 - g0 == 4) topk_pick_t<4>(hist, cntw, rowbuf, flag, MASK, rowbase, t0, j, wave, lane, wave * 4); else if (g1 - g0 == 2) topk_pick_t<2>(hist, cntw, rowbuf, flag, MASK, rowbase, t0, j, wave, lane, g0 * 8 + wave * 2); else topk_pick_t<1>(hist, cntw, rowbuf, flag, MASK, rowbase, t0, j, wave, lane, g0 * 8 + wave); __syncthreads(); }
    if (*flag == 0u) return;
#if DIFF_F
    if (tid == 0) atomicAdd((float*)(ws + 32768), 1.0f);
#endif
    __syncthreads(); lds_clear128k(lds, tid); __syncthreads();
    topk_pass<0>(afl, IX, MASK, hist, bnd, pfx, lov, rowbase, t0, j, wave, r32, hi, g0, g1);
    __syncthreads(); topk_select<11>(hist, pfx, needv, flag, wave, lane); __syncthreads(); lds_clear128k(lds, tid); __syncthreads();
    topk_pass<1>(afl, IX, MASK, hist, bnd, pfx, lov, rowbase, t0, j, wave, r32, hi, g0, g1);
    __syncthreads(); topk_select<11>(hist, pfx, needv, flag, wave, lane); __syncthreads(); lds_clear128k(lds, tid); __syncthreads();
    topk_pass<2>(afl, IX, MASK, hist, bnd, pfx, lov, rowbase, t0, j, wave, r32, hi, g0, g1);
    __syncthreads(); topk_select<10>(hist, pfx, needv, flag, wave, lane); __syncthreads();
    topk_pass<3>(afl, IX, MASK, hist, bnd, pfx, lov, rowbase, t0, j, wave, r32, hi, g0, g1);
    __syncthreads();
}

constexpr int NWAVES = 8, LDS_BYTES = 160768, RING_BYTES = 131072;
struct MArgs { const void* in[23]; float* out; char* ws; int ph_lo, ph_hi; };

__device__ __forceinline__ void conv_item(const float* W, int K, int Nsrc, bf16_t* WT, int mode, int srcoff, int Ndst, LAS float* scr, int item, int lane) {
    const int nblk = Ndst / 32, kb = item / nblk, nb = item % nblk, k0 = 64 * kb, n0 = 32 * nb;
    const int c4 = lane & 7, rsub = lane >> 3; const int n = n0 + 4 * c4; const int scol = (mode == 1) ? win_srccol(n) : srcoff + n;
    f32x4 wv[8];
#pragma unroll
    for (int i = 0; i < 8; ++i) wv[i] = (scol >= 0) ? *(const f32x4*)(W + (size_t)(k0 + 8 * i + rsub) * Nsrc + scol) : (f32x4){0.f, 0.f, 0.f, 0.f};
#pragma unroll
    for (int i = 0; i < 8; ++i) { LAS float* d = scr + (8 * i + rsub) * 33 + 4 * c4; d[0] = wv[i].x; d[1] = wv[i].y; d[2] = wv[i].z; d[3] = wv[i].w; }
    asm volatile("s_waitcnt lgkmcnt(0)" ::: "memory");
    const int c = lane & 7;
#pragma unroll
    for (int j = 0; j < 4; ++j) { const int nn = (lane >> 3) + 8 * j; const LAS float* s = scr + (8 * c) * 33 + nn;
        u32x4 o; o.x = pk2(s[0 * 33], s[1 * 33]); o.y = pk2(s[2 * 33], s[3 * 33]); o.z = pk2(s[4 * 33], s[5 * 33]); o.w = pk2(s[6 * 33], s[7 * 33]);
        *(u32x4*)(WT + (size_t)(n0 + nn) * K + k0 + 8 * c) = o; }
    asm volatile("s_waitcnt lgkmcnt(0)" ::: "memory");
}
__device__ __forceinline__ void rms_row(const float* x, float* xcopy, const float* g, bf16_t* out, int m, int lane) {
    const f32x4* xr = (const f32x4*)(x + (size_t)m * DM) + lane; f32x4 v[4]; float s = 0.f;
#pragma unroll
    for (int j = 0; j < 4; ++j) { v[j] = xr[64 * j]; s += (v[j].x * v[j].x + v[j].y * v[j].y) + (v[j].z * v[j].z + v[j].w * v[j].w); }
    s = wave_sum(s); const float r = rsqrtf(s * (1.f / DM) + EPS);
    if (xcopy) {
#pragma unroll
        for (int j = 0; j < 4; ++j) ((f32x4*)(xcopy + (size_t)m * DM) + lane)[64 * j] = v[j];
    }
#pragma unroll
    for (int j = 0; j < 4; ++j) { const f32x4 gg = ((const f32x4*)g + lane)[64 * j]; u32x2 w; w.x = pk2(v[j].x * r * gg.x, v[j].y * r * gg.y); w.y = pk2(v[j].z * r * gg.z, v[j].w * r * gg.w);
        *(u32x2*)(out + (size_t)m * DM + (64 * j + lane) * 4) = w; }
}
__device__ __forceinline__ void rms_row2(const float* x, float* xcopy, const float* g, bf16_t* out, int m0, int m1, int lane) {
    const f32x4* xa = (const f32x4*)(x + (size_t)m0 * DM) + lane; const f32x4* xb = (const f32x4*)(x + (size_t)m1 * DM) + lane; f32x4 va[4], vb[4]; float sa = 0.f, sb = 0.f;
#pragma unroll
    for (int j = 0; j < 4; ++j) { va[j] = xa[64 * j]; vb[j] = xb[64 * j]; }
#pragma unroll
    for (int j = 0; j < 4; ++j) { sa += (va[j].x * va[j].x + va[j].y * va[j].y) + (va[j].z * va[j].z + va[j].w * va[j].w); sb += (vb[j].x * vb[j].x + vb[j].y * vb[j].y) + (vb[j].z * vb[j].z + vb[j].w * vb[j].w); }
    sa = wave_sum(sa); sb = wave_sum(sb); const float ra = rsqrtf(sa * (1.f / DM) + EPS), rb = rsqrtf(sb * (1.f / DM) + EPS);
    if (xcopy) {
#pragma unroll
        for (int j = 0; j < 4; ++j) { ((f32x4*)(xcopy + (size_t)m0 * DM) + lane)[64 * j] = va[j]; ((f32x4*)(xcopy + (size_t)m1 * DM) + lane)[64 * j] = vb[j]; }
    }
#pragma unroll
    for (int j = 0; j < 4; ++j) { const f32x4 gg = ((const f32x4*)g + lane)[64 * j]; u32x2 w;
        w.x = pk2(va[j].x * ra * gg.x, va[j].y * ra * gg.y); w.y = pk2(va[j].z * ra * gg.z, va[j].w * ra * gg.w); *(u32x2*)(out + (size_t)m0 * DM + (64 * j + lane) * 4) = w;
        w.x = pk2(vb[j].x * rb * gg.x, vb[j].y * rb * gg.y); w.y = pk2(vb[j].z * rb * gg.z, vb[j].w * rb * gg.w); *(u32x2*)(out + (size_t)m1 * DM + (64 * j + lane) * 4) = w; }
}
template <int NT>
__device__ __forceinline__ void prepass_tokens(char* ws, const int (&mm)[NT], int w, int lane, int t256, const float* g_qa, const float* g_ka, const float* g_kidx) {
    bf16_t q0r[NT], q1r[NT], k0r[NT], k1r[NT], iqr[NT], ikr[NT], iwr[NT];
    float cA[NT], sA[NT], cI[NT], sI[NT];
    const float gq0 = g_qa[lane], gq1 = g_qa[lane + 64], gk0 = g_ka[lane], gk1 = g_ka[lane + 64], gki = g_kidx[lane];
#pragma unroll
    for (int t = 0; t < NT; ++t) { const size_t mo = (size_t)mm[t] * 512;
        const bf16_t* pq = (const bf16_t*)(ws + WS_QA) + mo + w * 128; const bf16_t* pk = (const bf16_t*)(ws + WS_KA) + mo + w * 128; const bf16_t* ix = (const bf16_t*)(ws + WS_IDX) + mo;
        const float* rt = (const float*)(ws + WS_ROPE) + (size_t)mm[t] * 48;
        q0r[t] = pq[lane]; q1r[t] = pq[lane + 64]; k0r[t] = pk[lane]; k1r[t] = pk[lane + 64]; iqr[t] = ix[w * 64 + lane]; ikr[t] = ix[256 + lane]; iwr[t] = ix[320 + w];
        cA[t] = rt[lane & 15]; sA[t] = rt[16 + (lane & 15)]; cI[t] = rt[32 + (lane & 7)]; sI[t] = rt[40 + (lane & 7)];
    }
#pragma unroll
    for (int t = 0; t < NT; ++t) { const int m = mm[t]; const size_t mo = (size_t)m * 512;
        bf16_t* pq = (bf16_t*)(ws + WS_QA) + mo + w * 128; bf16_t* pk = (bf16_t*)(ws + WS_KA) + mo + w * 128; bf16_t* ix = (bf16_t*)(ws + WS_IDX) + mo;
        float qo0, qo1, ko0, ko1;
        { const float v0 = bf2f(q0r[t]), v1 = bf2f(q1r[t]); const float r = rsqrtf(wave_sum(v0 * v0 + v1 * v1) * (1.f / 128.f) + EPS);
          float y0 = v0 * r * gq0; const float y1 = v1 * r * gq1; const float part = __shfl_xor(y0, 16);
          if (lane < 32) y0 = (lane < 16) ? y0 * cA[t] - part * sA[t] : y0 * cA[t] + part * sA[t];
          qo0 = y0 * QSCALE; qo1 = y1 * QSCALE; }
        { const float v0 = bf2f(k0r[t]), v1 = bf2f(k1r[t]); const float r = rsqrtf(wave_sum(v0 * v0 + v1 * v1) * (1.f / 128.f) + EPS);
          float y0 = v0 * r * gk0; const float y1 = v1 * r * gk1; const float part = __shfl_xor(y0, 16);
          if (lane < 32) y0 = (lane < 16) ? y0 * cA[t] - part * sA[t] : y0 * cA[t] + part * sA[t];
          ko0 = y0; ko1 = y1; }
        float iqo, iko;
        { float y = bf2f(iqr[t]); const float part = __shfl_xor(y, 8);
          if (lane < 16) y = (lane < 8) ? y * cI[t] - part * sI[t] : y * cI[t] + part * sI[t];
          iqo = y * bf2f(iwr[t]) * 0.0625f; }
        { const float v = bf2f(ikr[t]); const float r = rsqrtf(wave_sum(v * v) * (1.f / 64.f) + EPS);
          float y = v * r * gki; const float part = __shfl_xor(y, 8);
          if (lane < 16) y = (lane < 8) ? y * cI[t] - part * sI[t] : y * cI[t] + part * sI[t];
          iko = y; }
        pq[lane] = (bf16_t)f2bf(qo0); pq[lane + 64] = (bf16_t)f2bf(qo1); pk[lane] = (bf16_t)f2bf(ko0); pk[lane + 64] = (bf16_t)f2bf(ko1);
        ix[w * 64 + lane] = (bf16_t)f2bf(iqo);
        if (w == 0) { ix[256 + lane] = (bf16_t)f2bf(iko);
            ((bf16_t*)(ws + WS_KIF))[(((size_t)(m >> 5) * 4 + (lane >> 4)) * 64 + (m & 31) + 32 * ((lane >> 3) & 1)) * 8 + (lane & 7)] = (bf16_t)f2bf(iko); }
    }
}
__device__ __forceinline__ void conv_token(char* ws, int m, int lane, const float* cbw, const float* cbb, const float* lng, const float* lnb, const float* ccw) {
    const int t = m & (SEQ - 1); const int c0 = lane * 8;
    {
        const bf16_t* U = (const bf16_t*)(ws + WS_GLUA); float acc[8];
#pragma unroll
        for (int j = 0; j < 8; ++j) acc[j] = cbb[c0 + j];
        for (int k = 0; k < 31; ++k) { const int tt = t - 30 + k; if (tt < 0) continue;
            const bf16x8 u = *(const bf16x8*)(U + (size_t)(m - 30 + k) * 512 + c0);
#pragma unroll
            for (int j = 0; j < 8; ++j) acc[j] += cbw[k * 512 + c0 + j] * bfs2f(u[j]); }
        float s = 0.f;
#pragma unroll
        for (int j = 0; j < 8; ++j) s += acc[j];
        const float mean = wave_sum(s) * (1.f / 512.f); float q = 0.f;
#pragma unroll
        for (int j = 0; j < 8; ++j) { acc[j] -= mean; q += acc[j] * acc[j]; }
        const float r = rsqrtf(wave_sum(q) * (1.f / 512.f) + EPS); float o[8];
#pragma unroll
        for (int j = 0; j < 8; ++j) { const float y = acc[j] * r * lng[c0 + j] + lnb[c0 + j]; o[j] = y * sigmoidf_(y); }
        u32x4 wv; wv.x = pk2(o[0], o[1]); wv.y = pk2(o[2], o[3]); wv.z = pk2(o[4], o[5]); wv.w = pk2(o[6], o[7]);
        *(u32x4*)((bf16_t*)(ws + WS_GLUB) + (size_t)m * 512 + c0) = wv;
    }
    {
        const bf16_t* X = (const bf16_t*)(ws + WS_GC); float acc[8];
#pragma unroll
        for (int j = 0; j < 8; ++j) acc[j] = 0.f;
        for (int k = 0; k < 3; ++k) { const int tt = t - 2 + k; if (tt < 0) continue;
            const bf16x8 u = *(const bf16x8*)(X + (size_t)(m - 2 + k) * 512 + c0);
#pragma unroll
            for (int j = 0; j < 8; ++j) acc[j] += ccw[k * 512 + c0 + j] * bfs2f(u[j]); }
        const bf16x8 g = *(const bf16x8*)((const bf16_t*)(ws + WS_GB) + (size_t)m * 512 + c0); float o[8];
#pragma unroll
        for (int j = 0; j < 8; ++j) o[j] = acc[j] * bfs2f(g[j]);
        u32x4 wv; wv.x = pk2(o[0], o[1]); wv.y = pk2(o[2], o[3]); wv.z = pk2(o[4], o[5]); wv.w = pk2(o[6], o[7]);
        *(u32x4*)((bf16_t*)(ws + WS_XC) + (size_t)m * 512 + c0) = wv;
    }
}

__device__ __forceinline__ void conv_run8(char* ws, int m0, int lane, const LAS float* wB, const LAS float* wC, const float* cbb, const float* lng, const float* lnb) {
    const int t0 = m0 & (SEQ - 1), c0 = lane * 8;
    {
        float acc[8][8];
        { const f32x4 b0 = *(const f32x4*)(cbb + c0), b1 = *(const f32x4*)(cbb + c0 + 4);
#pragma unroll
          for (int i = 0; i < 8; ++i) { acc[i][0] = b0.x; acc[i][1] = b0.y; acc[i][2] = b0.z; acc[i][3] = b0.w; acc[i][4] = b1.x; acc[i][5] = b1.y; acc[i][6] = b1.z; acc[i][7] = b1.w; } }
        const bf16_t* U = (const bf16_t*)(ws + WS_GLUA) + c0;
#pragma unroll 1
        for (int rc = 0; rc < 5; ++rc) {
            bf16x8 u[8];
#pragma unroll
            for (int rr = 0; rr < 8; ++rr) { const int r = 8 * rc + rr; u[rr] = (bf16x8){0, 0, 0, 0, 0, 0, 0, 0}; if (r < 38 && t0 - 30 + r >= 0) u[rr] = *(const bf16x8*)(U + (size_t)(m0 - 30 + r) * 512); }
#pragma unroll
            for (int rr = 0; rr < 8; ++rr) {
                float uf[8];
#pragma unroll
                for (int j = 0; j < 8; ++j) uf[j] = bfs2f(u[rr][j]);
#pragma unroll
                for (int i = 0; i < 8; ++i) { const int k = 8 * rc + rr - i;
                    if (k >= 0 && k <= 30) { const LAS float* wp = wB + k * 512 + c0; const f32x4 w0 = *(const LAS f32x4*)wp, w1 = *(const LAS f32x4*)(wp + 4);
                        acc[i][0] += w0.x * uf[0]; acc[i][1] += w0.y * uf[1]; acc[i][2] += w0.z * uf[2]; acc[i][3] += w0.w * uf[3];
                        acc[i][4] += w1.x * uf[4]; acc[i][5] += w1.y * uf[5]; acc[i][6] += w1.z * uf[6]; acc[i][7] += w1.w * uf[7]; } }
            }
        }
        const f32x4 g0 = *(const f32x4*)(lng + c0), g1 = *(const f32x4*)(lng + c0 + 4), e0 = *(const f32x4*)(lnb + c0), e1 = *(const f32x4*)(lnb + c0 + 4);
        const float gg[8] = {g0.x, g0.y, g0.z, g0.w, g1.x, g1.y, g1.z, g1.w}, ee[8] = {e0.x, e0.y, e0.z, e0.w, e1.x, e1.y, e1.z, e1.w};
#pragma unroll
        for (int i = 0; i < 8; ++i) {
            float sm = 0.f;
#pragma unroll
            for (int j = 0; j < 8; ++j) sm += acc[i][j];
            const float mean = wave_sum(sm) * (1.f / 512.f); float q = 0.f;
#pragma unroll
            for (int j = 0; j < 8; ++j) { acc[i][j] -= mean; q += acc[i][j] * acc[i][j]; }
            const float r = rsqrtf(wave_sum(q) * (1.f / 512.f) + EPS); float o[8];
#pragma unroll
            for (int j = 0; j < 8; ++j) { const float y = acc[i][j] * r * gg[j] + ee[j]; o[j] = y * sigmoidf_(y); }
            u32x4 wv; wv.x = pk2(o[0], o[1]); wv.y = pk2(o[2], o[3]); wv.z = pk2(o[4], o[5]); wv.w = pk2(o[6], o[7]);
            *(u32x4*)((bf16_t*)(ws + WS_GLUB) + (size_t)(m0 + i) * 512 + c0) = wv;
        }
    }
    {
        float acc[8][8];
#pragma unroll
        for (int i = 0; i < 8; ++i)
#pragma unroll
            for (int j = 0; j < 8; ++j) acc[i][j] = 0.f;
        const bf16_t* X = (const bf16_t*)(ws + WS_GC) + c0;
        bf16x8 u[10];
#pragma unroll
        for (int r = 0; r < 10; ++r) { u[r] = (bf16x8){0, 0, 0, 0, 0, 0, 0, 0}; if (t0 - 2 + r >= 0) u[r] = *(const bf16x8*)(X + (size_t)(m0 - 2 + r) * 512); }
#pragma unroll
        for (int r = 0; r < 10; ++r) {
            float uf[8];
#pragma unroll
            for (int j = 0; j < 8; ++j) uf[j] = bfs2f(u[r][j]);
#pragma unroll
            for (int i = 0; i < 8; ++i) { const int k = r - i;
                if (k >= 0 && k <= 2) { const LAS float* wp = wC + k * 512 + c0; const f32x4 w0 = *(const LAS f32x4*)wp, w1 = *(const LAS f32x4*)(wp + 4);
                    acc[i][0] += w0.x * uf[0]; acc[i][1] += w0.y * uf[1]; acc[i][2] += w0.z * uf[2]; acc[i][3] += w0.w * uf[3];
                    acc[i][4] += w1.x * uf[4]; acc[i][5] += w1.y * uf[5]; acc[i][6] += w1.z * uf[6]; acc[i][7] += w1.w * uf[7]; } }
        }
#pragma unroll
        for (int i = 0; i < 8; ++i) {
            const bf16x8 g = *(const bf16x8*)((const bf16_t*)(ws + WS_GB) + (size_t)(m0 + i) * 512 + c0); float o[8];
#pragma unroll
            for (int j = 0; j < 8; ++j) o[j] = acc[i][j] * bfs2f(g[j]);
            u32x4 wv; wv.x = pk2(o[0], o[1]); wv.y = pk2(o[2], o[3]); wv.z = pk2(o[4], o[5]); wv.w = pk2(o[6], o[7]);
            *(u32x4*)((bf16_t*)(ws + WS_XC) + (size_t)(m0 + i) * 512 + c0) = wv;
        }
    }
}

template <class F, bool BR, bool ALIGN, class Sched>
__device__ __forceinline__ void run_gemm(LAS unsigned char* lds, const bf16_t* A, const bf16_t* Bt, int M, int N, int K, const Sched& S, const F& f) {
    const pg8::Gemm g{A, Bt, M, N, K}; const pg8::EpiFn<F, BR> E{f};
    pg8::gemm_phase<pg8::EpiFn<F, BR>, Sched, ALIGN, true>(lds, g, S, E);
}


#define XB_TMO      128
#define XB_XCNT(j)  (256  + 64 * (j))
#define XB_XSUB(j)  (1280 + 64 * (j))
#define XB_XGEN(j)  (2304 + 64 * (j))
#define XB_TOP      3328
#define XB_TOPGEN   3392
#define XCD_BAR_WORDS 3456
#define XB_SPIN_CAP (1u << 18)

__device__ __forceinline__ unsigned xb_ld(unsigned* p)              { return __hip_atomic_load(p, __ATOMIC_RELAXED, __HIP_MEMORY_SCOPE_AGENT); }
__device__ __forceinline__ unsigned xb_add(unsigned* p, unsigned v) { return __hip_atomic_fetch_add(p, v, __ATOMIC_RELAXED, __HIP_MEMORY_SCOPE_AGENT); }
__device__ __forceinline__ unsigned xb_xcc_id() { return (unsigned)__builtin_amdgcn_s_getreg((3 << 11) | 20) & 0xFu; }
#define XB_SPIN(cond, bar) do { unsigned _sp = 0; while (cond) { __builtin_amdgcn_s_sleep(1); \
    if ((++_sp & 255u) == 0u) { if (xb_ld(&(bar)[XB_TMO])) break; if (_sp > XB_SPIN_CAP) { atomicAdd(&(bar)[XB_TMO], 1u); break; } } } } while (0)

struct XcdBarrier {
    unsigned* bar; unsigned x;
    volatile LAS unsigned* st;
};

__device__ __forceinline__ XcdBarrier xcd_barrier_post(unsigned* bar, volatile LAS unsigned* st) {
    XcdBarrier b; b.bar = bar; b.x = xb_xcc_id(); b.st = st;
    if (threadIdx.x == 0) (void)xb_add(&bar[XB_XCNT(b.x)], 1u);
    return b;
}
__device__ __forceinline__ void xcd_barrier_complete(unsigned* bar, unsigned x, unsigned& nloc, unsigned& nx) {
    const unsigned G = gridDim.x * gridDim.y * gridDim.z;
    unsigned sum, cnt, mine, sp = 0u;
    for (;;) {
        sum = 0u; cnt = 0u; mine = 0u;
#pragma unroll
        for (unsigned j = 0; j < 16; ++j) { const unsigned c = xb_ld(&bar[XB_XCNT(j)]); sum += c; cnt += (c > 0u) ? 1u : 0u; mine = (j == x) ? c : mine; }
        if (sum == G) break;
        __builtin_amdgcn_s_sleep(1);
        if ((++sp & 255u) == 0u) { if (xb_ld(&bar[XB_TMO])) break; if (sp > XB_SPIN_CAP) { atomicAdd(&bar[XB_TMO], 1u); break; } }
    }
    nloc = mine > 0u ? mine : 1u; nx = cnt > 0u ? cnt : 1u;
}

__device__ __forceinline__ void xcd_barrier(const XcdBarrier& b) {
    asm volatile("s_waitcnt vmcnt(0)" ::: "memory");
    __syncthreads();
    if (threadIdx.x == 0) {
        unsigned* bar = b.bar;
        __builtin_amdgcn_s_waitcnt(0);
        unsigned nloc = b.st[0], nx = b.st[1];
        if (nloc == 0u) { xcd_barrier_complete(bar, b.x, nloc, nx); b.st[0] = nloc; b.st[1] = nx; }
        const unsigned old = xb_add(&bar[XB_XSUB(b.x)], 1u);
        const unsigned gen = old / nloc;
        if (old + 1u == (gen + 1u) * nloc) {
            __builtin_amdgcn_fence(__ATOMIC_RELEASE, "agent");
            asm volatile("s_waitcnt vmcnt(0)" ::: "memory");
            const unsigned og = xb_add(&bar[XB_TOP], 1u);
            const unsigned tg = og / nx;
            if (og + 1u == (tg + 1u) * nx) xb_add(&bar[XB_TOPGEN], 1u);
            else XB_SPIN(xb_ld(&bar[XB_TOPGEN]) == tg, bar);
            __builtin_amdgcn_fence(__ATOMIC_ACQUIRE, "agent");
            xb_add(&bar[XB_XGEN(b.x)], 1u);
            asm volatile("s_waitcnt vmcnt(0)" ::: "memory");
        } else {
            XB_SPIN(xb_ld(&bar[XB_XGEN(b.x)]) == gen, bar);
            __builtin_amdgcn_fence(__ATOMIC_ACQUIRE, "agent");
            asm volatile("s_waitcnt vmcnt(0)" ::: "memory");
        }
    }
    __syncthreads();
}

#define FIN(i) ((const float*)a.in[i])
#ifndef PROBE_PHASE
#define PROBE_PHASE -1
#endif
#ifndef TOPK_REPS
#define TOPK_REPS 1
#endif
#ifndef CONV_REPS
#define CONV_REPS 1
#endif
#ifndef PROBE_REPS
#define PROBE_REPS 2
#endif
#define REPS(kk) ((kk) == PROBE_PHASE ? PROBE_REPS : 0)
#define PH_BEGIN(kk) if (a.ph_lo <= L * 16 + (kk) && L * 16 + (kk) < a.ph_hi) { if (TS_EPI >= 0 && blockIdx.x == 0 && threadIdx.x == 0) { g_phase = L * 16 + (kk); if (L * 16 + (kk) == 0) { g_dbg[0] = 0ull; g_dbg[1] = 0ull; } } __syncthreads(); const unsigned long long tbusy0 = (TS_BUSY == (kk)) ? __builtin_amdgcn_s_memrealtime() : 0ull; for (int rep = 0; rep <= REPS(kk); ++rep) {
#define PH_END(kk) if (TS_BUSY == (kk) && L == 0 && threadIdx.x == 0) ((unsigned long long*)(a.ws + 65536 + 1024))[blockIdx.x] = __builtin_amdgcn_s_memrealtime() - tbusy0; \
    if (rep < REPS(kk) || L * 16 + (kk) + 1 < a.ph_hi) { if (L == 0 && (kk) == 0 && rep == 0) grid.sync(); else xcd_barrier(bar); } } \
    if (TS_PHASE >= 0 && blockIdx.x == 0 && threadIdx.x == 0) ((unsigned long long*)(a.ws + 65536))[L * 16 + (kk) + 1] = __builtin_amdgcn_s_memrealtime(); }
__device__ __forceinline__ int next_item(unsigned* ctr, LAS unsigned char* lds) {
    volatile LAS unsigned* slot = (volatile LAS unsigned*)(lds + 160016);
    __syncthreads();
    if (threadIdx.x == 0) *slot = atomicAdd(ctr, 1u);
    __syncthreads();
    return (int)*slot;
}
__device__ __forceinline__ unsigned take_early(unsigned* ctr) { return (threadIdx.x == 0) ? atomicAdd(ctr, 1u) : 0u; }
__device__ __forceinline__ int publish_late(unsigned v, LAS unsigned char* lds) {
    volatile LAS unsigned* slot = (volatile LAS unsigned*)(lds + 160016);
    if (threadIdx.x == 0) *slot = v;
    __syncthreads();
    const int r = (int)*slot;
    __syncthreads();
    return r;
}
template <int L> __device__ __forceinline__ void phase3_body(const MArgs& a, LAS unsigned char* lds) {
    const int tid = threadIdx.x, lane = tid & 63, wave = __builtin_amdgcn_readfirstlane(tid >> 6);
    unsigned* ctr = (unsigned*)(a.ws + 15360) + L * 2;
    int it = next_item(ctr, lds);
    while (it < 512) { vt_block(lds, (bf16_t*)(a.ws + (it < 256 ? WS_VA : WS_SV)), it & 255); it = next_item(ctr, lds); }
    it -= 512;
#if !NAIVE_TOPK
    while (it < 1408) {
        int b, j, g0, g1;
        { const int r = 63 - it / 22, k = it % 22, t = k >> 1; b = k & 1;
          if (t == 0) { j = r; g0 = 0; g1 = 4; }
          else if (t < 3) { j = 64 + r; g0 = 2 * (t - 1); g1 = g0 + 2; }
          else { const int u = t - 3; j = 128 + 2 * r + (u >> 2); g0 = u & 3; g1 = g0 + 1; } }
#pragma unroll 1
        for (int r2 = 0; r2 < TOPK_REPS; ++r2) topk_item(lds, a.ws, b, j, g0, g1);
        it = next_item(ctr, lds) - 512;
    }
#else
    while (it < 1408) it = next_item(ctr, lds) - 512;
#endif
    if (it < 1664) {
        LAS float* wB = (LAS float*)lds; LAS float* wC = wB + 31 * 512;
        const f32x4* sB = (const f32x4*)(FIN(9) + (size_t)L * 31 * 512); const f32x4* sC = (const f32x4*)(FIN(14) + (size_t)L * 3 * 512);
        for (int i = tid; i < 31 * 128; i += NWAVES * 64) ((LAS f32x4*)wB)[i] = sB[i];
        for (int i = tid; i < 3 * 128; i += NWAVES * 64) ((LAS f32x4*)wC)[i] = sC[i];
        __syncthreads();
        do {
#pragma unroll 1
            for (int r2 = 0; r2 < CONV_REPS; ++r2) conv_run8(a.ws, (it - 1408) * 64 + wave * 8, lane, wB, wC, FIN(10) + L * 512, FIN(11) + L * 512, FIN(12) + L * 512);
            it = next_item(ctr, lds) - 512;
        } while (it < 1664);
    }
}
template <int L> __device__ __forceinline__ void layer_phases(const MArgs& a, LAS unsigned char* lds, const cg::grid_group& grid, const XcdBarrier& bar) {
    const int tid = threadIdx.x, lane = tid & 63, wave = __builtin_amdgcn_readfirstlane(tid >> 6);
    const int G = gridDim.x, bx = blockIdx.x;
    PH_BEGIN(0)
        char* ws = a.ws; const int gw = bx * NWAVES + wave, NGW = G * NWAVES;
        LAS float* scr = (LAS float*)(lds + wave * 16384);
        const float* w_in = FIN(3) + (size_t)L * DM * NIN_SRC;
        constexpr int I_WIN = 16 * 192, I_WG = 16 * 128, I_WO = 8 * 32, I_WM = 16 * 32, I_FF = 16 * 88, I_FD = 44 * 32;
        constexpr int NITEMS = I_WIN + I_WG + 4 * I_WO + I_WM + 2 * I_FF + I_FD;
        for (int it = gw; it < NITEMS; it += NGW) {
            int r = it;
            if (r < I_WIN) { conv_item(w_in, DM, NIN_SRC, (bf16_t*)(ws + WS_WIN), 1, 0, 6144, scr, r, lane); continue; } r -= I_WIN;
            if (r < I_WG) { conv_item(w_in, DM, NIN_SRC, (bf16_t*)(ws + WS_WGATE), 0, 5956, 4096, scr, r, lane); continue; } r -= I_WG;
            if (r < 4 * I_WO) { const int br = r / I_WO; const int idx = br == 0 ? 8 : br == 1 ? 13 : br == 2 ? 15 : 16;
                conv_item(FIN(idx) + (size_t)L * 512 * DM, 512, DM, (bf16_t*)(ws + WS_WO) + (size_t)br * DM * 512, 0, 0, DM, scr, r % I_WO, lane); continue; } r -= 4 * I_WO;
            if (r < I_WM) { conv_item(FIN(17) + (size_t)L * DM * DM, DM, DM, (bf16_t*)(ws + WS_WM), 0, 0, DM, scr, r, lane); continue; } r -= I_WM;
            if (r < I_FF) { conv_item(FIN(19) + (size_t)L * DM * DFF, DM, DFF, (bf16_t*)(ws + WS_WFG), 0, 0, DFF, scr, r, lane); continue; } r -= I_FF;
            if (r < I_FF) { conv_item(FIN(20) + (size_t)L * DM * DFF, DM, DFF, (bf16_t*)(ws + WS_WFU), 0, 0, DFF, scr, r, lane); continue; } r -= I_FF;
            conv_item(FIN(22) + (size_t)L * DFF * DM, DFF, DM, (bf16_t*)(ws + WS_WFD), 0, 0, DM, scr, r, lane);
        }
        for (int m = gw; m < MTOK; m += 2 * NGW) rms_row2(L == 0 ? FIN(0) : (const float*)a.out, L == 0 ? a.out : (float*)nullptr, FIN(2) + (size_t)L * DM, (bf16_t*)(ws + WS_H), m, m + NGW, lane);
        if (L == 0) {
            const int* positions = (const int*)a.in[1]; float* rt = (float*)(ws + WS_ROPE);
            for (int idx = gw * 64 + lane; idx < MTOK * 24; idx += NGW * 64) { const int m = idx / 24, f = idx - m * 24;
                const float inv = (f < 16) ? powf(500000.f, -((float)f * 2.0f) / 32.f) : powf(500000.f, -((float)(f - 16) * 2.0f) / 16.f);
                const float ang = (float)positions[m] * inv; const int o = (f < 16) ? f : 16 + f;
                rt[(size_t)m * 48 + o] = cosf(ang); rt[(size_t)m * 48 + o + ((f < 16) ? 16 : 8)] = sinf(ang); }
        }
    PH_END(0)
    PH_BEGIN(1)
        pg8::StaticOrder S; S.init(MTOK, 6144, G, bx);
        const pg8::Gemm g{(const bf16_t*)(a.ws + WS_H), (const bf16_t*)(a.ws + WS_WIN), MTOK, 6144, DM}; const pg8::EpiInProj E{a.ws, lds, FIN(5) + L * 128, FIN(6) + L * 128, FIN(7) + L * 64};
        pg8::gemm_phase<pg8::EpiInProj, pg8::StaticOrder, true, true>(lds, g, S, E);
    PH_END(1)
    PH_BEGIN(3)
#if TS_PHASE == 100 && TS_BUSY < 0
        const unsigned long long tb0 = __builtin_amdgcn_s_memrealtime();
#endif
        phase3_body<L>(a, lds);
#if TS_PHASE == 100 && TS_BUSY < 0
        if (L == 0 && threadIdx.x == 0) ((unsigned long long*)(a.ws + 65536 + 1024))[blockIdx.x] = __builtin_amdgcn_s_memrealtime() - tb0;
#endif
    PH_END(3)
    PH_BEGIN(4)
#if !NAIVE_A
        { const float* gq = FIN(5) + L * 128; const float* gk = FIN(6) + L * 128;
          const float mq = wave_max(fmaxf(fabsf(gq[lane]), fabsf(gq[lane + 64]))), mk = wave_max(fmaxf(fabsf(gk[lane]), fabsf(gk[lane + 64])));
          const float negC = -16.33f * mq * mk;
          for (;;) { const int it = next_item((unsigned*)(a.ws + 15360) + L * 2 + 1 + 8 * rep, lds); if (it >= 768) break;
              if (it < 512) { const int bh = it & 7; attnA_unit(lds, a.ws, (bf16_t*)(a.ws + (rep ? WS_END : WS_QA)), bh >> 2, bh & 3, 63 - (it >> 3), negC); }
              else { const int si = (it - 512) * 8 + wave;
                  sb_item(a.ws, (bf16_t*)(a.ws + WS_SQ), si >> 10, (si >> 8) & 3, si & 255, lane); } } }
#endif
    PH_END(4)
    PH_BEGIN(5)
        pg8::StaticOrder S; S.init(MTOK, 4096, G, bx);
        run_gemm<EpiGates, false, true>(lds, (const bf16_t*)(a.ws + WS_H), (const bf16_t*)(a.ws + WS_WGATE), MTOK, 4096, DM, S, EpiGates{(bf16_t*)(a.ws + WS_GATES), FIN(4) + (size_t)L * 4096});
    PH_END(5)
    PH_BEGIN(6)
        pg8::BranchOrder S; S.init(G, bx);
        run_gemm<EpiOut, true, true>(lds, (const bf16_t*)(a.ws + WS_BR), (const bf16_t*)(a.ws + WS_WO), MTOK, DM, 512, S, EpiOut{(const bf16_t*)(a.ws + WS_GATES), (bf16_t*)(a.ws + WS_H)});
    PH_END(6)
    PH_BEGIN(7)
        pg8::StaticOrder S; S.init(MTOK, DM, G, bx);
        run_gemm<EpiResid, false, false>(lds, (const bf16_t*)(a.ws + WS_H), (const bf16_t*)(a.ws + WS_WM), MTOK, DM, DM, S, EpiResid{a.out, rep ? 0.f : 1.f, 0});
    PH_END(7)
    PH_BEGIN(8)
        const int gw = bx * NWAVES + wave, NGW = G * NWAVES;
        for (int m = gw; m < MTOK; m += 2 * NGW) rms_row2(a.out, nullptr, FIN(18) + (size_t)L * DM, (bf16_t*)(a.ws + WS_H), m, m + NGW, lane);
    PH_END(8)
    PH_BEGIN(9)
        pg8::StaticOrder S; S.init(MTOK, DFF, G, bx);
        run_gemm<EpiStore, false, true>(lds, (const bf16_t*)(a.ws + WS_H), (const bf16_t*)(a.ws + WS_WFG), MTOK, DFF, DM, S, EpiStore{(bf16_t*)(a.ws + WS_GP), DFF, 0});
    PH_END(9)
    PH_BEGIN(10)
        pg8::StaticOrder S; S.init(MTOK, DFF, G, bx);
        run_gemm<EpiFfnAct, false, true>(lds, (const bf16_t*)(a.ws + WS_H), (const bf16_t*)(a.ws + WS_WFU), MTOK, DFF, DM, S, EpiFfnAct{(const bf16_t*)(a.ws + WS_GP), FIN(21) + (size_t)L * 3 * DFF, (bf16_t*)(a.ws + WS_ACT)});
    PH_END(10)
    PH_BEGIN(11)
        pg8::StaticOrder S; S.init(MTOK, DM, G, bx);
        run_gemm<EpiResid, false, false>(lds, (const bf16_t*)(a.ws + WS_ACT), (const bf16_t*)(a.ws + WS_WFD), MTOK, DM, DFF, S, EpiResid{a.out, rep ? 0.f : 1.f, 0});
    PH_END(11)
}
__global__ void __launch_bounds__(NWAVES * 64, 2) mega(MArgs a) {
    extern __shared__ __attribute__((aligned(16))) unsigned char lds_raw[];
    cg::grid_group grid = cg::this_grid();
    LAS unsigned char* lds = (LAS unsigned char*)lds_raw;
    volatile LAS unsigned* misc = (volatile LAS unsigned*)(lds + 160000);
    if (threadIdx.x < 2) misc[threadIdx.x] = 0u;
    __syncthreads();
    const XcdBarrier bar = xcd_barrier_post((unsigned*)a.ws, misc);
    if (TS_PHASE >= 0 && blockIdx.x == 0 && threadIdx.x == 0) ((unsigned long long*)(a.ws + 65536))[0] = __builtin_amdgcn_s_memrealtime();
    layer_phases<0>(a, lds, grid, bar);
    layer_phases<1>(a, lds, grid, bar);
#if TS_PHASE >= 0
    {
        xcd_barrier(bar);
        const unsigned long long* ts = (const unsigned long long*)(a.ws + 65536);
#if TS_PHASE == 104
        const float frac = (float)g_dbg[0] / (float)(ts[28] - ts[0]);
#elif TS_PHASE == 102
        const unsigned long long* td = (const unsigned long long*)(a.ws + 65536 + 8192);
        unsigned long long sum = 0ull; int cntI = 0;
        for (int i = 0; i < 512; ++i) { const int jj = 255 - (i >> 1); if (jj >= TS_JLO && jj <= TS_JHI) { if (TS_MAX) { if (td[i] > sum) sum = td[i]; cntI = 1; } else { sum += td[i]; ++cntI; } } }
        const float frac = ((float)sum / (float)cntI) / (float)(ts[28] - ts[0]);
#elif TS_PHASE == 100 || TS_PHASE == 101
        unsigned long long sum = 0ull; for (int i = 0; i < (int)gridDim.x; ++i) sum += ts[128 + i];
        const float frac = ((float)sum / (float)gridDim.x) / (float)(ts[28] - ts[0]);
#else
        const unsigned long long t_start = (TS_PHASE == 0) ? ts[0] : ((TS_PHASE == 16) ? ts[12] : ts[TS_PHASE]);
        const float frac = (float)(ts[TS_PHASE + 1] - t_start) / (float)(ts[28] - ts[0]);
#endif
        const float f = 1.f + sqrtf(TS_SCALE * frac);
        for (size_t i = (size_t)blockIdx.x * 512 + threadIdx.x; i < (size_t)MTOK * DM / 4; i += (size_t)gridDim.x * 512) { f32x4* p = (f32x4*)a.out + i; *p = *p * f; }
    }
#endif
}
#undef FIN

#ifndef DIFF_A
#define DIFF_A 0
#endif
__global__ __launch_bounds__(256) void k_compare(const bf16_t* a, const bf16_t* b, size_t n, float* acc) {
    float num = 0.f, den = 0.f;
    for (size_t i = (size_t)blockIdx.x * 256 + threadIdx.x; i < n; i += (size_t)gridDim.x * 256) { const float x = bf2f(a[i]), y = bf2f(b[i]); num += (x - y) * (x - y); den += y * y; }
    num = wave_sum(num); den = wave_sum(den);
    if ((threadIdx.x & 63) == 0) { atomicAdd(acc, num); atomicAdd(acc + 1, den); }
}
#ifndef DIFF_T
#define DIFF_T 0
#endif
#ifndef DIFF_F
#define DIFF_F 0
#endif
__global__ __launch_bounds__(256) void k_compare_mask(const unsigned* a, const unsigned* b, float* acc) {
    float num = 0.f, den = 0.f;
    for (size_t i = (size_t)blockIdx.x * 256 + threadIdx.x; i < (size_t)MTOK * 256; i += (size_t)gridDim.x * 256) { const int m = (int)(i >> 8), w = (int)(i & 255);
        if (w <= ((m & (SEQ - 1)) >> 5)) { const unsigned x = a[i], y = b[i]; num += (float)__popc(x ^ y); den += (float)__popc(y); } }
    num = wave_sum(num); den = wave_sum(den);
    if ((threadIdx.x & 63) == 0) { atomicAdd(acc, num); atomicAdd(acc + 1, den); }
}
__global__ __launch_bounds__(256) void k_encode(float* out, size_t n, const float* acc) {
    const float f = DIFF_F ? 1.f + sqrtf(acc[0] * (1e-2f / 1024.f)) : 1.f + (DIFF_T ? 1.f : 10.f) * sqrtf(acc[0] / acc[1]);
    for (size_t i = (size_t)blockIdx.x * 256 + threadIdx.x; i < n; i += (size_t)gridDim.x * 256) out[i] *= f;
}
template <class Epi> static void gemm_simple(hipStream_t st, const bf16_t* A, int lda, const bf16_t* Bt, int ldb, int M, int N, int K, Epi e, int aux = 0) {
    GemmArgs<Epi> ga{}; ga.A = A; ga.Bt = Bt; ga.lda = lda; ga.ldb = ldb; ga.K = K; ga.aux = aux; ga.epi = e;
    hipLaunchKernelGGL(k_gemm_simple<Epi>, dim3(N / 128, M / 128), dim3(256), 0, st, ga);
}
static int g_grid = 0;
static void launch_mega(hipStream_t st, MArgs a, int lo, int hi) {
    a.ph_lo = lo; a.ph_hi = hi; void* args[] = {&a};
    hipMemsetAsync(a.ws, 0, 16384, st);
    hipError_t e = hipLaunchCooperativeKernel((const void*)mega, dim3(g_grid), dim3(NWAVES * 64), args, LDS_BYTES, st);
    if (e != hipSuccess) fprintf(stderr, "cooperative launch failed: %s (grid %d)\n", hipGetErrorString(e), g_grid);
}

extern "C" void kernel_launch(void* const* d_in, const int* in_sizes, int n_in, void* d_out, int out_size, void* d_ws, size_t ws_size, hipStream_t stream) {
    if (n_in != 23 || ws_size < WS_ROPE + 3 * MiB || out_size != MTOK * DM) { fprintf(stderr, "kernel_launch: unexpected shapes (n_in %d, ws %zu, out %d)\n", n_in, ws_size, out_size); return; }
    if (g_grid == 0) {
        int dev = 0, cus = 0, per_cu = 0;
        hipGetDevice(&dev); hipDeviceGetAttribute(&cus, hipDeviceAttributeMultiprocessorCount, dev);
        if (hipFuncSetAttribute((const void*)mega, hipFuncAttributeMaxDynamicSharedMemorySize, LDS_BYTES) != hipSuccess) { fprintf(stderr, "hipFuncSetAttribute failed\n"); g_grid = -1; return; }
        if (hipOccupancyMaxActiveBlocksPerMultiprocessor(&per_cu, (const void*)mega, NWAVES * 64, LDS_BYTES) != hipSuccess || per_cu < 1) { fprintf(stderr, "occupancy query: %d blocks/CU\n", per_cu); g_grid = -1; return; }
        g_grid = cus * per_cu;
        if (g_grid < 256) { fprintf(stderr, "this kernel needs 256 co-resident workgroups, the device admits %d\n", g_grid); g_grid = -1; return; }
        g_grid = 256;
    }
    if (g_grid < 0) return;
    char* ws = (char*)d_ws;
    MArgs a{}; for (int i = 0; i < 23; ++i) a.in[i] = d_in[i]; a.out = (float*)d_out; a.ws = ws;
#if DIFF_F
    hipMemsetAsync(ws + 32768, 0, 64, stream);
    launch_mega(stream, a, 0, 28);
    hipLaunchKernelGGL(k_encode, dim3(1024), dim3(256), 0, stream, (float*)d_out, (size_t)MTOK * DM, (const float*)(ws + 32768));
#elif !(NAIVE_TOPK || NAIVE_A || NAIVE_D || DIFF_A || DIFF_T)
    launch_mega(stream, a, 0, 28);
#else
    for (int l = 0; l < DEPTH; ++l) {
        launch_mega(stream, a, l * 16 + 0, l * 16 + 4);
#if NAIVE_TOPK
        hipLaunchKernelGGL(k_topk_naive, dim3(MTOK), dim3(256), 0, stream, (const char*)ws, (unsigned*)(ws + WS_MASK));
#endif
#if DIFF_T
        if (l == 0) {
            hipMemsetAsync(ws + 32768, 0, 64, stream);
            hipLaunchKernelGGL(k_topk_naive, dim3(MTOK), dim3(256), 0, stream, (const char*)ws, (unsigned*)(ws + WS_END));
            hipLaunchKernelGGL(k_compare_mask, dim3(1024), dim3(256), 0, stream, (const unsigned*)(ws + WS_MASK), (const unsigned*)(ws + WS_END), (float*)(ws + 32768));
        }
#endif
#if NAIVE_A
        hipLaunchKernelGGL(k_attnA_naive, dim3(MTOK), dim3(256), 0, stream, ws, (bf16_t*)(ws + WS_QA));
#endif
#if NAIVE_D
        hipLaunchKernelGGL(k_sb_naive, dim3(MTOK * 4), dim3(256), 0, stream, ws);
#endif
#if DIFF_A
        if (l == 0) {
            hipMemsetAsync(ws + 32768, 0, 64, stream);
            hipLaunchKernelGGL(k_attnA_naive, dim3(MTOK), dim3(256), 0, stream, ws, (bf16_t*)(ws + WS_END));
            launch_mega(stream, a, l * 16 + 4, l * 16 + 5);
            hipLaunchKernelGGL(k_compare, dim3(1024), dim3(256), 0, stream, (const bf16_t*)(ws + WS_QA), (const bf16_t*)(ws + WS_END), (size_t)MTOK * 512, (float*)(ws + 32768));
            launch_mega(stream, a, l * 16 + 5, l * 16 + 12);
        } else
#endif
        launch_mega(stream, a, l * 16 + 4, l * 16 + 12);
    }
#endif
#if DIFF_A || DIFF_T
    hipLaunchKernelGGL(k_encode, dim3(1024), dim3(256), 0, stream, (float*)d_out, (size_t)MTOK * DM, (const float*)(ws + 32768));
#endif
}
```

```cpp
#include <hip/hip_runtime.h>
#include <hip/hip_cooperative_groups.h>
#include <cstdint>
#include <cstdio>
#include <cmath>

namespace cg = cooperative_groups;
typedef unsigned short bf16_t;
typedef short bf16x8 __attribute__((ext_vector_type(8)));
typedef float f32x4 __attribute__((ext_vector_type(4)));
typedef unsigned u32x4 __attribute__((ext_vector_type(4)));
typedef unsigned u32x2 __attribute__((ext_vector_type(2)));

#ifndef NAIVE_TOPK
#define NAIVE_TOPK 0
#endif
#ifndef NAIVE_A
#define NAIVE_A 0
#endif
#ifndef NAIVE_D
#define NAIVE_D 0
#endif
#ifndef REP_COLLECT
#define REP_COLLECT 1
#endif
#ifndef TS_PHASE
#define TS_PHASE -1
#endif
#ifndef TS_BUSY
#define TS_BUSY -1
#endif
#ifndef TS_JLO
#define TS_JLO 0
#endif
#ifndef TS_JHI
#define TS_JHI 255
#endif
#ifndef TS_MAX
#define TS_MAX 0
#endif
#ifndef TS_SCALE
#define TS_SCALE 0.01f
#endif
#ifndef REP_HEAD
#define REP_HEAD 1
#endif
#ifndef REP_TAIL
#define REP_TAIL 1
#endif
#ifndef REP_PICK
#define REP_PICK 1
#endif
#ifndef REP_SAMPLE
#define REP_SAMPLE 1
#endif
constexpr int SEQ = 8192, DM = 1024, MTOK = 2 * SEQ, DEPTH = 2, NIN_SRC = 10052, DFF = 2816;
constexpr float EPS = 1e-6f;
constexpr float QSCALE = 0.08838834764831845f * 1.4426950408889634f;

constexpr size_t MiB = 1u << 20;
constexpr size_t WS_WIN = 1 * MiB, WS_WGATE = 13 * MiB, WS_WO = 21 * MiB, WS_WM = 25 * MiB, WS_WFG = 27 * MiB, WS_WFU = WS_WFG + 5767168, WS_WFD = WS_WFU + 5767168;
constexpr size_t WS_H = 44 * MiB;
constexpr size_t WS_QA = 76 * MiB, WS_GLUB = 92 * MiB, WS_XC = 108 * MiB, WS_SQ = 124 * MiB;
constexpr size_t WS_KA = 140 * MiB, WS_VA = 156 * MiB, WS_IDX = 172 * MiB, WS_GLUA = 188 * MiB, WS_GB = 204 * MiB, WS_GC = 220 * MiB, WS_SK = 236 * MiB, WS_SV = 252 * MiB;
constexpr size_t WS_MASK = 268 * MiB, WS_END = 284 * MiB;
constexpr size_t WS_PART = 512 * 1024;
constexpr size_t WS_X1 = WS_MASK;
constexpr size_t WS_GATES = 140 * MiB;
constexpr size_t WS_GP = 76 * MiB, WS_ACT = 164 * MiB;
constexpr size_t WS_BR = WS_QA;
constexpr size_t WS_ROPE = 302 * MiB;
constexpr size_t WS_KIF = 300 * MiB;

__host__ __device__ __forceinline__ size_t vt_index(int m, int h, int d) { return ((size_t)((m >> 6) * 4 + h) * 128 + d) * 64 + (m & 63); }
__device__ __forceinline__ float bf2f(bf16_t b) { return __uint_as_float((unsigned)b << 16); }
__device__ __forceinline__ float bfs2f(short b) { return __uint_as_float(((unsigned)(unsigned short)b) << 16); }
__device__ __forceinline__ unsigned f2bf(float f) { unsigned u = __float_as_uint(f); return (u + 0x7fffu + ((u >> 16) & 1u)) >> 16; }
typedef float pk2_f32x2 __attribute__((ext_vector_type(2)));
typedef __bf16 pk2_bf16x2 __attribute__((ext_vector_type(2)));
__device__ __forceinline__ unsigned pk2(float lo, float hi) { pk2_f32x2 v = {lo, hi}; pk2_bf16x2 b = __builtin_convertvector(v, pk2_bf16x2); return __builtin_bit_cast(unsigned, b); }
#define DPP_F(x, ctrl) __int_as_float(__builtin_amdgcn_update_dpp(0, __float_as_int(x), (ctrl), 0xf, 0xf, true))
__device__ __forceinline__ float wave_sum(float v) {
    v += DPP_F(v, 0xB1); v += DPP_F(v, 0x4E); v += DPP_F(v, 0x141); v += DPP_F(v, 0x140);
    const int iv = __float_as_int(v);
    return (__int_as_float(__builtin_amdgcn_readlane(iv, 0)) + __int_as_float(__builtin_amdgcn_readlane(iv, 16))) + (__int_as_float(__builtin_amdgcn_readlane(iv, 32)) + __int_as_float(__builtin_amdgcn_readlane(iv, 48)));
}
__device__ __forceinline__ float wave_max(float v) {
    v = fmaxf(v, DPP_F(v, 0xB1)); v = fmaxf(v, DPP_F(v, 0x4E)); v = fmaxf(v, DPP_F(v, 0x141)); v = fmaxf(v, DPP_F(v, 0x140));
    const int iv = __float_as_int(v);
    return fmaxf(fmaxf(__int_as_float(__builtin_amdgcn_readlane(iv, 0)), __int_as_float(__builtin_amdgcn_readlane(iv, 16))), fmaxf(__int_as_float(__builtin_amdgcn_readlane(iv, 32)), __int_as_float(__builtin_amdgcn_readlane(iv, 48))));
}
#define DPP_U(x, ctrl) ((unsigned)__builtin_amdgcn_update_dpp(0, (int)(x), (ctrl), 0xf, 0xf, true))
__device__ __forceinline__ unsigned wave_max_u(unsigned v) {
    v = max(v, DPP_U(v, 0xB1)); v = max(v, DPP_U(v, 0x4E)); v = max(v, DPP_U(v, 0x141)); v = max(v, DPP_U(v, 0x140));
    return max(max((unsigned)__builtin_amdgcn_readlane((int)v, 0), (unsigned)__builtin_amdgcn_readlane((int)v, 16)), max((unsigned)__builtin_amdgcn_readlane((int)v, 32), (unsigned)__builtin_amdgcn_readlane((int)v, 48)));
}
__device__ __forceinline__ unsigned wave_sum_u_dpp(unsigned v) {
    v += DPP_U(v, 0xB1); v += DPP_U(v, 0x4E); v += DPP_U(v, 0x141); v += DPP_U(v, 0x140);
    return ((unsigned)__builtin_amdgcn_readlane((int)v, 0) + (unsigned)__builtin_amdgcn_readlane((int)v, 16)) + ((unsigned)__builtin_amdgcn_readlane((int)v, 32) + (unsigned)__builtin_amdgcn_readlane((int)v, 48));
}
__device__ __forceinline__ unsigned wave_sum_u(unsigned v) {
#pragma unroll
    for (int o = 32; o > 0; o >>= 1) v += __shfl_xor(v, o);
    return v;
}
__device__ __forceinline__ float sigmoidf_(float x) { return __builtin_amdgcn_rcpf(1.f + __builtin_amdgcn_exp2f(fminf(-1.4426950408889634f * x, 80.f))); }

struct ConvJob { const float* src; bf16_t* dst; int K, Nsrc, Ndst, mode, srcoff, pad; };
__host__ __device__ __forceinline__ int win_srccol(int n) {
    if (n < 1536) return n;
    if (n < 2048) { const int j = n - 1536; return j < 324 ? 1536 + j : -1; }
    if (n < 3072) { const int m = n - 2048, ch = (m >> 8) * 128 + (m & 127); return ((m >> 7) & 1 ? 2372 : 1860) + ch; }
    if (n < 3584) return 2884 + (n - 3072);
    if (n < 4608) { const int m = n - 3584, ch = (m >> 8) * 128 + (m & 127); return ((m >> 7) & 1 ? 3908 : 3396) + ch; }
    return 4420 + (n - 4608);
}
__global__ __launch_bounds__(256) void k_convert(ConvJob jb) {
    __shared__ float tile[64][65];
    const int n0 = blockIdx.x * 64, k0 = blockIdx.y * 64, tx = threadIdx.x & 63, ty = threadIdx.x >> 6;
    const int n = n0 + tx; const int sc = (jb.mode == 1) ? win_srccol(n) : jb.srcoff + n;
    for (int i = ty; i < 64; i += 4) { float v = 0.f; if (sc >= 0) v = jb.src[(size_t)(k0 + i) * jb.Nsrc + sc]; tile[i][tx] = v; }
    __syncthreads();
    for (int c = threadIdx.x; c < 512; c += 256) {
        const int nn = c >> 3, ch = c & 7; u32x4 w;
        w.x = pk2(tile[ch * 8 + 0][nn], tile[ch * 8 + 1][nn]); w.y = pk2(tile[ch * 8 + 2][nn], tile[ch * 8 + 3][nn]);
        w.z = pk2(tile[ch * 8 + 4][nn], tile[ch * 8 + 5][nn]); w.w = pk2(tile[ch * 8 + 6][nn], tile[ch * 8 + 7][nn]);
        *(u32x4*)(jb.dst + (size_t)(n0 + nn) * jb.K + k0 + ch * 8) = w;
    }
}

__global__ __launch_bounds__(256) void k_rmsnorm(const float* x, float* xcopy, const float* g, bf16_t* out) {
    const int wave = threadIdx.x >> 6, lane = threadIdx.x & 63; const int m = blockIdx.x * 4 + wave;
    const f32x4* xr = (const f32x4*)(x + (size_t)m * DM) + lane; f32x4 v[4]; float s = 0.f;
#pragma unroll
    for (int j = 0; j < 4; ++j) { v[j] = xr[64 * j]; s += (v[j].x * v[j].x + v[j].y * v[j].y) + (v[j].z * v[j].z + v[j].w * v[j].w); }
    s = wave_sum(s); const float r = rsqrtf(s * (1.f / DM) + EPS);
    if (xcopy) {
#pragma unroll
        for (int j = 0; j < 4; ++j) ((f32x4*)(xcopy + (size_t)m * DM) + lane)[64 * j] = v[j];
    }
#pragma unroll
    for (int j = 0; j < 4; ++j) { const f32x4 gg = ((const f32x4*)g + lane)[64 * j]; u32x2 w; w.x = pk2(v[j].x * r * gg.x, v[j].y * r * gg.y); w.y = pk2(v[j].z * r * gg.z, v[j].w * r * gg.w);
        *(u32x2*)(out + (size_t)m * DM + (64 * j + lane) * 4) = w; }
}

__device__ __forceinline__ void unpack8bf(u32x4 w, f32x4& a, f32x4& b) {
    a.x = __uint_as_float(w.x << 16); a.y = __uint_as_float(w.x & 0xffff0000u); a.z = __uint_as_float(w.y << 16); a.w = __uint_as_float(w.y & 0xffff0000u);
    b.x = __uint_as_float(w.z << 16); b.y = __uint_as_float(w.z & 0xffff0000u); b.z = __uint_as_float(w.w << 16); b.w = __uint_as_float(w.w & 0xffff0000u); }
__device__ __forceinline__ void store4bf(bf16_t* p, f32x4 v) { u32x2 w; w.x = pk2(v.x, v.y); w.y = pk2(v.z, v.w); *(u32x2*)p = w; }
__device__ __forceinline__ f32x4 load4bf(const bf16_t* p) { const u32x2 w = *(const u32x2*)p; f32x4 r; r.x = __uint_as_float(w.x << 16); r.y = __uint_as_float(w.x & 0xffff0000u); r.z = __uint_as_float(w.y << 16); r.w = __uint_as_float(w.y & 0xffff0000u); return r; }
__host__ __device__ __forceinline__ size_t goff_of(int g) {
    switch (g) { case 0: return WS_QA; case 1: return WS_KA; case 2: return WS_VA; case 3: return WS_IDX; case 4: return WS_GLUA; case 5: return WS_GLUB;
                 case 6: return WS_GB; case 7: return WS_GC; case 8: return WS_XC; case 9: return WS_SQ; case 10: return WS_SK; default: return WS_SV; } }
__device__ __forceinline__ void store8bf(bf16_t* p, f32x4 a, f32x4 b) { u32x4 w; w.x = pk2(a.x, a.y); w.y = pk2(a.z, a.w); w.z = pk2(b.x, b.y); w.w = pk2(b.z, b.w); *(u32x4*)p = w; }
__device__ __forceinline__ void load8bf(const bf16_t* p, f32x4& a, f32x4& b) { const u32x4 w = *(const u32x4*)p;
    a.x = __uint_as_float(w.x << 16); a.y = __uint_as_float(w.x & 0xffff0000u); a.z = __uint_as_float(w.y << 16); a.w = __uint_as_float(w.y & 0xffff0000u);
    b.x = __uint_as_float(w.z << 16); b.y = __uint_as_float(w.z & 0xffff0000u); b.z = __uint_as_float(w.w << 16); b.w = __uint_as_float(w.w & 0xffff0000u); }
__device__ __forceinline__ f32x4 sig4(f32x4 v) { f32x4 o; o.x = sigmoidf_(v.x); o.y = sigmoidf_(v.y); o.z = sigmoidf_(v.z); o.w = sigmoidf_(v.w); return o; }
struct EpiSplit { char* ws;
    __device__ __forceinline__ void operator()(int row, int col, f32x4 v, int aux) const { store4bf((bf16_t*)(ws + goff_of(col >> 9)) + (size_t)row * 512 + (col & 511), v); }
    struct Prep { int d; }; __device__ __forceinline__ void prep(Prep& p, int col) const { p.d = 0; }
    __device__ __forceinline__ void op8(const Prep&, int row, int col, f32x4 a, f32x4 b, int aux) const { store8bf((bf16_t*)(ws + goff_of(col >> 9)) + (size_t)row * 512 + (col & 511), a, b); } };
__device__ __forceinline__ unsigned q8pack(f32x4 s) { const unsigned a = (unsigned)(s.x * 255.f + 0.5f), b = (unsigned)(s.y * 255.f + 0.5f), c = (unsigned)(s.z * 255.f + 0.5f), d = (unsigned)(s.w * 255.f + 0.5f); return a | (b << 8) | (c << 16) | (d << 24); }
__device__ __forceinline__ f32x4 q8unpack(unsigned w) { f32x4 o; o.x = (float)(w & 255u); o.y = (float)((w >> 8) & 255u); o.z = (float)((w >> 16) & 255u); o.w = (float)(w >> 24); return o * (1.f / 255.f); }
struct EpiGates { unsigned char* G; const float* bias;
    __device__ __forceinline__ void operator()(int row, int col, f32x4 v, int aux) const { const f32x4 b = *(const f32x4*)(bias + col); *(unsigned*)(G + (size_t)row * 4096 + col) = q8pack(sig4(v + b)); }
    struct Prep { f32x4 b0, b1; }; __device__ __forceinline__ void prep(Prep& p, int col) const { p.b0 = *(const f32x4*)(bias + col); p.b1 = *(const f32x4*)(bias + col + 4); }
    __device__ __forceinline__ void op8(const Prep& p, int row, int col, f32x4 a, f32x4 b, int aux) const { u32x2 w; w.x = q8pack(sig4(a + p.b0)); w.y = q8pack(sig4(b + p.b1)); *(u32x2*)(G + (size_t)row * 4096 + col) = w; } };
struct EpiOut { struct Prep { int dummy; };
    const unsigned char* G; bf16_t* Mg;
    __device__ __forceinline__ void operator()(int row, int col, f32x4 v, int aux) const { const int br = aux; const f32x4 g = q8unpack(*(const unsigned*)(G + (size_t)row * 4096 + br * 1024 + col)); f32x4 p = (f32x4){0.f, 0.f, 0.f, 0.f};
        if (br) p = load4bf(Mg + (size_t)row * DM + col); store4bf(Mg + (size_t)row * DM + col, p + g * v); }
    __device__ __forceinline__ void prep(Prep& pr, int col0) const { pr.dummy = 0; }
    __device__ __forceinline__ void op8(const Prep&, int row, int col, f32x4 a, f32x4 b, int aux) const { const u32x2 gw = *(const u32x2*)(G + (size_t)row * 4096 + aux * 1024 + col); const f32x4 g0 = q8unpack(gw.x), g1 = q8unpack(gw.y); f32x4 p0 = (f32x4){0.f, 0.f, 0.f, 0.f}, p1 = p0;
        if (aux) load8bf(Mg + (size_t)row * DM + col, p0, p1); store8bf(Mg + (size_t)row * DM + col, p0 + g0 * a, p1 + g1 * b); }
    static constexpr int NB = 8; struct Ld { u32x2 gw; u32x4 m; };
    __device__ __forceinline__ void ld8(Ld& L, int row, int col, int aux) const { L.gw = *(const u32x2*)(G + (size_t)row * 4096 + aux * 1024 + col); if (aux) L.m = *(const u32x4*)(Mg + (size_t)row * DM + col); }
    __device__ __forceinline__ void op8b(const Prep&, const Ld& L, int row, int col, f32x4 a, f32x4 b, int aux) const { const f32x4 g0 = q8unpack(L.gw.x), g1 = q8unpack(L.gw.y); f32x4 p0 = (f32x4){0.f, 0.f, 0.f, 0.f}, p1 = p0;
        if (aux) unpack8bf(L.m, p0, p1); store8bf(Mg + (size_t)row * DM + col, p0 + g0 * a, p1 + g1 * b); } };
struct EpiResid { float* x; const float* src; float scale; int pad;
    __device__ __forceinline__ void operator()(int row, int col, f32x4 v, int aux) const { f32x4* p = (f32x4*)(x + (size_t)row * DM + col); *p = *(const f32x4*)(src + (size_t)row * DM + col) + v * scale; }
    struct Prep { int d; }; __device__ __forceinline__ void prep(Prep& p, int col) const { p.d = 0; }
    __device__ __forceinline__ void op8(const Prep&, int row, int col, f32x4 a, f32x4 b, int aux) const { const size_t o = (size_t)row * DM + col; f32x4* p = (f32x4*)(x + o); const f32x4* q = (const f32x4*)(src + o); const f32x4 x0 = q[0], x1 = q[1]; p[0] = x0 + a * scale; p[1] = x1 + b * scale; } };
template <bool SRC_BF, bool DST_BF> struct EpiResidT { void* x; const void* src; float scale; int pad;
    __device__ __forceinline__ void operator()(int row, int col, f32x4 v, int aux) const { const size_t o = (size_t)row * DM + col;
        const f32x4 r = (SRC_BF ? load4bf((const bf16_t*)src + o) : *(const f32x4*)((const float*)src + o)) + v * scale;
        if (DST_BF) store4bf((bf16_t*)x + o, r); else *(f32x4*)((float*)x + o) = r; }
    struct Prep { int d; }; __device__ __forceinline__ void prep(Prep& p, int col) const { p.d = 0; }
    __device__ __forceinline__ void op8(const Prep&, int row, int col, f32x4 a, f32x4 b, int aux) const { const size_t o = (size_t)row * DM + col; f32x4 x0, x1;
        if (SRC_BF) load8bf((const bf16_t*)src + o, x0, x1); else { const f32x4* q = (const f32x4*)((const float*)src + o); x0 = q[0]; x1 = q[1]; }
        x0 = x0 + a * scale; x1 = x1 + b * scale;
        if (DST_BF) store8bf((bf16_t*)x + o, x0, x1); else { f32x4* pp = (f32x4*)((float*)x + o); pp[0] = x0; pp[1] = x1; } }
    static constexpr int NB = 8; struct Ld { u32x4 raw; f32x4 f0, f1; };
    __device__ __forceinline__ void ld8(Ld& L, int row, int col, int aux) const { const size_t o = (size_t)row * DM + col;
        if (SRC_BF) L.raw = *(const u32x4*)((const bf16_t*)src + o); else { const f32x4* q = (const f32x4*)((const float*)src + o); L.f0 = q[0]; L.f1 = q[1]; } }
    __device__ __forceinline__ void op8b(const Prep&, const Ld& L, int row, int col, f32x4 a, f32x4 b, int aux) const { const size_t o = (size_t)row * DM + col; f32x4 x0, x1;
        if (SRC_BF) unpack8bf(L.raw, x0, x1); else { x0 = L.f0; x1 = L.f1; }
        x0 = x0 + a * scale; x1 = x1 + b * scale;
        if (DST_BF) store8bf((bf16_t*)x + o, x0, x1); else { f32x4* pp = (f32x4*)((float*)x + o); pp[0] = x0; pp[1] = x1; } } };
struct EpiStore { bf16_t* O; int ldc, pad;
    __device__ __forceinline__ void operator()(int row, int col, f32x4 v, int aux) const { store4bf(O + (size_t)row * ldc + col, v); }
    struct Prep { int d; }; __device__ __forceinline__ void prep(Prep& p, int col) const { p.d = 0; }
    __device__ __forceinline__ void op8(const Prep&, int row, int col, f32x4 a, f32x4 b, int aux) const { store8bf(O + (size_t)row * ldc + col, a, b); } };
struct EpiFfnAct {
    const bf16_t* GP; const float* cw; bf16_t* ACT;
    __device__ __forceinline__ void operator()(int row, int col, f32x4 v, int aux) const {
        const int t = row & (SEQ - 1); const f32x4 z = (f32x4){0.f, 0.f, 0.f, 0.f};
        const f32x4 g2 = load4bf(GP + (size_t)row * DFF + col), g1 = t >= 1 ? load4bf(GP + (size_t)(row - 1) * DFF + col) : z, g0 = t >= 2 ? load4bf(GP + (size_t)(row - 2) * DFF + col) : z;
        const f32x4 w0 = *(const f32x4*)(cw + col), w1 = *(const f32x4*)(cw + DFF + col), w2 = *(const f32x4*)(cw + 2 * DFF + col);
        const f32x4 gt = w0 * g0 + w1 * g1 + w2 * g2; f32x4 o;
        o.x = gt.x * sigmoidf_(gt.x) * v.x; o.y = gt.y * sigmoidf_(gt.y) * v.y; o.z = gt.z * sigmoidf_(gt.z) * v.z; o.w = gt.w * sigmoidf_(gt.w) * v.w;
        store4bf(ACT + (size_t)row * DFF + col, o); }
    struct Prep8 { f32x4 w[3][2]; }; typedef Prep8 Prep;
    __device__ __forceinline__ void prep(Prep8& p, int col) const {
#pragma unroll
        for (int k = 0; k < 3; ++k) { p.w[k][0] = *(const f32x4*)(cw + k * DFF + col); p.w[k][1] = *(const f32x4*)(cw + k * DFF + col + 4); } }
    __device__ __forceinline__ void op8(const Prep8& pw, int row, int col, f32x4 a, f32x4 b, int aux) const {
        const int t = row & (SEQ - 1); const bf16_t* p2 = GP + (size_t)row * DFF + col; const bf16_t* p1 = p2 - (t >= 1 ? DFF : 0); const bf16_t* p0 = p2 - (t >= 2 ? 2 * DFF : 0);
        f32x4 g00, g01, g10, g11, g20, g21; load8bf(p0, g00, g01); load8bf(p1, g10, g11); load8bf(p2, g20, g21);
        const float m0 = t >= 2 ? 1.f : 0.f, m1 = t >= 1 ? 1.f : 0.f;
        const f32x4 t0 = pw.w[0][0] * (g00 * m0) + pw.w[1][0] * (g10 * m1) + pw.w[2][0] * g20, t1 = pw.w[0][1] * (g01 * m0) + pw.w[1][1] * (g11 * m1) + pw.w[2][1] * g21;
        store8bf(ACT + (size_t)row * DFF + col, t0 * sig4(t0) * a, t1 * sig4(t1) * b); }
    struct Ld { u32x4 g0, g1, g2; };
    __device__ __forceinline__ void ld8(Ld& L, int row, int col, int aux) const {
        const int t = row & (SEQ - 1); const bf16_t* p2 = GP + (size_t)row * DFF + col; const bf16_t* p1 = p2 - (t >= 1 ? DFF : 0); const bf16_t* p0 = p2 - (t >= 2 ? 2 * DFF : 0);
        L.g0 = *(const u32x4*)p0; L.g1 = *(const u32x4*)p1; L.g2 = *(const u32x4*)p2; }
    __device__ __forceinline__ void op8b(const Prep8& pw, const Ld& L, int row, int col, f32x4 a, f32x4 b, int aux) const {
        const int t = row & (SEQ - 1); f32x4 g00, g01, g10, g11, g20, g21; unpack8bf(L.g0, g00, g01); unpack8bf(L.g1, g10, g11); unpack8bf(L.g2, g20, g21);
        const float m0 = t >= 2 ? 1.f : 0.f, m1 = t >= 1 ? 1.f : 0.f;
        const f32x4 t0 = pw.w[0][0] * (g00 * m0) + pw.w[1][0] * (g10 * m1) + pw.w[2][0] * g20, t1 = pw.w[0][1] * (g01 * m0) + pw.w[1][1] * (g11 * m1) + pw.w[2][1] * g21;
        store8bf(ACT + (size_t)row * DFF + col, t0 * sig4(t0) * a, t1 * sig4(t1) * b); } };

__device__ __forceinline__ float row_rs(const float* part, int row) { const f32x4 p = *(const f32x4*)(part + (size_t)row * 4); return rsqrtf(((p.x + p.y) + (p.z + p.w)) * (1.f / DM) + EPS); }
struct EpiStoreRS { bf16_t* O; const float* part; int ldc, pad;
    struct Prep { int d; }; __device__ __forceinline__ void prep(Prep& p, int col) const { p.d = 0; }
    __device__ __forceinline__ void operator()(int row, int col, f32x4 v, int aux) const { store4bf(O + (size_t)row * ldc + col, v * row_rs(part, row)); }
    __device__ __forceinline__ void op8(const Prep&, int row, int col, f32x4 a, f32x4 b, int aux) const { const float r = row_rs(part, row); store8bf(O + (size_t)row * ldc + col, a * r, b * r); }
    static constexpr int NB = 8; struct Ld { f32x4 p; };
    __device__ __forceinline__ void ld8(Ld& L, int row, int col, int aux) const { L.p = *(const f32x4*)(part + (size_t)row * 4); }
    __device__ __forceinline__ void op8b(const Prep&, const Ld& L, int row, int col, f32x4 a, f32x4 b, int aux) const { const float r = rsqrtf(((L.p.x + L.p.y) + (L.p.z + L.p.w)) * (1.f / DM) + EPS); store8bf(O + (size_t)row * ldc + col, a * r, b * r); } };
struct EpiFfnActRS {
    EpiFfnAct f; const float* part;
    typedef EpiFfnAct::Prep8 Prep;
    __device__ __forceinline__ void prep(Prep& p, int col) const { f.prep(p, col); }
    __device__ __forceinline__ void operator()(int row, int col, f32x4 v, int aux) const { f(row, col, v * row_rs(part, row), aux); }
    __device__ __forceinline__ void op8(const Prep& pw, int row, int col, f32x4 a, f32x4 b, int aux) const { const float r = row_rs(part, row); f.op8(pw, row, col, a * r, b * r, aux); }
    static constexpr int NB = 2; struct Ld { f32x4 p; EpiFfnAct::Ld g; };
    __device__ __forceinline__ void ld8(Ld& L, int row, int col, int aux) const { L.p = *(const f32x4*)(part + (size_t)row * 4); f.ld8(L.g, row, col, aux); }
    __device__ __forceinline__ void op8b(const Prep& pw, const Ld& L, int row, int col, f32x4 a, f32x4 b, int aux) const { const float r = rsqrtf(((L.p.x + L.p.y) + (L.p.z + L.p.w)) * (1.f / DM) + EPS); f.op8b(pw, L.g, row, col, a * r, b * r, aux); } };

struct EpiGatesRS { EpiGates f; const float* part;
    typedef EpiGates::Prep Prep;
    __device__ __forceinline__ void prep(Prep& p, int col) const { f.prep(p, col); }
    __device__ __forceinline__ void operator()(int row, int col, f32x4 v, int aux) const { f(row, col, part ? v * row_rs(part, row) : v, aux); }
    __device__ __forceinline__ void op8(const Prep& pw, int row, int col, f32x4 a, f32x4 b, int aux) const { const float r = part ? row_rs(part, row) : 1.f; f.op8(pw, row, col, a * r, b * r, aux); }
    static constexpr int NB = 8; struct Ld { f32x4 p; };
    __device__ __forceinline__ void ld8(Ld& L, int row, int col, int aux) const { if (part) L.p = *(const f32x4*)(part + (size_t)row * 4); }
    __device__ __forceinline__ void op8b(const Prep& pw, const Ld& L, int row, int col, f32x4 a, f32x4 b, int aux) const { const float r = part ? rsqrtf(((L.p.x + L.p.y) + (L.p.z + L.p.w)) * (1.f / DM) + EPS) : 1.f; f.op8(pw, row, col, a * r, b * r, aux); } };

template <class Epi> struct GemmArgs { const bf16_t* A; const bf16_t* Bt; int lda, ldb, K, aux; Epi epi; };
template <class Epi>
__global__ __launch_bounds__(256) void k_gemm_simple(GemmArgs<Epi> ga) {
    const bf16_t* A = ga.A; const bf16_t* Bt = ga.Bt; const int lda = ga.lda, ldb = ga.ldb, K = ga.K; const Epi& epi = ga.epi;
    const int lane = threadIdx.x & 63, w = threadIdx.x >> 6, fr = lane & 15, fq = lane >> 4;
    const int row0 = blockIdx.y * 128 + (w >> 1) * 64, col0 = blockIdx.x * 128 + (w & 1) * 64;
    f32x4 acc[4][4];
#pragma unroll
    for (int i = 0; i < 4; ++i)
#pragma unroll
        for (int j = 0; j < 4; ++j) acc[i][j] = (f32x4){0.f, 0.f, 0.f, 0.f};
    const bf16_t* ap = A + (size_t)(row0 + fr) * lda + fq * 8; const bf16_t* bp = Bt + (size_t)(col0 + fr) * ldb + fq * 8;
    for (int k0 = 0; k0 < K; k0 += 32) {
        bf16x8 a[4], b[4];
#pragma unroll
        for (int i = 0; i < 4; ++i) { a[i] = *(const bf16x8*)(ap + (size_t)(i * 16) * lda + k0); b[i] = *(const bf16x8*)(bp + (size_t)(i * 16) * ldb + k0); }
#pragma unroll
        for (int i = 0; i < 4; ++i)
#pragma unroll
            for (int j = 0; j < 4; ++j) acc[i][j] = __builtin_amdgcn_mfma_f32_16x16x32_bf16(b[j], a[i], acc[i][j], 0, 0, 0);
    }
#pragma unroll
    for (int i = 0; i < 4; ++i)
#pragma unroll
        for (int j = 0; j < 4; ++j) epi(row0 + i * 16 + fr, col0 + j * 16 + fq * 4, acc[i][j], ga.aux);
}

__global__ __launch_bounds__(256) void k_prepass(char* ws, const int* positions, const float* g_qa, const float* g_ka, const float* g_kidx) {
    const int m = blockIdx.x, tid = threadIdx.x, w = tid >> 6, lane = tid & 63;
    const float pos = (float)positions[m];
#pragma unroll
    for (int which = 0; which < 2; ++which) {
        bf16_t* p = (bf16_t*)(ws + (which ? WS_KA : WS_QA)) + (size_t)m * 512 + w * 128; const float* g = which ? g_ka : g_qa;
        const float v0 = bf2f(p[lane]), v1 = bf2f(p[lane + 64]);
        const float ss = wave_sum(v0 * v0 + v1 * v1); const float r = rsqrtf(ss * (1.f / 128.f) + EPS);
        float y0 = v0 * r * g[lane]; const float y1 = v1 * r * g[lane + 64];
        const float part = __shfl_xor(y0, 16);
        if (lane < 32) { const int i = lane & 15; const float inv = powf(500000.f, -((float)i * 2.0f) / 32.f); const float ang = pos * inv; const float c = cosf(ang), s = sinf(ang);
            y0 = (lane < 16) ? y0 * c - part * s : y0 * c + part * s; }
        const float sc = which ? 1.f : QSCALE;
        p[lane] = (bf16_t)f2bf(y0 * sc); p[lane + 64] = (bf16_t)f2bf(y1 * sc);
    }
    bf16_t* ix = (bf16_t*)(ws + WS_IDX) + (size_t)m * 512;
    const float wv = bf2f(ix[320 + w]);
    {
        float y = bf2f(ix[w * 64 + lane]); const float part = __shfl_xor(y, 8);
        if (lane < 16) { const int i = lane & 7; const float inv = powf(500000.f, -((float)i * 2.0f) / 16.f); const float ang = pos * inv; const float c = cosf(ang), s = sinf(ang);
            y = (lane < 8) ? y * c - part * s : y * c + part * s; }
        ix[w * 64 + lane] = (bf16_t)f2bf(y * wv * 0.0625f);
    }
    if (w == 0) {
        const float v = bf2f(ix[256 + lane]); const float ss = wave_sum(v * v); const float r = rsqrtf(ss * (1.f / 64.f) + EPS);
        float y = v * r * g_kidx[lane]; const float part = __shfl_xor(y, 8);
        if (lane < 16) { const int i = lane & 7; const float inv = powf(500000.f, -((float)i * 2.0f) / 16.f); const float ang = pos * inv; const float c = cosf(ang), s = sinf(ang);
            y = (lane < 8) ? y * c - part * s : y * c + part * s; }
        ix[256 + lane] = (bf16_t)f2bf(y);
    }
    bf16_t* ga = (bf16_t*)(ws + WS_GLUA) + (size_t)m * 512; const bf16_t* gb = (const bf16_t*)(ws + WS_GLUB) + (size_t)m * 512;
    bf16_t* gc = (bf16_t*)(ws + WS_GC) + (size_t)m * 512; const bf16_t* xc = (const bf16_t*)(ws + WS_XC) + (size_t)m * 512;
    bf16_t* sq = (bf16_t*)(ws + WS_SQ) + (size_t)m * 512;
#pragma unroll
    for (int e = 0; e < 2; ++e) { const int c = tid + e * 256;
        ga[c] = (bf16_t)f2bf(bf2f(ga[c]) * sigmoidf_(bf2f(gb[c])));
        gc[c] = (bf16_t)f2bf(bf2f(gc[c]) * bf2f(xc[c]));
        sq[c] = (bf16_t)f2bf(bf2f(sq[c]) * QSCALE); }
}

__global__ __launch_bounds__(256) void k_conv(char* ws, const float* cbw, const float* cbb, const float* lng, const float* lnb, const float* ccw) {
    const int wave = threadIdx.x >> 6, lane = threadIdx.x & 63; const int m = blockIdx.x * 4 + wave; const int t = m & (SEQ - 1); const int c0 = lane * 8;
    {
        const bf16_t* U = (const bf16_t*)(ws + WS_GLUA); float acc[8];
#pragma unroll
        for (int j = 0; j < 8; ++j) acc[j] = cbb[c0 + j];
        for (int k = 0; k < 31; ++k) { const int tt = t - 30 + k; if (tt < 0) continue;
            const bf16x8 u = *(const bf16x8*)(U + (size_t)(m - 30 + k) * 512 + c0);
#pragma unroll
            for (int j = 0; j < 8; ++j) acc[j] += cbw[k * 512 + c0 + j] * bfs2f(u[j]); }
        float s = 0.f;
#pragma unroll
        for (int j = 0; j < 8; ++j) s += acc[j];
        const float mean = wave_sum(s) * (1.f / 512.f); float q = 0.f;
#pragma unroll
        for (int j = 0; j < 8; ++j) { acc[j] -= mean; q += acc[j] * acc[j]; }
        const float r = rsqrtf(wave_sum(q) * (1.f / 512.f) + EPS); float o[8];
#pragma unroll
        for (int j = 0; j < 8; ++j) { const float y = acc[j] * r * lng[c0 + j] + lnb[c0 + j]; o[j] = y * sigmoidf_(y); }
        u32x4 wv; wv.x = pk2(o[0], o[1]); wv.y = pk2(o[2], o[3]); wv.z = pk2(o[4], o[5]); wv.w = pk2(o[6], o[7]);
        *(u32x4*)((bf16_t*)(ws + WS_GLUB) + (size_t)m * 512 + c0) = wv;
    }
    {
        const bf16_t* X = (const bf16_t*)(ws + WS_GC); float acc[8];
#pragma unroll
        for (int j = 0; j < 8; ++j) acc[j] = 0.f;
        for (int k = 0; k < 3; ++k) { const int tt = t - 2 + k; if (tt < 0) continue;
            const bf16x8 u = *(const bf16x8*)(X + (size_t)(m - 2 + k) * 512 + c0);
#pragma unroll
            for (int j = 0; j < 8; ++j) acc[j] += ccw[k * 512 + c0 + j] * bfs2f(u[j]); }
        const bf16x8 g = *(const bf16x8*)((const bf16_t*)(ws + WS_GB) + (size_t)m * 512 + c0); float o[8];
#pragma unroll
        for (int j = 0; j < 8; ++j) o[j] = acc[j] * bfs2f(g[j]);
        u32x4 wv; wv.x = pk2(o[0], o[1]); wv.y = pk2(o[2], o[3]); wv.z = pk2(o[4], o[5]); wv.w = pk2(o[6], o[7]);
        *(u32x4*)((bf16_t*)(ws + WS_XC) + (size_t)m * 512 + c0) = wv;
    }
}

__device__ __forceinline__ unsigned sortkey(float f) { const unsigned u = __float_as_uint(f); return (u & 0x80000000u) ? ~u : (u | 0x80000000u); }
__global__ __launch_bounds__(256) void k_topk_naive(const char* ws, unsigned* MASK) {
    __shared__ unsigned sc[SEQ]; __shared__ float qf[256]; __shared__ unsigned maskw[256]; __shared__ float wsg[4]; __shared__ unsigned cnt_s;
    const int m = blockIdx.x, b = m >> 13, t = m & (SEQ - 1), tid = threadIdx.x, lane = tid & 63;
    const bf16_t* IX = (const bf16_t*)(ws + WS_IDX);
    qf[tid] = bf2f(IX[(size_t)m * 512 + tid]); maskw[tid] = 0u; if (tid < 4) wsg[tid] = bf2f(IX[(size_t)m * 512 + 320 + tid]);
    __syncthreads();
    const int n = t + 1;
    for (int s = tid; s < n; s += 256) {
        const bf16x8* kp = (const bf16x8*)(IX + (size_t)(b * SEQ + s) * 512 + 256); float x0 = 0.f, x1 = 0.f, x2 = 0.f, x3 = 0.f;
#pragma unroll
        for (int c = 0; c < 8; ++c) { const bf16x8 kk = kp[c];
#pragma unroll
            for (int j = 0; j < 8; ++j) { const float kv = bfs2f(kk[j]); const int d = c * 8 + j; x0 += qf[d] * kv; x1 += qf[64 + d] * kv; x2 += qf[128 + d] * kv; x3 += qf[192 + d] * kv; } }
        float score = (wsg[0] >= 0.f ? fmaxf(x0, 0.f) : fminf(x0, 0.f));
        score += (wsg[1] >= 0.f ? fmaxf(x1, 0.f) : fminf(x1, 0.f));
        score += (wsg[2] >= 0.f ? fmaxf(x2, 0.f) : fminf(x2, 0.f));
        score += (wsg[3] >= 0.f ? fmaxf(x3, 0.f) : fminf(x3, 0.f));
        sc[s] = sortkey(score);
    }
    __syncthreads();
    if (n <= 256) { if (tid < n) atomicOr(&maskw[tid >> 5], 1u << (tid & 31)); }
    else {
        unsigned T = 0u;
        for (int bit = 31; bit >= 0; --bit) {
            const unsigned cand = T | (1u << bit);
            if (tid == 0) cnt_s = 0u;
            __syncthreads();
            unsigned c = 0u; for (int s = tid; s < n; s += 256) c += (sc[s] >= cand) ? 1u : 0u;
            c = wave_sum_u(c); if (lane == 0) atomicAdd(&cnt_s, c);
            __syncthreads();
            if (cnt_s >= 256u) T = cand;
            __syncthreads();
        }
        if (tid == 0) cnt_s = 0u;
        __syncthreads();
        { unsigned c = 0u; for (int s = tid; s < n; s += 256) c += (sc[s] > T) ? 1u : 0u; c = wave_sum_u(c); if (lane == 0) atomicAdd(&cnt_s, c); }
        __syncthreads();
        const int need = 256 - (int)cnt_s;
        for (int s = tid; s < n; s += 256) if (sc[s] > T) atomicOr(&maskw[s >> 5], 1u << (s & 31));
        if (tid < 64) { int taken = 0;
            for (int base = 0; base < n && taken < need; base += 64) { const int s = base + lane; const bool tie = (s < n) && (sc[s] == T);
                const unsigned long long bal = __ballot(tie); const int pre = __popcll(bal & ((1ull << lane) - 1ull));
                if (tie && taken + pre < need) atomicOr(&maskw[s >> 5], 1u << (s & 31));
                taken += __popcll(bal); } }
    }
    __syncthreads();
    MASK[(size_t)m * 256 + tid] = maskw[tid];
}

__device__ __forceinline__ float block_max256(float v, float* red) { v = wave_max(v); __syncthreads(); if ((threadIdx.x & 63) == 0) red[threadIdx.x >> 6] = v; __syncthreads(); return fmaxf(fmaxf(red[0], red[1]), fmaxf(red[2], red[3])); }
__device__ __forceinline__ float block_sum256(float v, float* red) { v = wave_sum(v); __syncthreads(); if ((threadIdx.x & 63) == 0) red[threadIdx.x >> 6] = v; __syncthreads(); return (red[0] + red[1]) + (red[2] + red[3]); }

__global__ __launch_bounds__(256) void k_attnA_naive(char* ws, bf16_t* outbase) {
    __shared__ int sel[256]; __shared__ float q[512]; __shared__ float p[256]; __shared__ float red[4]; __shared__ int pre[256]; __shared__ float osum[256];
    const int m = blockIdx.x, b = m >> 13, tid = threadIdx.x;
    const unsigned* MW = (const unsigned*)(ws + WS_MASK) + (size_t)m * 256; bf16_t* QA = (bf16_t*)(ws + WS_QA) + (size_t)m * 512;
    const bf16_t* KA = (const bf16_t*)(ws + WS_KA); const bf16_t* VA = (const bf16_t*)(ws + WS_VA);
    q[tid] = bf2f(QA[tid]); q[tid + 256] = bf2f(QA[tid + 256]);
    unsigned w = (tid <= ((m & (SEQ - 1)) >> 5)) ? MW[tid] : 0u; const int c = __popc(w); pre[tid] = c; sel[tid] = 0;
    __syncthreads();
    for (int o = 1; o < 256; o <<= 1) { const int v = tid >= o ? pre[tid - o] : 0; __syncthreads(); pre[tid] += v; __syncthreads(); }
    int off = pre[tid] - c; int nsel = pre[255]; if (nsel > 256) nsel = 256;
    while (w) { const int bit = __ffs(w) - 1; w &= w - 1u; if (off < 256) sel[off] = tid * 32 + bit; ++off; }
    __syncthreads();
    for (int h = 0; h < 4; ++h) {
        float l = -INFINITY;
        if (tid < nsel) { const bf16x8* kp = (const bf16x8*)(KA + (size_t)(b * SEQ + sel[tid]) * 512 + h * 128); float a = 0.f;
#pragma unroll
            for (int cc = 0; cc < 16; ++cc) { const bf16x8 kk = kp[cc];
#pragma unroll
                for (int j = 0; j < 8; ++j) a += q[h * 128 + cc * 8 + j] * bfs2f(kk[j]); }
            l = a; }
        const float mx = block_max256(l, red); const float e = tid < nsel ? exp2f(l - mx) : 0.f; const float sum = block_sum256(e, red);
        p[tid] = e; __syncthreads();
        const int d = tid & 127, half = tid >> 7; float o = 0.f; const int j0 = half * 128, j1 = min(nsel, j0 + 128);
        for (int j = j0; j < j1; ++j) o += p[j] * bf2f(VA[vt_index(b * SEQ + sel[j], h, d)]);
        osum[tid] = o; __syncthreads();
        if (tid < 128) outbase[(size_t)m * 512 + h * 128 + tid] = (bf16_t)f2bf((osum[tid] + osum[tid + 128]) / sum);
        __syncthreads();
    }
}

__device__ __forceinline__ float softplus2(float z) { return fmaxf(z, 0.f) + log2f(1.f + exp2f(-fabsf(z))); }
__global__ __launch_bounds__(256) void k_sb_naive(char* ws) {
    __shared__ float q[128]; __shared__ float av[SEQ + 256]; __shared__ float csum[256]; __shared__ float osum[256];
    const int m = blockIdx.x >> 2, h = blockIdx.x & 3, b = m >> 13, t = m & (SEQ - 1), tid = threadIdx.x;
    bf16_t* SQ = (bf16_t*)(ws + WS_SQ) + (size_t)m * 512 + h * 128; const bf16_t* SK = (const bf16_t*)(ws + WS_SK); const bf16_t* SV = (const bf16_t*)(ws + WS_SV);
    if (tid < 128) q[tid] = bf2f(SQ[tid]);
    __syncthreads();
    for (int s = tid; s < t; s += 256) { const bf16x8* kp = (const bf16x8*)(SK + (size_t)(b * SEQ + s) * 512 + h * 128); float a = 0.f;
#pragma unroll
        for (int cc = 0; cc < 16; ++cc) { const bf16x8 kk = kp[cc];
#pragma unroll
            for (int j = 0; j < 8; ++j) a += q[cc * 8 + j] * bfs2f(kk[j]); }
        av[s + (s >> 5)] = a; }
    __syncthreads();
    float tot = 0.f;
    for (int i = 0; i < 32; ++i) { const int s = tid * 32 + i; if (s < t) tot -= softplus2(av[s + (s >> 5)]); }
    csum[tid] = tot; __syncthreads();
    float run = 0.f; for (int j = tid + 1; j < 256; ++j) run += csum[j];
    for (int i = 31; i >= 0; --i) { const int s = tid * 32 + i; const int ix = s + (s >> 5);
        if (s < t) { const float z = av[ix]; const float sp = softplus2(z); av[ix] = exp2f(z - sp + run); run -= sp; } else if (s < SEQ) av[ix] = 0.f; }
    __syncthreads();
    const int d = tid & 127, half = tid >> 7; const int hs = (t + 1) >> 1; const int s0 = half ? hs : 0, s1 = half ? t : hs; float o = 0.f;
    for (int s = s0; s < s1; ++s) o += av[s + (s >> 5)] * bf2f(SV[vt_index(b * SEQ + s, h, d)]);
    osum[tid] = o; __syncthreads();
    if (tid < 128) SQ[tid] = (bf16_t)f2bf(osum[tid] + osum[tid + 128]);
}

#ifndef TS_EPI
#define TS_EPI -1
#endif
__device__ unsigned long long g_dbg[4];
__device__ int g_phase;
namespace pg8 {
#define PG8_LAS __attribute__((address_space(3)))
typedef unsigned short bf16_t;
typedef short bf16x8 __attribute__((ext_vector_type(8)));
typedef float f32x4 __attribute__((ext_vector_type(4)));
typedef unsigned u32x4 __attribute__((ext_vector_type(4)));
constexpr int BM = 256, BK = 64, HALF = 128, HTB = HALF * BK * 2  , STAGE_BYTES = 8 * HTB, NXCD = 8, WGM = 8;

__host__ __device__ __forceinline__ int lds_byte(int r, int c) { const int st = (r >> 4) * 2 + (c >> 5), rr = r & 15, cc = c & 31, ob = rr * 64 + cc * 2; return st * 1024 + (ob ^ (((ob >> 9) & 1) << 5)); }
__host__ __device__ __forceinline__ void stage_rc(int b, int& R, int& C) { const int st = b / 1024, sb = b % 1024, swz = sb ^ (((sb >> 9) & 1) << 5); R = (st >> 1) * 16 + swz / 64; C = (st & 1) * 32 + (swz % 64) / 2; }
__host__ __device__ __forceinline__ int perm32(int rho) { const int n = rho >> 4, i = rho & 15; return 8 * (i >> 2) + 4 * n + (i & 3); }

struct Unit { int pm, pn; };
struct Gemm { const bf16_t* A; const bf16_t* Bt; int M, N, K; };

struct StaticOrder {
    int nM, nN, nwg, G, c;
    __host__ __device__ void init(int M, int N, int G_, int c_) { nM = M / BM; nN = N / BM; nwg = nM * nN; G = G_; c = c_; }
    __host__ __device__ bool next(int i, Unit& u) const {
        const long L = (long)i * G + c; if (L >= nwg) return false;
        int wgid = (int)L; { const int q = nwg / NXCD, r = nwg % NXCD, xcd = wgid % NXCD, off = wgid / NXCD; wgid = (xcd < r ? xcd * (q + 1) : r * (q + 1) + (xcd - r) * q) + off; }
        const int nig = WGM * nN, gid = wgid / nig, fm = gid * WGM, gsz = (nM - fm) < WGM ? (nM - fm) : WGM;
        u.pm = fm + ((wgid % nig) % gsz); u.pn = (wgid % nig) / gsz; return true;
    }
    __device__ __forceinline__ void a_ready(const Unit&) const {}
    __device__ __forceinline__ void done(const Unit&) const {}
};


template <class F, bool BRANCHED> struct EpiFn {
    static constexpr bool PERM = true, AFTER_DRAIN = false;
    F f;
    __device__ __forceinline__ void operator()(const f32x4 (&acc)[2][2][4][2], const Unit& u, int wr, int wc, int fr, int fq) const {
        int pm = u.pm, pn = u.pn, aux = 0;
        if (BRANCHED) { aux = u.pn >> 2; pn = u.pn & 3; pm = u.pm & 63; }
        const int row0 = pm * BM + wr * 64 + fr, col0 = pn * BM + wc * 32 + 8 * fq;
#pragma unroll
        for (int bj = 0; bj < 2; ++bj) {
            typename F::Prep pr; f.prep(pr, col0 + bj * HALF);
#pragma unroll
            for (int ai = 0; ai < 2; ++ai)
#pragma unroll
                for (int m = 0; m < 4; ++m) f.op8(pr, row0 + ai * HALF + m * 16, col0 + bj * HALF, acc[ai][bj][m][0], acc[ai][bj][m][1], aux);
        }
    }
};
template <class F, bool BRANCHED> struct EpiFnB {
    static constexpr bool PERM = true, AFTER_DRAIN = false;
    F f;
    __device__ __forceinline__ void operator()(const f32x4 (&acc)[2][2][4][2], const Unit& u, int wr, int wc, int fr, int fq) const {
        int pm = u.pm, pn = u.pn, aux = 0;
        if (BRANCHED) { aux = u.pn >> 2; pn = u.pn & 3; pm = u.pm & 63; }
        const int row0 = pm * BM + wr * 64 + fr, col0 = pn * BM + wc * 32 + 8 * fq;
#pragma unroll
        for (int bj = 0; bj < 2; ++bj) {
            typename F::Prep pr; f.prep(pr, col0 + bj * HALF);
#pragma unroll
            for (int p0 = 0; p0 < 8; p0 += F::NB) {
                typename F::Ld L[F::NB];
#pragma unroll
                for (int p = 0; p < F::NB; ++p) f.ld8(L[p], row0 + ((p0 + p) >> 2) * HALF + ((p0 + p) & 3) * 16, col0 + bj * HALF, aux);
#pragma unroll
                for (int p = 0; p < F::NB; ++p) f.op8b(pr, L[p], row0 + ((p0 + p) >> 2) * HALF + ((p0 + p) & 3) * 16, col0 + bj * HALF, acc[(p0 + p) >> 2][bj][(p0 + p) & 3][0], acc[(p0 + p) >> 2][bj][(p0 + p) & 3][1], aux);
            }
        }
    }
};
struct EpiInProj {
    static constexpr bool PERM = true, AFTER_DRAIN = false;
    char* ws; PG8_LAS unsigned char* lds; const float* g_qa; const float* g_ka; const float* g_kidx; const float* part;
    __device__ __forceinline__ void operator()(const f32x4 (&acc_)[2][2][4][2], const Unit& u, int wr, int wc, int fr_, int fq_) const {
        int fr = fr_, fq = fq_; asm volatile("" : "+v"(fr), "+v"(fq));
        const int pn = u.pn, row0 = u.pm * BM + wr * 64 + fr, cw = wc * 32 + 8 * fq;
        f32x4 (&acc)[2][2][4][2] = const_cast<f32x4 (&)[2][2][4][2]>(acc_);
        if (part) {
#pragma unroll
            for (int ai = 0; ai < 2; ++ai)
#pragma unroll
                for (int m = 0; m < 4; ++m) { const f32x4 p = *(const f32x4*)(part + (size_t)(row0 + ai * HALF + m * 16) * 4); const float r = rsqrtf(((p.x + p.y) + (p.z + p.w)) * (1.f / 1024.f) + EPS);
#pragma unroll
                    for (int bj = 0; bj < 2; ++bj) { acc[ai][bj][m][0] = acc[ai][bj][m][0] * r; acc[ai][bj][m][1] = acc[ai][bj][m][1] * r; } }
        }
        const float* rope = (const float*)(ws + WS_ROPE);
        if ((pn >= 8 && pn < 12) || (pn >= 14 && pn < 18)) {
            const bool glu = pn < 12; bf16_t* dst = (bf16_t*)(ws + (glu ? WS_GLUA : WS_GC)) + (glu ? pn - 8 : pn - 14) * 128 + cw;
#pragma unroll
            for (int ai = 0; ai < 2; ++ai)
#pragma unroll
                for (int m = 0; m < 4; ++m) { const int row = row0 + ai * HALF + m * 16;
                    const f32x4 a0 = acc[ai][0][m][0], a1 = acc[ai][0][m][1], b0 = acc[ai][1][m][0], b1 = acc[ai][1][m][1];
                    if (glu) store8bf(dst + (size_t)row * 512, a0 * sig4(b0), a1 * sig4(b1)); else store8bf(dst + (size_t)row * 512, a0 * b0, a1 * b1); }
        } else if (pn < 4) {
            const bool isq = pn < 2; const float* gain = isq ? g_qa : g_ka; const float osc = isq ? QSCALE : 1.f;
            const f32x4 gA = *(const f32x4*)(gain + cw), gB = *(const f32x4*)(gain + cw + 4);
            PG8_LAS float* P = (PG8_LAS float*)(lds + 131072);
#pragma unroll
            for (int ai = 0; ai < 2; ++ai)
#pragma unroll
                for (int m = 0; m < 4; ++m)
#pragma unroll
                    for (int bj = 0; bj < 2; ++bj) { const f32x4 a = acc[ai][bj][m][0], b = acc[ai][bj][m][1];
                        float ss = (a.x * a.x + a.y * a.y) + (a.z * a.z + a.w * a.w) + (b.x * b.x + b.y * b.y) + (b.z * b.z + b.w * b.w);
                        ss += __shfl_xor(ss, 16); ss += __shfl_xor(ss, 32);
                        if (fq == 0) P[((ai * HALF + wr * 64 + m * 16 + fr) * 2 + bj) * 4 + wc] = ss; }
            asm volatile("s_waitcnt lgkmcnt(0)" ::: "memory"); __builtin_amdgcn_s_barrier(); asm volatile("" ::: "memory");
            bf16_t* dst = (bf16_t*)(ws + (isq ? WS_QA : WS_KA)) + (pn & 1) * 256 + cw;
            const float sg = (fq < 2) ? -1.f : 1.f;
#pragma unroll
            for (int ai = 0; ai < 2; ++ai)
#pragma unroll
                for (int m2 = 0; m2 < 4; m2 += 2) {
                    f32x4 rc[2][2], rs[2][2];
                    if (wc == 0) {
#pragma unroll
                        for (int mm = 0; mm < 2; ++mm) { const float* rt = rope + (size_t)(u.pm * BM + ai * HALF + wr * 64 + (m2 + mm) * 16 + fr) * 48 + 8 * (fq & 1);
#pragma unroll
                            for (int hh = 0; hh < 2; ++hh) { rc[mm][hh] = *(const f32x4*)(rt + 4 * hh); rs[mm][hh] = *(const f32x4*)(rt + 16 + 4 * hh); } } }
#pragma unroll
                    for (int mm = 0; mm < 2; ++mm) { const int m = m2 + mm; const int rl = ai * HALF + wr * 64 + m * 16 + fr, row = u.pm * BM + rl;
#pragma unroll
                    for (int bj = 0; bj < 2; ++bj) { const f32x4 p4 = *(const PG8_LAS f32x4*)(P + (rl * 2 + bj) * 4);
                        const float r = rsqrtf(((p4.x + p4.y) + (p4.z + p4.w)) * (1.f / 128.f) + EPS);
                        f32x4 yy[2];
#pragma unroll
                        for (int hh = 0; hh < 2; ++hh) {
                            f32x4 y = acc[ai][bj][m][hh] * r * (hh ? gB : gA);
                            if (wc == 0) {
                                const f32x4 c = rc[mm][hh], sn = rs[mm][hh];
                                f32x4 q; q.x = __shfl_xor(y.x, 32); q.y = __shfl_xor(y.y, 32); q.z = __shfl_xor(y.z, 32); q.w = __shfl_xor(y.w, 32);
                                y = y * c + q * sn * sg; }
                            yy[hh] = y * osc; }
                        store8bf(dst + (size_t)row * 512 + bj * HALF, yy[0], yy[1]); } }
                    asm volatile("" ::: "memory"); }
        } else if (pn == 6) {
            bf16_t* dst = (bf16_t*)(ws + WS_IDX) + cw;
#pragma unroll
            for (int ai = 0; ai < 2; ++ai)
#pragma unroll
                for (int m = 0; m < 4; ++m) { const int row = row0 + ai * HALF + m * 16;
                    f32x4 c0 = (f32x4){1.f, 1.f, 1.f, 1.f}, c1 = c0, s0 = (f32x4){0.f, 0.f, 0.f, 0.f}, s1 = s0;
                    if ((wc & 1) == 0) { const float* rt = rope + (size_t)row * 48 + 32; c0 = *(const f32x4*)rt; c1 = *(const f32x4*)(rt + 4); s0 = *(const f32x4*)(rt + 8); s1 = *(const f32x4*)(rt + 12); }
#pragma unroll
                    for (int bj = 0; bj < 2; ++bj) { f32x4 y0 = acc[ai][bj][m][0], y1 = acc[ai][bj][m][1];
                        if ((wc & 1) == 0) {
                            f32x4 q0, q1; q0.x = __shfl_xor(y0.x, 16); q0.y = __shfl_xor(y0.y, 16); q0.z = __shfl_xor(y0.z, 16); q0.w = __shfl_xor(y0.w, 16);
                            q1.x = __shfl_xor(y1.x, 16); q1.y = __shfl_xor(y1.y, 16); q1.z = __shfl_xor(y1.z, 16); q1.w = __shfl_xor(y1.w, 16);
                            if (fq < 2) { const float sg = (fq == 0) ? -1.f : 1.f; y0 = y0 * c0 + q0 * s0 * sg; y1 = y1 * c1 + q1 * s1 * sg; } }
                        store8bf(dst + (size_t)row * 512 + bj * HALF, y0, y1); }
                    asm volatile("" ::: "memory"); __builtin_amdgcn_sched_barrier(0); }
        } else if (pn == 7) {
            PG8_LAS float* P = (PG8_LAS float*)(lds + 131072);
#pragma unroll
            for (int ai = 0; ai < 2; ++ai)
#pragma unroll
                for (int m = 0; m < 4; ++m) { const f32x4 a = acc[ai][0][m][0], b = acc[ai][0][m][1];
                    float ss = (a.x * a.x + a.y * a.y) + (a.z * a.z + a.w * a.w) + (b.x * b.x + b.y * b.y) + (b.z * b.z + b.w * b.w);
                    ss += __shfl_xor(ss, 16); ss += __shfl_xor(ss, 32);
                    if (fq == 0 && wc < 2) P[(ai * HALF + wr * 64 + m * 16 + fr) * 2 + wc] = ss; }
            asm volatile("s_waitcnt lgkmcnt(0)" ::: "memory"); __builtin_amdgcn_s_barrier(); asm volatile("" ::: "memory");
            bf16_t* dst = (bf16_t*)(ws + WS_IDX) + 256 + cw;
            const f32x4 gA = (wc < 2) ? *(const f32x4*)(g_kidx + cw) : (f32x4){1.f, 1.f, 1.f, 1.f}, gB = (wc < 2) ? *(const f32x4*)(g_kidx + cw + 4) : (f32x4){1.f, 1.f, 1.f, 1.f};
#pragma unroll
            for (int ai = 0; ai < 2; ++ai)
#pragma unroll
                for (int m = 0; m < 4; ++m) { const int rl = ai * HALF + wr * 64 + m * 16 + fr, row = u.pm * BM + rl;
                    f32x4 y0 = acc[ai][0][m][0], y1 = acc[ai][0][m][1];
                    if (wc < 2) { const float r = rsqrtf((P[rl * 2] + P[rl * 2 + 1]) * (1.f / 64.f) + EPS); y0 = y0 * r * gA; y1 = y1 * r * gB; }
                    if (wc == 0) { const float* rt = rope + (size_t)row * 48 + 32; const f32x4 c0 = *(const f32x4*)rt, c1 = *(const f32x4*)(rt + 4), s0 = *(const f32x4*)(rt + 8), s1 = *(const f32x4*)(rt + 12);
                        f32x4 q0, q1; q0.x = __shfl_xor(y0.x, 16); q0.y = __shfl_xor(y0.y, 16); q0.z = __shfl_xor(y0.z, 16); q0.w = __shfl_xor(y0.w, 16);
                        q1.x = __shfl_xor(y1.x, 16); q1.y = __shfl_xor(y1.y, 16); q1.z = __shfl_xor(y1.z, 16); q1.w = __shfl_xor(y1.w, 16);
                        if (fq < 2) { const float sg = (fq == 0) ? -1.f : 1.f; y0 = y0 * c0 + q0 * s0 * sg; y1 = y1 * c1 + q1 * s1 * sg; } }
                    store8bf(dst + (size_t)row * 512, y0, y1);
                    if (wc < 2) store8bf((bf16_t*)(ws + WS_KIF) + (((size_t)(row >> 5) * 4 + 2 * wc + (fq >> 1)) * 64 + (row & 31) + 32 * (fq & 1)) * 8, y0, y1);
                    store8bf(dst + (size_t)row * 512 + HALF, acc[ai][1][m][0], acc[ai][1][m][1]);
                    asm volatile("" ::: "memory"); __builtin_amdgcn_sched_barrier(0); }
        } else if (pn == 4 || pn == 5 || pn >= 22) {
            bf16_t* vt = (bf16_t*)(ws + (pn < 6 ? WS_VA : WS_SV));
            PG8_LAS unsigned char* scr = lds + 131072 + (wr * 4 + wc) * 2304;
            const int ln = fq * 16 + fr;
#pragma unroll
            for (int pa = 0; pa < 8; ++pa) {
                const int ai = pa >> 2, bj = (pa >> 1) & 1, h2 = pa & 1;
                if ((fq >> 1) == h2) {
#pragma unroll
                    for (int m = 0; m < 4; ++m) {
                        const f32x4 a = acc[ai][bj][m][0], b = acc[ai][bj][m][1];
                        const unsigned w0 = pk2(a.x, a.y), w1 = pk2(a.z, a.w), w2 = pk2(b.x, b.y), w3 = pk2(b.z, b.w);
                        PG8_LAS unsigned char* d0 = scr + (8 * (fq & 1)) * 144 + (16 * m + fr) * 2;
                        *(PG8_LAS unsigned short*)(d0 + 0 * 144) = (unsigned short)w0; *(PG8_LAS unsigned short*)(d0 + 1 * 144) = (unsigned short)(w0 >> 16);
                        *(PG8_LAS unsigned short*)(d0 + 2 * 144) = (unsigned short)w1; *(PG8_LAS unsigned short*)(d0 + 3 * 144) = (unsigned short)(w1 >> 16);
                        *(PG8_LAS unsigned short*)(d0 + 4 * 144) = (unsigned short)w2; *(PG8_LAS unsigned short*)(d0 + 5 * 144) = (unsigned short)(w2 >> 16);
                        *(PG8_LAS unsigned short*)(d0 + 6 * 144) = (unsigned short)w3; *(PG8_LAS unsigned short*)(d0 + 7 * 144) = (unsigned short)(w3 >> 16);
                    }
                }
                asm volatile("s_waitcnt lgkmcnt(0)" ::: "memory");
                const int blk = u.pm * 4 + ai * 2 + wr, hd = (pn & 1) * 2 + bj;
                bf16_t* dp = vt + ((size_t)(blk * 4 + hd) * 128 + wc * 32 + h2 * 16) * 64;
                const u32x4 r0 = *(const PG8_LAS u32x4*)(scr + (ln >> 3) * 144 + (ln & 7) * 16), r1 = *(const PG8_LAS u32x4*)(scr + (8 + (ln >> 3)) * 144 + (ln & 7) * 16);
                *(u32x4*)(dp + (size_t)ln * 8) = r0; *(u32x4*)(dp + (size_t)(64 + ln) * 8) = r1;
                asm volatile("s_waitcnt lgkmcnt(0)" ::: "memory");
            }
        } else {
            const size_t off = pn < 6 ? WS_VA : pn < 14 ? WS_GB : pn < 20 ? WS_SQ : pn < 22 ? WS_SK : WS_SV;
            const float sc = (pn == 18 || pn == 19) ? QSCALE : 1.f;
            bf16_t* dst = (bf16_t*)(ws + off) + (pn & 1) * 256 + cw;
#pragma unroll
            for (int ai = 0; ai < 2; ++ai)
#pragma unroll
                for (int m = 0; m < 4; ++m)
#pragma unroll
                    for (int bj = 0; bj < 2; ++bj) store8bf(dst + (size_t)(row0 + ai * HALF + m * 16) * 512 + bj * HALF, acc[ai][bj][m][0] * sc, acc[ai][bj][m][1] * sc);
        }
    }
};
template <bool SRC_BF> struct EpiResidNorm {
    static constexpr bool PERM = true, AFTER_DRAIN = false;
    bf16_t* x1; const void* src; const float* g2; bf16_t* xg; float* part; PG8_LAS unsigned char* lds; float scale; int pad;
    __device__ __forceinline__ void operator()(const f32x4 (&acc)[2][2][4][2], const Unit& u, int wr, int wc, int fr_, int fq_) const {
        int fr = fr_, fq = fq_; asm volatile("" : "+v"(fr), "+v"(fq));
        const int pn = u.pn, cw = pn * BM + wc * 32 + 8 * fq;
        PG8_LAS float* P = (PG8_LAS float*)(lds + 131072);
        const f32x4 ga0 = *(const f32x4*)(g2 + cw), gb0 = *(const f32x4*)(g2 + cw + 4), ga1 = *(const f32x4*)(g2 + cw + HALF), gb1 = *(const f32x4*)(g2 + cw + HALF + 4);
#pragma unroll
        for (int ai = 0; ai < 2; ++ai) {
            u32x4 raw[4][2]; f32x4 f0[4][2], f1[4][2];
#pragma unroll
            for (int m = 0; m < 4; ++m)
#pragma unroll
                for (int bj = 0; bj < 2; ++bj) { const size_t o = (size_t)(u.pm * BM + ai * HALF + wr * 64 + m * 16 + fr) * DM + cw + bj * HALF;
                    if (SRC_BF) raw[m][bj] = *(const u32x4*)((const bf16_t*)src + o); else { const f32x4* q = (const f32x4*)((const float*)src + o); f0[m][bj] = q[0]; f1[m][bj] = q[1]; } }
#pragma unroll
            for (int m = 0; m < 4; ++m) { const int rl = ai * HALF + wr * 64 + m * 16 + fr; const size_t ro = (size_t)(u.pm * BM + rl) * DM + cw; float ss = 0.f;
#pragma unroll
                for (int bj = 0; bj < 2; ++bj) { const size_t o = ro + bj * HALF; f32x4 x0, xv;
                    if (SRC_BF) unpack8bf(raw[m][bj], x0, xv); else { x0 = f0[m][bj]; xv = f1[m][bj]; }
                    x0 = x0 + acc[ai][bj][m][0] * scale; xv = xv + acc[ai][bj][m][1] * scale;
                    store8bf(x1 + o, x0, xv); store8bf(xg + o, x0 * (bj ? ga1 : ga0), xv * (bj ? gb1 : gb0));
                    ss += ((x0.x * x0.x + x0.y * x0.y) + (x0.z * x0.z + x0.w * x0.w)) + ((xv.x * xv.x + xv.y * xv.y) + (xv.z * xv.z + xv.w * xv.w)); }
                ss += __shfl_xor(ss, 16); ss += __shfl_xor(ss, 32);
                if (fq == 0) P[rl * 4 + wc] = ss; }
        }
        asm volatile("s_waitcnt lgkmcnt(0)" ::: "memory"); __builtin_amdgcn_s_barrier(); asm volatile("" ::: "memory");
        if (wc == 0 && fq == 0) {
#pragma unroll
            for (int ai = 0; ai < 2; ++ai)
#pragma unroll
                for (int m = 0; m < 4; ++m) { const int rl = ai * HALF + wr * 64 + m * 16 + fr; const f32x4 p4 = *(const PG8_LAS f32x4*)(P + rl * 4);
                    part[(size_t)(u.pm * BM + rl) * 4 + pn] = (p4.x + p4.y) + (p4.z + p4.w); }
        }
    }
};
struct BranchOrder {
    StaticOrder S;
    __device__ void init(int G_, int c_) { S.init(16384, 1024, G_, c_); }
    __device__ bool next(int i, Unit& u) const { Unit t; if (!S.next(i >> 2, t)) return false; const int br = i & 3; u.pm = br * 64 + t.pm; u.pn = br * 4 + t.pn; return true; }
    __device__ __forceinline__ void a_ready(const Unit&) const {}
    __device__ __forceinline__ void done(const Unit&) const {}
};

template <class Epi, class Sched, bool ALIGN_EPI = false, bool SP2 = false>
__device__ __forceinline__ void gemm_phase(PG8_LAS unsigned char* lds, const Gemm g, const Sched& S, const Epi& E) {
    const int tid = threadIdx.x, wid = __builtin_amdgcn_readfirstlane(tid >> 6), lane = tid & 63, wr = wid >> 2, wc = wid & 3, fr = lane & 15, fq = lane >> 4;
    const int K = g.K, nt = K / BK;
    unsigned voffA[2], voffB[2];
#pragma unroll
    for (int i = 0; i < 2; ++i) { int R, C; stage_rc(tid * 16 + i * 8192, R, C); const int Rb = Epi::PERM ? ((R & ~31) + perm32(R & 31)) : R;
        voffA[i] = (unsigned)(R * K + C) * 2u; voffB[i] = (unsigned)(Rb * K + C) * 2u; }
    const size_t kstep = (size_t)(BK * 2);
    const size_t hstep = (size_t)HALF * K * 2;
    const size_t tstep = 2 * hstep;
    const unsigned ldsw = (unsigned)wid * 1024u;
    const int aoff = lds_byte(wr * 64 + fr, fq * 8), boff = lds_byte(wc * 32 + fr, fq * 8);
#define PG8_SA(b, h) (((b) * 2 + (h)) * HTB)
#define PG8_SB(b, h) ((4 + (b) * 2 + (h)) * HTB)
#define PG8_STAGE(bufoff, gbase, voff) do { _Pragma("unroll") for (int _i = 0; _i < 2; ++_i) \
        __builtin_amdgcn_global_load_lds((const unsigned*)((const char*)(gbase) + (voff)[_i]), (PG8_LAS unsigned*)(lds + (bufoff) + ldsw + _i * 8192), 16, 0, 0); } while (0)
#define PG8_LDA(dst, b, h) do { _Pragma("unroll") for (int m = 0; m < 4; ++m) _Pragma("unroll") for (int k = 0; k < 2; ++k) dst[m][k] = *(const PG8_LAS bf16x8*)(lds + PG8_SA(b, h) + aoff + m * 2048 + k * 1024); } while (0)
#define PG8_LDB(dst, b, h) do { _Pragma("unroll") for (int n = 0; n < 2; ++n) _Pragma("unroll") for (int k = 0; k < 2; ++k) dst[n][k] = *(const PG8_LAS bf16x8*)(lds + PG8_SB(b, h) + boff + n * 2048 + k * 1024); } while (0)
#define PG8_MMA(ai, bj, At, Bt) do { __builtin_amdgcn_s_setprio(1); _Pragma("unroll") for (int m = 0; m < 4; ++m) _Pragma("unroll") for (int n = 0; n < 2; ++n) _Pragma("unroll") for (int k = 0; k < 2; ++k) \
        acc[ai][bj][m][n] = __builtin_amdgcn_mfma_f32_16x16x32_bf16(Bt[n][k], At[m][k], acc[ai][bj][m][n], 0, 0, 0); __builtin_amdgcn_s_setprio(0); } while (0)
#define PG8_WAIT_V(n) asm volatile("s_waitcnt vmcnt(" #n ")" ::: "memory")
#define PG8_WAIT_L(n) asm volatile("s_waitcnt lgkmcnt(" #n ")" ::: "memory")
#define PG8_BAR __builtin_amdgcn_s_barrier()
#define PG8_SCHED __builtin_amdgcn_sched_barrier(0)
    Unit cur, nxt; int ui = 0;
    if (!S.next(0, cur)) return;
    f32x4 acc[2][2][4][2];
#pragma unroll
    for (int a = 0; a < 2; ++a)
#pragma unroll
        for (int b = 0; b < 2; ++b)
#pragma unroll
            for (int m = 0; m < 4; ++m)
#pragma unroll
                for (int n = 0; n < 2; ++n) acc[a][b][m][n] = (f32x4){0.f, 0.f, 0.f, 0.f};
    bf16x8 At[4][2], B0[2][2], B1[2][2];
    const char* cA = (const char*)g.A + (size_t)cur.pm * tstep; const char* cB = (const char*)g.Bt + (size_t)cur.pn * tstep;
    S.a_ready(cur);
    if constexpr (SP2) {
        PG8_STAGE(PG8_SB(0, 0), cB, voffB); PG8_STAGE(PG8_SB(0, 1), cB + hstep, voffB); PG8_STAGE(PG8_SA(0, 0), cA, voffA); PG8_STAGE(PG8_SA(0, 1), cA + hstep, voffA);
        if (wr == 1) PG8_BAR;
        PG8_WAIT_V(2); PG8_BAR;
        PG8_STAGE(PG8_SB(1, 0), cB + kstep, voffB); PG8_STAGE(PG8_SA(1, 0), cA + kstep, voffA); PG8_STAGE(PG8_SB(1, 1), cB + hstep + kstep, voffB);
        PG8_WAIT_V(6); PG8_BAR;
    } else {
        PG8_STAGE(PG8_SB(0, 0), cB, voffB); PG8_STAGE(PG8_SA(0, 0), cA, voffA); PG8_STAGE(PG8_SB(0, 1), cB + hstep, voffB); PG8_STAGE(PG8_SA(0, 1), cA + hstep, voffA);
        if (wr == 1) PG8_BAR;
        PG8_WAIT_V(4); PG8_BAR;
        PG8_STAGE(PG8_SB(1, 0), cB + kstep, voffB); PG8_STAGE(PG8_SA(1, 0), cA + kstep, voffA); PG8_STAGE(PG8_SB(1, 1), cB + hstep + kstep, voffB);
        PG8_WAIT_V(6); PG8_BAR;
    }
    for (;;) {
        const bool has_next = S.next(ui + 1, nxt);
        const char* nA = has_next ? (const char*)g.A + (size_t)nxt.pm * tstep : cA; const char* nB = has_next ? (const char*)g.Bt + (size_t)nxt.pn * tstep : cB;
        for (int t = 0; t < nt; t += 2) {
            const bool last = (t == nt - 2);
            const char* a1 = cA + (size_t)(t + 1) * kstep;
            const char* a2 = last ? nA : cA + (size_t)(t + 2) * kstep; const char* b2 = last ? nB : cB + (size_t)(t + 2) * kstep;
            const char* a3 = a2 + kstep; const char* b3 = b2 + kstep;
            if (last && has_next) S.a_ready(nxt);
            if constexpr (SP2) {
            PG8_LDB(B0, 0, 0); PG8_LDB(B1, 0, 1); PG8_SCHED; PG8_LDA(At, 0, 0); PG8_STAGE(PG8_SA(1, 1), a1 + hstep, voffA);
            PG8_WAIT_V(8); PG8_WAIT_L(0); PG8_BAR; PG8_MMA(0, 0, At, B0); PG8_MMA(0, 1, At, B1); PG8_BAR; PG8_SCHED;
            PG8_LDA(At, 0, 1); PG8_STAGE(PG8_SB(0, 0), b2, voffB); PG8_STAGE(PG8_SB(0, 1), b2 + hstep, voffB); PG8_STAGE(PG8_SA(0, 0), a2, voffA);
            PG8_WAIT_V(8); PG8_WAIT_L(0); PG8_BAR; PG8_MMA(1, 0, At, B0); PG8_MMA(1, 1, At, B1); PG8_BAR; PG8_SCHED;
            PG8_LDB(B0, 1, 0); PG8_LDB(B1, 1, 1); PG8_SCHED; PG8_LDA(At, 1, 0); PG8_STAGE(PG8_SA(0, 1), a2 + hstep, voffA);
            PG8_WAIT_V(8); PG8_WAIT_L(0); PG8_BAR; PG8_MMA(0, 0, At, B0); PG8_MMA(0, 1, At, B1); PG8_BAR; PG8_SCHED;
            PG8_LDA(At, 1, 1); PG8_STAGE(PG8_SB(1, 0), b3, voffB); PG8_STAGE(PG8_SB(1, 1), b3 + hstep, voffB); PG8_STAGE(PG8_SA(1, 0), a3, voffA);
            PG8_WAIT_V(8); PG8_WAIT_L(0); PG8_BAR; PG8_MMA(1, 0, At, B0); PG8_MMA(1, 1, At, B1); PG8_BAR; PG8_SCHED;
            } else {
            PG8_LDB(B0, 0, 0); PG8_SCHED; PG8_LDA(At, 0, 0); PG8_STAGE(PG8_SA(1, 1), a1 + hstep, voffA);
            PG8_WAIT_L(8); PG8_BAR; PG8_WAIT_L(0); PG8_MMA(0, 0, At, B0); PG8_BAR; PG8_SCHED;
            PG8_LDB(B1, 0, 1); PG8_STAGE(PG8_SB(0, 0), b2, voffB);
            PG8_BAR; PG8_WAIT_L(0); PG8_MMA(0, 1, At, B1); PG8_BAR;
            PG8_LDA(At, 0, 1); PG8_STAGE(PG8_SA(0, 0), a2, voffA);
            PG8_BAR; PG8_WAIT_L(0); PG8_MMA(1, 0, At, B0); PG8_BAR; PG8_SCHED;
            PG8_STAGE(PG8_SB(0, 1), b2 + hstep, voffB);
            PG8_WAIT_V(6); PG8_BAR; PG8_MMA(1, 1, At, B1); PG8_BAR;
            PG8_LDB(B0, 1, 0); PG8_SCHED; PG8_LDA(At, 1, 0); PG8_STAGE(PG8_SA(0, 1), a2 + hstep, voffA);
            PG8_WAIT_L(8); PG8_BAR; PG8_WAIT_L(0); PG8_MMA(0, 0, At, B0); PG8_BAR; PG8_SCHED;
            PG8_LDB(B1, 1, 1); PG8_STAGE(PG8_SB(1, 0), b3, voffB);
            PG8_BAR; PG8_WAIT_L(0); PG8_MMA(0, 1, At, B1); PG8_BAR;
            PG8_LDA(At, 1, 1); PG8_STAGE(PG8_SA(1, 0), a3, voffA);
            PG8_BAR; PG8_WAIT_L(0); PG8_MMA(1, 0, At, B0); PG8_BAR; PG8_SCHED;
            PG8_STAGE(PG8_SB(1, 1), b3 + hstep, voffB);
            PG8_WAIT_V(6); PG8_BAR; PG8_MMA(1, 1, At, B1); PG8_BAR;
            }
        }
        if constexpr (ALIGN_EPI) { if (wr == 0) PG8_BAR; }
        if constexpr (!Epi::AFTER_DRAIN) {
#if TS_EPI >= 0
            unsigned long long te0 = 0ull; const bool stamp = (blockIdx.x == 0 && threadIdx.x == 0 && g_phase == TS_EPI); if (stamp) te0 = __builtin_amdgcn_s_memrealtime();
#endif
            E(acc, cur, wr, wc, fr, fq); S.done(cur);
#if TS_EPI >= 0
            if (stamp) { asm volatile("s_waitcnt vmcnt(0)" ::: "memory"); g_dbg[0] += __builtin_amdgcn_s_memrealtime() - te0; g_dbg[1] += 1ull; }
#endif
        }
        if (!has_next) break;
#pragma unroll
        for (int a = 0; a < 2; ++a)
#pragma unroll
            for (int b = 0; b < 2; ++b)
#pragma unroll
                for (int m = 0; m < 4; ++m)
#pragma unroll
                    for (int n = 0; n < 2; ++n) acc[a][b][m][n] = (f32x4){0.f, 0.f, 0.f, 0.f};
        cur = nxt; cA = nA; cB = nB; ++ui;
        if constexpr (ALIGN_EPI) { if (wr == 1) PG8_BAR; }
    }
    PG8_WAIT_V(0);
    if constexpr (!ALIGN_EPI) { if (wr == 0) PG8_BAR; }
    PG8_BAR;
    if constexpr (Epi::AFTER_DRAIN) { E.fused(acc, cur, wr, wc, fr, fq, lds, wid, lane); S.done(cur); }
#undef PG8_SA
#undef PG8_SB
#undef PG8_STAGE
#undef PG8_LDA
#undef PG8_LDB
#undef PG8_MMA
#undef PG8_WAIT_V
#undef PG8_WAIT_L
#undef PG8_BAR
#undef PG8_SCHED
}
}

#define LAS __attribute__((address_space(3)))
typedef float f32x16 __attribute__((ext_vector_type(16)));
typedef float f32x2_t __attribute__((ext_vector_type(2)));
typedef __bf16 bf16x2_t __attribute__((ext_vector_type(2)));
#define MFMA32(a, b, c) __builtin_amdgcn_mfma_f32_32x32x16_bf16((a), (b), (c), 0, 0, 0)
__device__ __forceinline__ unsigned cvtpk(float lo, float hi) { f32x2_t v = {lo, hi}; bf16x2_t b = __builtin_convertvector(v, bf16x2_t); return __builtin_bit_cast(unsigned, b); }
__device__ __forceinline__ int kappa(int i) { return (i & ~12) | ((i & 4) << 1) | ((i & 8) >> 1); }
#define PACK8(P, S) __builtin_bit_cast(bf16x8, (u32x4){cvtpk(P[8 * (S) + 0], P[8 * (S) + 1]), cvtpk(P[8 * (S) + 2], P[8 * (S) + 3]), cvtpk(P[8 * (S) + 4], P[8 * (S) + 5]), cvtpk(P[8 * (S) + 6], P[8 * (S) + 7])})

__device__ __forceinline__ void load_kfrag(bf16x8 (&kf)[8], const bf16_t* K, int rowbase, int kb, int h, int r32, int hi) {
    const bf16_t* p = K + (size_t)(rowbase + kb * 32 + kappa(r32)) * 512 + h * 128 + 8 * hi;
#pragma unroll
    for (int s = 0; s < 8; ++s) kf[s] = *(const bf16x8*)(p + 16 * s);
}
__device__ __forceinline__ void load_vfrag(bf16x8 (&vf)[4][2], const bf16_t* VT, int rowbase, int kb, int h, int r32, int hi) {
    const int blk64 = (rowbase + kb * 32) >> 6;
    const bf16_t* p = VT + ((size_t)(blk64 * 4 + h) * 128 + r32) * 64 + (kb & 1) * 32 + 8 * hi;
#pragma unroll
    for (int db = 0; db < 4; ++db) { vf[db][0] = *(const bf16x8*)(p + (size_t)db * 32 * 64); vf[db][1] = *(const bf16x8*)(p + (size_t)db * 32 * 64 + 16); }
}
__device__ __forceinline__ void sb_item(char* ws, bf16_t* Ob, int b, int h, int qb, int lane) {
    const int r32 = lane & 31, hi = lane >> 5, rowbase = b * SEQ, q0 = qb * 32;
    bf16_t* Q = (bf16_t*)(ws + WS_SQ); const bf16_t* K = (const bf16_t*)(ws + WS_SK); const bf16_t* VT = (const bf16_t*)(ws + WS_SV);
    bf16x8 qf[8];
    { const bf16_t* qp = Q + (size_t)(rowbase + q0 + r32) * 512 + h * 128 + 8 * hi;
#pragma unroll
      for (int s = 0; s < 8; ++s) qf[s] = *(const bf16x8*)(qp + 16 * s); }
    f32x16 o[4];
#pragma unroll
    for (int db = 0; db < 4; ++db)
#pragma unroll
        for (int r = 0; r < 16; ++r) o[db][r] = 0.f;
    float carry = 1.f;
    for (int kb = qb; kb >= 0; --kb) {
        bf16x8 kf[8]; load_kfrag(kf, K, rowbase, kb, h, r32, hi);
        bf16x8 vf[4][2]; load_vfrag(vf, VT, rowbase, kb, h, r32, hi);
        f32x16 p;
#pragma unroll
        for (int r = 0; r < 16; ++r) p[r] = 0.f;
#pragma unroll
        for (int s = 0; s < 8; ++s) p = MFMA32(kf[s], qf[s], p);
        const bool diag = (kb == qb);
        float kp[16];
#pragma unroll
        for (int r = 0; r < 16; ++r) {
            const float e = __builtin_amdgcn_exp2f(fminf(p[r], 80.f)); const float rinv = __builtin_amdgcn_rcpf(1.f + e);
            const bool valid = !diag || (((r & 7) + 8 * hi + 16 * (r >> 3)) < r32);
            kp[r] = valid ? rinv : 1.f; p[r] = valid ? e * rinv : 0.f;
        }
        float ex1 = 1.f, ex0 = 1.f;
#pragma unroll
        for (int r = 15; r >= 8; --r) { p[r] *= ex1; ex1 *= kp[r]; }
#pragma unroll
        for (int r = 7; r >= 0; --r) { p[r] *= ex0; ex0 *= kp[r]; }
        const float oT1 = __shfl_xor(ex1, 32), oT0 = __shfl_xor(ex0, 32);
        const float T11 = hi ? ex1 : oT1, T01 = hi ? oT1 : ex1, T10 = hi ? ex0 : oT0, T00 = hi ? oT0 : ex0;
        const float c1 = carry * T11, c2 = c1 * T01, c3 = c2 * T10;
        const float off1 = hi ? carry : c1, off0 = hi ? c2 : c3;
#pragma unroll
        for (int r = 8; r < 16; ++r) p[r] *= off1;
#pragma unroll
        for (int r = 0; r < 8; ++r) p[r] *= off0;
        carry = c3 * T00;
        const bf16x8 pb0 = PACK8(p, 0), pb1 = PACK8(p, 1);
#pragma unroll
        for (int db = 0; db < 4; ++db) { o[db] = MFMA32(vf[db][0], pb0, o[db]); o[db] = MFMA32(vf[db][1], pb1, o[db]); }
        if (__all(carry < 1e-12f)) break;
    }
    bf16_t* orow = Ob + (size_t)(rowbase + q0 + r32) * 512 + h * 128;
#pragma unroll
    for (int db = 0; db < 4; ++db)
#pragma unroll
        for (int g = 0; g < 4; ++g) { u32x2 w; w.x = cvtpk(o[db][4 * g], o[db][4 * g + 1]); w.y = cvtpk(o[db][4 * g + 2], o[db][4 * g + 3]); *(u32x2*)(orow + db * 32 + 8 * g + 4 * hi) = w; }
}
__device__ __forceinline__ void attnA_unit(LAS unsigned char* lds, char* ws, bf16_t* Ob, int b, int h, int qblk, float negC) {
    constexpr int KP = 272, VP = 144, KBYTES = 64 * KP, BUF = KBYTES + 128 * VP;
    const int tid = threadIdx.x, lane = tid & 63, wave = __builtin_amdgcn_readfirstlane(tid >> 6), r32 = lane & 31, hi = lane >> 5, rowbase = b * SEQ;
    const int qsub = wave & 3, kpar = wave >> 2, qb = qblk * 4 + qsub, q0 = qb * 32, ntiles = 2 * qblk + 2;
    const bf16_t* Q = (const bf16_t*)(ws + WS_QA); const bf16_t* Kg = (const bf16_t*)(ws + WS_KA) + (size_t)rowbase * 512 + h * 128;
    const bf16_t* Vg = (const bf16_t*)(ws + WS_VA) + ((size_t)(rowbase >> 6) * 4 + h) * 8192;
    const unsigned* mrow = (const unsigned*)(ws + WS_MASK) + (size_t)(rowbase + q0 + r32) * 256;
    const int kr0 = tid >> 4, kc = tid & 15, vd0 = tid >> 3, vc = tid & 7;
    const bf16_t* kg0 = Kg + (size_t)kr0 * 512 + kc * 8; const bf16_t* vg0 = Vg + (size_t)vd0 * 64 + vc * 8;
    const int klds0 = kr0 * KP + kc * 16, vlds0 = KBYTES + vd0 * VP + vc * 16;
    bf16x8 qf[8];
    { const bf16_t* qp = Q + (size_t)(rowbase + q0 + r32) * 512 + h * 128 + 8 * hi;
#pragma unroll
      for (int s = 0; s < 8; ++s) qf[s] = *(const bf16x8*)(qp + 16 * s); }
    u32x4 sk0 = *(const u32x4*)(kg0), sk1 = *(const u32x4*)(kg0 + (size_t)32 * 512), sv0 = *(const u32x4*)(vg0), sv1 = *(const u32x4*)(vg0 + 64 * 64);
    *(LAS u32x4*)(lds + klds0) = sk0; *(LAS u32x4*)(lds + klds0 + 32 * KP) = sk1; *(LAS u32x4*)(lds + vlds0) = sv0; *(LAS u32x4*)(lds + vlds0 + 64 * VP) = sv1;
    { const bf16_t* kg = kg0 + (size_t)64 * 512; const bf16_t* vg = vg0 + (size_t)4 * 8192;
      sk0 = *(const u32x4*)(kg); sk1 = *(const u32x4*)(kg + (size_t)32 * 512); sv0 = *(const u32x4*)(vg); sv1 = *(const u32x4*)(vg + 64 * 64); }
    unsigned mw = (kpar <= qb) ? mrow[kpar] : 0u;
    f32x16 o[4];
#pragma unroll
    for (int db = 0; db < 4; ++db)
#pragma unroll
        for (int r = 0; r < 16; ++r) o[db][r] = 0.f;
    float l = 0.f;
    const int kfo = (32 * kpar + kappa(r32)) * KP + 16 * hi, vfo = KBYTES + r32 * VP + kpar * 64 + 16 * hi;
    __syncthreads();
#define ATT_BAR() do { asm volatile("s_waitcnt lgkmcnt(0)" ::: "memory"); __builtin_amdgcn_s_barrier(); asm volatile("" ::: "memory"); } while (0)
    if (kpar == 1) ATT_BAR();
    for (int kt = 0; kt < ntiles; ++kt) {
        const bool more = kt + 1 < ntiles; unsigned mwn = 0u;
        if (more) { LAS unsigned char* nb = lds + ((kt + 1) & 1) * BUF;
            *(LAS u32x4*)(nb + klds0) = sk0; *(LAS u32x4*)(nb + klds0 + 32 * KP) = sk1; *(LAS u32x4*)(nb + vlds0) = sv0; *(LAS u32x4*)(nb + vlds0 + 64 * VP) = sv1;
            const int kbn = 2 * (kt + 1) + kpar; if (kbn <= qb) mwn = mrow[kbn]; }
        const int kb = 2 * kt + kpar; const bool act = kb <= qb;
        bf16x8 vf[4][2]; f32x16 p;
        if (act) {
            const LAS unsigned char* buf = lds + (kt & 1) * BUF;
            bf16x8 kf[8];
#pragma unroll
            for (int s = 0; s < 8; ++s) kf[s] = *(const LAS bf16x8*)(buf + kfo + 32 * s);
#pragma unroll
            for (int db = 0; db < 4; ++db) { vf[db][0] = *(const LAS bf16x8*)(buf + vfo + db * 32 * VP); vf[db][1] = *(const LAS bf16x8*)(buf + vfo + db * 32 * VP + 32); }
            __builtin_amdgcn_sched_barrier(0);
#pragma unroll
            for (int r = 0; r < 16; ++r) p[r] = negC;
#pragma unroll
            for (int s = 0; s < 8; ++s) p = MFMA32(kf[s], qf[s], p);
            __builtin_amdgcn_sched_barrier(0);
        }
        if (kt + 2 < ntiles) { const bf16_t* kg = kg0 + (size_t)(kt + 2) * 64 * 512; const bf16_t* vg = vg0 + (size_t)(kt + 2) * 4 * 8192;
            sk0 = *(const u32x4*)(kg); sk1 = *(const u32x4*)(kg + (size_t)32 * 512); sv0 = *(const u32x4*)(vg); sv1 = *(const u32x4*)(vg + 64 * 64); }
        ATT_BAR();
        if (act) {
            const unsigned wsh = mw >> (8 * hi);
#pragma unroll
            for (int r = 0; r < 16; ++r) {
                int m; asm("v_bfe_i32 %0, %1, %2, 1" : "=v"(m) : "v"(wsh), "n"((r & 7) + 16 * (r >> 3)));
                const float e = __int_as_float(__float_as_int(__builtin_amdgcn_exp2f(p[r])) & m); p[r] = e; l += e;
            }
            const bf16x8 pb0 = PACK8(p, 0), pb1 = PACK8(p, 1);
#pragma unroll
            for (int db = 0; db < 4; ++db) { o[db] = MFMA32(vf[db][0], pb0, o[db]); o[db] = MFMA32(vf[db][1], pb1, o[db]); }
        }
        mw = mwn;
        ATT_BAR();
    }
    if (kpar == 0) ATT_BAR();
#undef ATT_BAR
    LAS float* part = (LAS float*)lds; LAS float* lp = part + 4 * 64 * 64;
    if (kpar == 1) {
#pragma unroll
        for (int db = 0; db < 4; ++db)
#pragma unroll
            for (int r = 0; r < 16; ++r) part[(qsub * 64 + db * 16 + r) * 64 + lane] = o[db][r];
        lp[qsub * 64 + lane] = l;
    }
    __syncthreads();
    if (kpar == 0) {
        float lt = l + lp[qsub * 64 + lane]; lt += __shfl_xor(lt, 32);
        const float inv = 1.f / lt;
        bf16_t* orow = Ob + (size_t)(rowbase + q0 + r32) * 512 + h * 128;
#pragma unroll
        for (int db = 0; db < 4; ++db)
#pragma unroll
            for (int g = 0; g < 4; ++g) { const LAS float* pp = part + (qsub * 64 + db * 16 + 4 * g) * 64 + lane;
                u32x2 w; w.x = cvtpk((o[db][4 * g] + pp[0]) * inv, (o[db][4 * g + 1] + pp[64]) * inv); w.y = cvtpk((o[db][4 * g + 2] + pp[128]) * inv, (o[db][4 * g + 3] + pp[192]) * inv);
                *(u32x2*)(orow + db * 32 + 8 * g + 4 * hi) = w; }
    }
    __syncthreads();
}
__device__ __forceinline__ void vt_block(LAS unsigned char* lds, bf16_t* V, int blk) {
    const int tid = threadIdx.x; constexpr int PITCH = 520;
    LAS bf16_t* t = (LAS bf16_t*)lds; bf16_t* base = V + (size_t)blk * 64 * 512;
#pragma unroll
    for (int i = 0; i < 8; ++i) { const int c = i * 512 + tid, row = c >> 6, c16 = c & 63; *(LAS u32x4*)(t + row * PITCH + c16 * 8) = *(const u32x4*)(base + (size_t)row * 512 + c16 * 8); }
    __syncthreads();
#pragma unroll
    for (int i = 0; i < 8; ++i) { const int c = i * 512 + tid, hd = c >> 3, ch = c & 7; const LAS bf16_t* s = t + (8 * ch) * PITCH + hd;
        u32x4 w; w.x = (unsigned)s[0] | ((unsigned)s[PITCH] << 16); w.y = (unsigned)s[2 * PITCH] | ((unsigned)s[3 * PITCH] << 16); w.z = (unsigned)s[4 * PITCH] | ((unsigned)s[5 * PITCH] << 16); w.w = (unsigned)s[6 * PITCH] | ((unsigned)s[7 * PITCH] << 16);
        *(u32x4*)(base + (size_t)hd * 64 + 8 * ch) = w; }
    __syncthreads();
}

template <int PASS>
__device__ __forceinline__ void topk_pass(const LAS unsigned char* afl, const bf16_t* IX, unsigned* MASK, LAS unsigned* hist, const LAS float* bnd, const LAS unsigned* pfx, const LAS unsigned* lov, int rowbase, int t0, int j, int wave, int r32, int hi, int g0, int g1) {
    constexpr int STRIDE = (PASS == 4) ? 64 : 8;
    const int kb0 = (PASS == 4) ? 8 * wave : wave;
    const bf16_t* kif = (const bf16_t*)((const char*)IX - WS_IDX + WS_KIF) + (size_t)(rowbase >> 5) * 2048 + (r32 + 32 * hi) * 8;
#pragma unroll 1
    for (int g = g0; g < g1; ++g) {
        bf16x8 afr[4]; f32x4 bd[4]; unsigned pq[4], lo[4];
#pragma unroll
        for (int s = 0; s < 4; ++s) afr[s] = *(const LAS bf16x8*)(afl + (g * 8) * 528 + s * 32);
#pragma unroll
        for (int a4 = 0; a4 < 4; ++a4) { const int q = g * 8 + 2 * a4 + hi; bd[a4] = *(const LAS f32x4*)(bnd + q * 4); pq[a4] = pfx[q]; lo[a4] = lov[q]; }
        bf16x8 bfr[4];
        if (kb0 <= j) {
#pragma unroll
            for (int s = 0; s < 4; ++s) bfr[s] = *(const bf16x8*)(kif + (size_t)kb0 * 2048 + 512 * s); }
        for (int kb = kb0; kb <= j; kb += STRIDE) {
            bf16x8 bn[4];
            { const int kn = (kb + STRIDE <= j) ? kb + STRIDE : kb;
#pragma unroll
              for (int s = 0; s < 4; ++s) bn[s] = *(const bf16x8*)(kif + (size_t)kn * 2048 + 512 * s); }
            const unsigned idxterm = 8191u - (unsigned)(kb * 32 + r32);
            const bool diag = (kb == j);
            f32x16 acc;
#pragma unroll
            for (int r = 0; r < 16; ++r) acc[r] = 0.f;
#pragma unroll
            for (int s = 0; s < 4; ++s) acc = MFMA32(afr[s], bfr[s], acc);
#pragma unroll
            for (int a4 = 0; a4 < 4; ++a4) {
                const int q = g * 8 + 2 * a4 + hi;
                const float sc = ((__builtin_amdgcn_fmed3f(acc[4 * a4 + 0], 0.f, bd[a4].x) + __builtin_amdgcn_fmed3f(acc[4 * a4 + 1], 0.f, bd[a4].y)) + __builtin_amdgcn_fmed3f(acc[4 * a4 + 2], 0.f, bd[a4].z)) + __builtin_amdgcn_fmed3f(acc[4 * a4 + 3], 0.f, bd[a4].w);
                const unsigned u = __float_as_uint(sc); const unsigned k32 = u ^ ((unsigned)((int)u >> 31) | 0x80000000u);
                const unsigned key = (k32 & 0xFFFFE000u) | idxterm;
                const bool valid = !diag || (r32 <= q);
                if (PASS == 4) { hist[q * 1024 + (kb >> 3) * 32 + r32] = valid ? key : 0u; }
                else if (PASS == 3) { const unsigned long long bal = __ballot(valid && key >= pq[a4]);
                    if (r32 == 0) MASK[(size_t)(rowbase + t0 + q) * 256 + kb] = hi ? (unsigned)(bal >> 32) : (unsigned)bal; }
                else {
                    const bool live = valid && key >= lo[a4];
                    if (PASS == 0) { if (live) { const unsigned dg = key >> 21; atomicAdd((unsigned*)(hist + q * 1024 + (dg >> 1)), 1u << (16 * (dg & 1))); } }
                    else if (PASS == 1) { if (live && (key >> 21) == pq[a4]) { const unsigned dg = (key >> 10) & 2047u; atomicAdd((unsigned*)(hist + q * 1024 + (dg >> 1)), 1u << (16 * (dg & 1))); } }
                    else { if (live && (key >> 10) == pq[a4]) { const unsigned dg = key & 1023u; atomicAdd((unsigned*)(hist + q * 1024 + (dg >> 1)), 1u << (16 * (dg & 1))); } }
                }
            }
#pragma unroll
            for (int s = 0; s < 4; ++s) bfr[s] = bn[s];
        }
    }
}
__device__ __forceinline__ void topk_sample_pass(const LAS unsigned char* afl, const bf16_t* IX, LAS unsigned* hist, const LAS float* bnd, int rowbase, int j, int wave, int r32, int hi, int g0, int g1) {
    const int kb0 = 8 * wave;
    const bf16_t* kif = (const bf16_t*)((const char*)IX - WS_IDX + WS_KIF) + (size_t)(rowbase >> 5) * 2048 + (r32 + 32 * hi) * 8;
    if (kb0 > j) return;
    bf16x8 B[4][4];
#pragma unroll
    for (int i = 0; i < 4; ++i) { const int kb = (kb0 + 64 * i <= j) ? kb0 + 64 * i : kb0;
#pragma unroll
        for (int s = 0; s < 4; ++s) B[i][s] = *(const bf16x8*)(kif + (size_t)kb * 2048 + 512 * s); }
#pragma unroll 1
    for (int g = g0; g < g1; ++g) {
        bf16x8 afr[4]; f32x4 bd[4];
#pragma unroll
        for (int s = 0; s < 4; ++s) afr[s] = *(const LAS bf16x8*)(afl + (g * 8) * 528 + s * 32);
#pragma unroll
        for (int a4 = 0; a4 < 4; ++a4) bd[a4] = *(const LAS f32x4*)(bnd + (g * 8 + 2 * a4 + hi) * 4);
#pragma unroll
        for (int i = 0; i < 4; ++i) {
            const int kb = kb0 + 64 * i;
            if (kb <= j) {
                const unsigned idxterm = 8191u - (unsigned)(kb * 32 + r32);
                const bool diag = (kb == j);
                f32x16 acc;
#pragma unroll
                for (int r = 0; r < 16; ++r) acc[r] = 0.f;
#pragma unroll
                for (int s = 0; s < 4; ++s) acc = MFMA32(afr[s], B[i][s], acc);
#pragma unroll
                for (int a4 = 0; a4 < 4; ++a4) {
                    const int q = g * 8 + 2 * a4 + hi;
                    const float sc = ((__builtin_amdgcn_fmed3f(acc[4 * a4 + 0], 0.f, bd[a4].x) + __builtin_amdgcn_fmed3f(acc[4 * a4 + 1], 0.f, bd[a4].y)) + __builtin_amdgcn_fmed3f(acc[4 * a4 + 2], 0.f, bd[a4].z)) + __builtin_amdgcn_fmed3f(acc[4 * a4 + 3], 0.f, bd[a4].w);
                    const unsigned u = __float_as_uint(sc); const unsigned k32 = u ^ ((unsigned)((int)u >> 31) | 0x80000000u);
                    const unsigned key = (k32 & 0xFFFFE000u) | idxterm;
                    const bool valid = !diag || (r32 <= q);
                    hist[q * 1024 + (kb >> 3) * 32 + r32] = valid ? key : 0u;
                }
            }
        }
    }
}
template <int BITS>
__device__ __forceinline__ void topk_select(LAS unsigned* hist, LAS unsigned* pfx, LAS unsigned* needv, LAS unsigned* flag, int wave, int lane) {
    constexpr int wpl = (BITS == 10) ? 8 : 16;
    for (int i = 0; i < 4; ++i) {
        const int q = wave * 4 + i; const LAS unsigned* hq = hist + q * 1024 + lane * wpl;
        unsigned c = 0u;
#pragma unroll
        for (int wi = 0; wi < wpl; ++wi) { const unsigned w = hq[wi]; c += (w & 0xffffu) + (w >> 16); }
        unsigned incl = c;
#pragma unroll
        for (int o = 1; o < 64; o <<= 1) { const unsigned v = __shfl_down(incl, o); if (lane + o < 64) incl += v; }
        const unsigned S = incl - c, nq = needv[q];
        if (lane == 0 && incl < nq) *flag = 1u;
        if (S < nq && nq <= incl) {
            unsigned run = S, bin = 0u, nn = 1u; bool found = false;
            for (int wi = wpl - 1; wi >= 0 && !found; --wi) { const unsigned w = hq[wi]; const unsigned h16 = w >> 16, l16 = w & 0xffffu;
                if (run + h16 >= nq) { bin = 2u * (unsigned)(lane * wpl + wi) + 1u; nn = nq - run; found = true; }
                else { run += h16; if (run + l16 >= nq) { bin = 2u * (unsigned)(lane * wpl + wi); nn = nq - run; found = true; } else run += l16; } }
            pfx[q] = (pfx[q] << BITS) | bin; needv[q] = nn;
        }
    }
}
template <int NQW>
__device__ __forceinline__ void topk_sample_bound(const LAS unsigned* samp, LAS float* lof, int qb, int lane) {
    unsigned v[NQW][16];
#pragma unroll
    for (int i = 0; i < NQW; ++i)
#pragma unroll
        for (int e = 0; e < 16; ++e) v[i][e] = samp[(qb + i) * 1024 + e * 64 + lane];
    unsigned T[NQW];
#pragma unroll
    for (int i = 0; i < NQW; ++i) T[i] = 0u;
    for (int bit = 31; bit >= 13; --bit) {
        unsigned c[NQW];
#pragma unroll
        for (int i = 0; i < NQW; ++i) { const unsigned cd = T[i] | (1u << bit); c[i] = 0u;
#pragma unroll
            for (int e = 0; e < 16; ++e) c[i] += (v[i][e] >= cd) ? 1u : 0u;
            c[i] = wave_sum_u_dpp(c[i]); }
#pragma unroll
        for (int i = 0; i < NQW; ++i) if (c[i] >= 80u) T[i] |= (1u << bit);
    }
#pragma unroll
    for (int i = 0; i < NQW; ++i) { const unsigned ub = (T[i] & 0x80000000u) ? (T[i] ^ 0x80000000u) : ~T[i];
        if (lane == 0) lof[qb + i] = (T[i] == 0u) ? -INFINITY : __uint_as_float(ub); }
}
constexpr int TK_CAP = 128;
__device__ __forceinline__ void topk_collect(const LAS unsigned char* afl, const bf16_t* IX, LAS unsigned* cand, const LAS float* bnd, const LAS float* lof, LAS unsigned* cntw, int rowbase, int j, int wave, int r32, int hi, int lane, int rotseed, int g0, int g1) {
    const bf16_t* kif = (const bf16_t*)((const char*)IX - WS_IDX + WS_KIF) + (size_t)(rowbase >> 5) * 2048 + (r32 + 32 * hi) * 8;
    const unsigned lanemask = (1u << r32) - 1u;
#pragma unroll 1
    for (int g = g0; g < g1; ++g) {
        bf16x8 afr[4]; f32x4 bd[4]; float lf[4]; unsigned cnt[4];
#pragma unroll
        for (int s = 0; s < 4; ++s) afr[s] = *(const LAS bf16x8*)(afl + (g * 8) * 528 + s * 32);
#pragma unroll
        for (int a4 = 0; a4 < 4; ++a4) { const int q = g * 8 + 2 * a4 + hi; bd[a4] = *(const LAS f32x4*)(bnd + q * 4); lf[a4] = lof[q]; cnt[a4] = 0u; }
        const int nit = (wave <= j) ? ((j - wave) >> 3) + 1 : 0;
        int ii = nit ? (rotseed + 5 * g) % nit : 0;
        float lfd[4];
#pragma unroll
        for (int a4 = 0; a4 < 4; ++a4) lfd[a4] = (r32 <= g * 8 + 2 * a4 + hi) ? lf[a4] : INFINITY;
        bf16x8 B0[4], B1[4], B2[4];
        { const int i1 = (ii + 1 < nit) ? ii + 1 : 0;
#pragma unroll
          for (int s = 0; s < 4; ++s) { B0[s] = *(const bf16x8*)(kif + (size_t)(wave + 8 * ii) * 2048 + 512 * s); B1[s] = *(const bf16x8*)(kif + (size_t)(wave + 8 * i1) * 2048 + 512 * s); } }
        auto step = [&](const bf16x8 (&cur)[4], bf16x8 (&ld)[4]) __attribute__((always_inline)) {
            const int kb = wave + 8 * ii;
            ii = (ii + 1 < nit) ? ii + 1 : 0;
            { const int i2 = (ii + 1 < nit) ? ii + 1 : 0;
#pragma unroll
              for (int s = 0; s < 4; ++s) ld[s] = *(const bf16x8*)(kif + (size_t)(wave + 8 * i2) * 2048 + 512 * s); }
            const unsigned idxterm = 8191u - (unsigned)(kb * 32 + r32);
            const bool diag = (kb == j);
            f32x16 acc;
#pragma unroll
            for (int r = 0; r < 16; ++r) acc[r] = 0.f;
#pragma unroll
            for (int s = 0; s < 4; ++s) acc = MFMA32(afr[s], cur[s], acc);
            float sc[4]; bool live[4]; unsigned mine[4];
#pragma unroll
            for (int a4 = 0; a4 < 4; ++a4) sc[a4] = ((__builtin_amdgcn_fmed3f(acc[4 * a4 + 0], 0.f, bd[a4].x) + __builtin_amdgcn_fmed3f(acc[4 * a4 + 1], 0.f, bd[a4].y)) + __builtin_amdgcn_fmed3f(acc[4 * a4 + 2], 0.f, bd[a4].z)) + __builtin_amdgcn_fmed3f(acc[4 * a4 + 3], 0.f, bd[a4].w);
#pragma unroll
            for (int a4 = 0; a4 < 4; ++a4) { live[a4] = sc[a4] >= (diag ? lfd[a4] : lf[a4]); const unsigned long long bal = __ballot(live[a4]); mine[a4] = hi ? (unsigned)(bal >> 32) : (unsigned)bal; }
#pragma unroll
            for (int a4 = 0; a4 < 4; ++a4) {
                const int q = g * 8 + 2 * a4 + hi;
                const unsigned u = __float_as_uint(sc[a4]); const unsigned k32 = u ^ ((unsigned)((int)u >> 31) | 0x80000000u);
                const unsigned key = (k32 & 0xFFFFE000u) | idxterm;
                const unsigned pos = cnt[a4] + (unsigned)__popc(mine[a4] & lanemask);
                if (live[a4] && pos < (unsigned)TK_CAP) cand[(q * 8 + wave) * TK_CAP + pos] = key;
                cnt[a4] += (unsigned)__popc(mine[a4]);
            }
        };
        for (int n = nit; n > 0; ) { step(B0, B2); if (--n == 0) break; step(B1, B0); if (--n == 0) break; step(B2, B1); --n; }
        if (r32 == 0) {
#pragma unroll
            for (int a4 = 0; a4 < 4; ++a4) cntw[wave * 32 + g * 8 + 2 * a4 + hi] = cnt[a4];
        }
    }
}
template <int NQW>
__device__ __forceinline__ void topk_pick_t(const LAS unsigned* cand, const LAS unsigned* cntw, LAS unsigned* rowbuf, LAS unsigned* flag, unsigned* MASK, int rowbase, int t0, int j, int wave, int lane, int qb) {
    LAS unsigned* row = rowbuf + wave * 256;
    unsigned v[NQW][16]; unsigned need[NQW], ntotv[NQW]; bool ok[NQW];
#pragma unroll
    for (int i = 0; i < NQW; ++i) {
        const int q = qb + i; unsigned ntot = 0u; bool over = false;
#pragma unroll
        for (int e = 0; e < 16; ++e) { const int slot = e * 64 + lane, w = slot >> 7, p = slot & 127; const unsigned c = cntw[w * 32 + q]; v[i][e] = ((unsigned)p < c) ? cand[q * 1024 + slot] : 0u; }
#pragma unroll
        for (int w = 0; w < 8; ++w) { const unsigned c = cntw[w * 32 + q]; ntot += c; over |= (c > (unsigned)TK_CAP); }
        const int n = t0 + q + 1; need[i] = (unsigned)(n < 256 ? n : 256);
        ok[i] = !(over || ntot < need[i]); ntotv[i] = ntot;
        if (!ok[i] && lane == 0) *flag = 1u;
    }
    unsigned T[NQW], cT[NQW]; int hbmax = -1;
#pragma unroll
    for (int i = 0; i < NQW; ++i) {
        unsigned mx = 0u, mnc = 0u;
#pragma unroll
        for (int e = 0; e < 16; ++e) { mx = max(mx, v[i][e]); mnc = max(mnc, v[i][e] ? ~v[i][e] : 0u); }
        mx = wave_max_u(mx); const unsigned mn = ~wave_max_u(mnc);
        const unsigned d = (mx >= mn) ? (mx ^ mn) : 0u;
        const int hb = d ? 31 - __builtin_clz(d) : -1;
        T[i] = (hb >= 0) ? ((hb == 31) ? 0u : (mx & ~((2u << hb) - 1u))) : mx;
        cT[i] = ntotv[i]; hbmax = hb > hbmax ? hb : hbmax;
    }
    for (int bit = hbmax; bit >= 0; --bit) {
        bool done = true;
#pragma unroll
        for (int i = 0; i < NQW; ++i) done = done && (!ok[i] || cT[i] == need[i]);
        if (done) break;
        unsigned c[NQW];
#pragma unroll
        for (int i = 0; i < NQW; ++i) { const unsigned cd = T[i] | (1u << bit); c[i] = 0u;
#pragma unroll
            for (int e = 0; e < 16; ++e) c[i] += (v[i][e] >= cd) ? 1u : 0u;
            c[i] = wave_sum_u_dpp(c[i]); }
#pragma unroll
        for (int i = 0; i < NQW; ++i) if (c[i] >= need[i]) { T[i] |= (1u << bit); cT[i] = c[i]; }
    }
#pragma unroll
    for (int i = 0; i < NQW; ++i) {
        if (!ok[i]) continue;
        const int q = qb + i;
#pragma unroll
        for (int e = 0; e < 4; ++e) row[e * 64 + lane] = 0u;
#pragma unroll
        for (int e = 0; e < 16; ++e) if (v[i][e] != 0u && v[i][e] >= T[i]) { const unsigned sidx = 8191u - (v[i][e] & 8191u); atomicOr((unsigned*)(row + (sidx >> 5)), 1u << (sidx & 31u)); }
        for (int w = lane; w <= j; w += 64) MASK[(size_t)(rowbase + t0 + q) * 256 + w] = row[w];
    }
}
__device__ __forceinline__ void lds_clear128k(LAS unsigned char* lds, int tid) {
#pragma unroll
    for (int i = 0; i < 16; ++i) *(LAS u32x4*)(lds + (size_t)(i * 512 + tid) * 16) = (u32x4){0u, 0u, 0u, 0u};
}
__device__ __forceinline__ void topk_item(LAS unsigned char* lds, char* ws, int b, int j, int g0, int g1) {
    const int tid = threadIdx.x, lane = tid & 63, wave = __builtin_amdgcn_readfirstlane(tid >> 6), r32 = lane & 31, hi = lane >> 5, rowbase = b * SEQ, t0 = j * 32;
    const bf16_t* IX = (const bf16_t*)(ws + WS_IDX); unsigned* MASK = (unsigned*)(ws + WS_MASK);
    LAS unsigned* hist = (LAS unsigned*)lds;
    LAS unsigned* rowbuf = (LAS unsigned*)(lds + 150528);
    LAS float* bnd = (LAS float*)(lds + 147968);
    LAS unsigned* pfx = (LAS unsigned*)(lds + 147968 + 512);
    LAS unsigned* needv = (LAS unsigned*)(lds + 147968 + 640);
    LAS unsigned* lov = (LAS unsigned*)(lds + 147968 + 768);
    LAS unsigned* flag = (LAS unsigned*)(lds + 147968 + 896);
    LAS float* lof = (LAS float*)(lds + 147968 + 1024);
    LAS unsigned* cntw = (LAS unsigned*)(lds + 147968 + 1152);
    LAS unsigned char* abase = lds + 131072;
#pragma unroll 1
    for (int rr = 0; rr < REP_HEAD; ++rr) {
    { const int q = tid >> 4, c16 = tid & 15;
      const bf16_t* rowp = IX + (size_t)(rowbase + t0 + q) * 512;
      const u32x4 v0 = *(const u32x4*)(rowp + c16 * 8), v1 = *(const u32x4*)(rowp + 128 + c16 * 8);
      const float w0 = bf2f(rowp[320 + (c16 >> 3)]) * 0.0625f, w1 = bf2f(rowp[322 + (c16 >> 3)]) * 0.0625f;
      u32x4 o0, o1;
#define FOLD2(X, W) pk2(__uint_as_float((X) << 16) * (W), __uint_as_float((X) & 0xffff0000u) * (W))
      o0.x = FOLD2(v0.x, w0); o0.y = FOLD2(v0.y, w0); o0.z = FOLD2(v0.z, w0); o0.w = FOLD2(v0.w, w0);
      o1.x = FOLD2(v1.x, w1); o1.y = FOLD2(v1.y, w1); o1.z = FOLD2(v1.z, w1); o1.w = FOLD2(v1.w, w1);
#undef FOLD2
      *(LAS u32x4*)(abase + q * 528 + c16 * 16) = o0; *(LAS u32x4*)(abase + q * 528 + 256 + c16 * 16) = o1; }
    if (tid < 128) { const int q = tid >> 2, c = tid & 3; const float w = bf2f(IX[(size_t)(rowbase + t0 + q) * 512 + 320 + c]); bnd[tid] = (w >= 0.f) ? INFINITY : -INFINITY; }
    if (tid < 32) { pfx[tid] = 0u; const int n = t0 + tid + 1; needv[tid] = (unsigned)(n < 256 ? n : 256); lov[tid] = 0u; lof[tid] = -INFINITY; }
    if (tid == 0) *flag = 0u;
    if (j >= 32) {
        const int nrow16 = (g1 - g0) * 8 * 256;
        for (int i = tid; i < nrow16; i += 512) *(LAS u32x4*)(lds + (size_t)g0 * 8 * 4096 + (size_t)i * 16) = (u32x4){0u, 0u, 0u, 0u}; }
    __syncthreads(); }
    const LAS unsigned char* afl = abase + (r32 >> 2) * 528 + (r32 & 3) * 128 + hi * 16;
    if (j >= 32) {
#pragma unroll 1
        for (int rr = 0; rr < REP_SAMPLE; ++rr) {
        topk_sample_pass(afl, IX, hist, bnd, rowbase, j, wave, r32, hi, g0, g1);
        __syncthreads(); if (g1 - g0 == 4) topk_sample_bound<4>(hist, lof, wave * 4, lane); else if (g1 - g0 == 2) topk_sample_bound<2>(hist, lof, g0 * 8 + wave * 2, lane); else topk_sample_bound<1>(hist, lof, g0 * 8 + wave, lane); __syncthreads(); }
    }
#pragma unroll 1
    for (int rr = 0; rr < REP_COLLECT; ++rr) { topk_collect(afl, IX, hist, bnd, lof, cntw, rowbase, j, wave, r32, hi, lane, (j * 2 + b) * 29, g0, g1); __syncthreads(); }
#pragma unroll 1
    for (int rr = 0; rr < REP_PICK; ++rr) { if (g1 - g0 == 4) topk_pick_t<4>(hist, cntw, rowbuf, flag, MASK, rowbase, t0, j, wave, lane, wave * 4); else if (g1 - g0 == 2) topk_pick_t<2>(hist, cntw, rowbuf, flag, MASK, rowbase, t0, j, wave, lane, g0 * 8 + wave * 2); else topk_pick_t<1>(hist, cntw, rowbuf, flag, MASK, rowbase, t0, j, wave, lane, g0 * 8 + wave); __syncthreads(); }
    if (*flag == 0u) return;
#if DIFF_F
    if (tid == 0) atomicAdd((float*)(ws + 32768), 1.0f);
#endif
    __syncthreads(); lds_clear128k(lds, tid); __syncthreads();
    topk_pass<0>(afl, IX, MASK, hist, bnd, pfx, lov, rowbase, t0, j, wave, r32, hi, g0, g1);
    __syncthreads(); topk_select<11>(hist, pfx, needv, flag, wave, lane); __syncthreads(); lds_clear128k(lds, tid); __syncthreads();
    topk_pass<1>(afl, IX, MASK, hist, bnd, pfx, lov, rowbase, t0, j, wave, r32, hi, g0, g1);
    __syncthreads(); topk_select<11>(hist, pfx, needv, flag, wave, lane); __syncthreads(); lds_clear128k(lds, tid); __syncthreads();
    topk_pass<2>(afl, IX, MASK, hist, bnd, pfx, lov, rowbase, t0, j, wave, r32, hi, g0, g1);
    __syncthreads(); topk_select<10>(hist, pfx, needv, flag, wave, lane); __syncthreads();
    topk_pass<3>(afl, IX, MASK, hist, bnd, pfx, lov, rowbase, t0, j, wave, r32, hi, g0, g1);
    __syncthreads();
}

constexpr int NWAVES = 8, LDS_BYTES = 160768, RING_BYTES = 131072;
struct MArgs { const void* in[23]; float* out; char* ws; int ph_lo, ph_hi; };

__device__ __forceinline__ void conv_item(const float* W, int K, int Nsrc, bf16_t* WT, int mode, int srcoff, int Ndst, LAS float* scr, int item, int lane) {
    const int nblk = Ndst / 32, kb = item / nblk, nb = item % nblk, k0 = 64 * kb, n0 = 32 * nb;
    const int c4 = lane & 7, rsub = lane >> 3; const int n = n0 + 4 * c4; const int scol = (mode == 1) ? win_srccol(n) : srcoff + n;
    f32x4 wv[8];
#pragma unroll
    for (int i = 0; i < 8; ++i) wv[i] = (scol >= 0) ? __builtin_nontemporal_load((const f32x4*)(W + (size_t)(k0 + 8 * i + rsub) * Nsrc + scol)) : (f32x4){0.f, 0.f, 0.f, 0.f};
#pragma unroll
    for (int i = 0; i < 8; ++i) { LAS float* d = scr + (8 * i + rsub) * 33 + 4 * c4; d[0] = wv[i].x; d[1] = wv[i].y; d[2] = wv[i].z; d[3] = wv[i].w; }
    asm volatile("s_waitcnt lgkmcnt(0)" ::: "memory");
    const int c = lane & 7;
#pragma unroll
    for (int j = 0; j < 4; ++j) { const int nn = (lane >> 3) + 8 * j; const LAS float* s = scr + (8 * c) * 33 + nn;
        u32x4 o; o.x = pk2(s[0 * 33], s[1 * 33]); o.y = pk2(s[2 * 33], s[3 * 33]); o.z = pk2(s[4 * 33], s[5 * 33]); o.w = pk2(s[6 * 33], s[7 * 33]);
        *(u32x4*)(WT + (size_t)(n0 + nn) * K + k0 + 8 * c) = o; }
    asm volatile("s_waitcnt lgkmcnt(0)" ::: "memory");
}
__device__ __forceinline__ void rms_row(const float* x, float* xcopy, const float* g, bf16_t* out, int m, int lane) {
    const f32x4* xr = (const f32x4*)(x + (size_t)m * DM) + lane; f32x4 v[4]; float s = 0.f;
#pragma unroll
    for (int j = 0; j < 4; ++j) { v[j] = xr[64 * j]; s += (v[j].x * v[j].x + v[j].y * v[j].y) + (v[j].z * v[j].z + v[j].w * v[j].w); }
    s = wave_sum(s); const float r = rsqrtf(s * (1.f / DM) + EPS);
    if (xcopy) {
#pragma unroll
        for (int j = 0; j < 4; ++j) ((f32x4*)(xcopy + (size_t)m * DM) + lane)[64 * j] = v[j];
    }
#pragma unroll
    for (int j = 0; j < 4; ++j) { const f32x4 gg = ((const f32x4*)g + lane)[64 * j]; u32x2 w; w.x = pk2(v[j].x * r * gg.x, v[j].y * r * gg.y); w.y = pk2(v[j].z * r * gg.z, v[j].w * r * gg.w);
        *(u32x2*)(out + (size_t)m * DM + (64 * j + lane) * 4) = w; }
}
__device__ __forceinline__ void rms_row2(const float* x, float* xcopy, const float* g, bf16_t* out, int m0, int m1, int lane) {
    const f32x4* xa = (const f32x4*)(x + (size_t)m0 * DM) + lane; const f32x4* xb = (const f32x4*)(x + (size_t)m1 * DM) + lane; f32x4 va[4], vb[4]; float sa = 0.f, sb = 0.f;
#pragma unroll
    for (int j = 0; j < 4; ++j) { va[j] = xa[64 * j]; vb[j] = xb[64 * j]; }
#pragma unroll
    for (int j = 0; j < 4; ++j) { sa += (va[j].x * va[j].x + va[j].y * va[j].y) + (va[j].z * va[j].z + va[j].w * va[j].w); sb += (vb[j].x * vb[j].x + vb[j].y * vb[j].y) + (vb[j].z * vb[j].z + vb[j].w * vb[j].w); }
    sa = wave_sum(sa); sb = wave_sum(sb); const float ra = rsqrtf(sa * (1.f / DM) + EPS), rb = rsqrtf(sb * (1.f / DM) + EPS);
    if (xcopy) {
#pragma unroll
        for (int j = 0; j < 4; ++j) { ((f32x4*)(xcopy + (size_t)m0 * DM) + lane)[64 * j] = va[j]; ((f32x4*)(xcopy + (size_t)m1 * DM) + lane)[64 * j] = vb[j]; }
    }
#pragma unroll
    for (int j = 0; j < 4; ++j) { const f32x4 gg = ((const f32x4*)g + lane)[64 * j]; u32x2 w;
        w.x = pk2(va[j].x * ra * gg.x, va[j].y * ra * gg.y); w.y = pk2(va[j].z * ra * gg.z, va[j].w * ra * gg.w); *(u32x2*)(out + (size_t)m0 * DM + (64 * j + lane) * 4) = w;
        w.x = pk2(vb[j].x * rb * gg.x, vb[j].y * rb * gg.y); w.y = pk2(vb[j].z * rb * gg.z, vb[j].w * rb * gg.w); *(u32x2*)(out + (size_t)m1 * DM + (64 * j + lane) * 4) = w; }
}
__device__ __forceinline__ void rms_row2_bf(const bf16_t* x, const float* g, bf16_t* out, int m0, int m1, int lane) {
    f32x4 va[2][2], vb[2][2]; float sa = 0.f, sb = 0.f;
#pragma unroll
    for (int j = 0; j < 2; ++j) { load8bf(x + (size_t)m0 * DM + j * 512 + lane * 8, va[j][0], va[j][1]); load8bf(x + (size_t)m1 * DM + j * 512 + lane * 8, vb[j][0], vb[j][1]); }
#pragma unroll
    for (int j = 0; j < 2; ++j)
#pragma unroll
        for (int h = 0; h < 2; ++h) { sa += (va[j][h].x * va[j][h].x + va[j][h].y * va[j][h].y) + (va[j][h].z * va[j][h].z + va[j][h].w * va[j][h].w); sb += (vb[j][h].x * vb[j][h].x + vb[j][h].y * vb[j][h].y) + (vb[j][h].z * vb[j][h].z + vb[j][h].w * vb[j][h].w); }
    sa = wave_sum(sa); sb = wave_sum(sb); const float ra = rsqrtf(sa * (1.f / DM) + EPS), rb = rsqrtf(sb * (1.f / DM) + EPS);
#pragma unroll
    for (int j = 0; j < 2; ++j) { const f32x4 g0 = *(const f32x4*)(g + j * 512 + lane * 8), g1 = *(const f32x4*)(g + j * 512 + lane * 8 + 4);
        store8bf(out + (size_t)m0 * DM + j * 512 + lane * 8, va[j][0] * ra * g0, va[j][1] * ra * g1); store8bf(out + (size_t)m1 * DM + j * 512 + lane * 8, vb[j][0] * rb * g0, vb[j][1] * rb * g1); }
}
template <int NT>
__device__ __forceinline__ void prepass_tokens(char* ws, const int (&mm)[NT], int w, int lane, int t256, const float* g_qa, const float* g_ka, const float* g_kidx) {
    bf16_t q0r[NT], q1r[NT], k0r[NT], k1r[NT], iqr[NT], ikr[NT], iwr[NT];
    float cA[NT], sA[NT], cI[NT], sI[NT];
    const float gq0 = g_qa[lane], gq1 = g_qa[lane + 64], gk0 = g_ka[lane], gk1 = g_ka[lane + 64], gki = g_kidx[lane];
#pragma unroll
    for (int t = 0; t < NT; ++t) { const size_t mo = (size_t)mm[t] * 512;
        const bf16_t* pq = (const bf16_t*)(ws + WS_QA) + mo + w * 128; const bf16_t* pk = (const bf16_t*)(ws + WS_KA) + mo + w * 128; const bf16_t* ix = (const bf16_t*)(ws + WS_IDX) + mo;
        const float* rt = (const float*)(ws + WS_ROPE) + (size_t)mm[t] * 48;
        q0r[t] = pq[lane]; q1r[t] = pq[lane + 64]; k0r[t] = pk[lane]; k1r[t] = pk[lane + 64]; iqr[t] = ix[w * 64 + lane]; ikr[t] = ix[256 + lane]; iwr[t] = ix[320 + w];
        cA[t] = rt[lane & 15]; sA[t] = rt[16 + (lane & 15)]; cI[t] = rt[32 + (lane & 7)]; sI[t] = rt[40 + (lane & 7)];
    }
#pragma unroll
    for (int t = 0; t < NT; ++t) { const int m = mm[t]; const size_t mo = (size_t)m * 512;
        bf16_t* pq = (bf16_t*)(ws + WS_QA) + mo + w * 128; bf16_t* pk = (bf16_t*)(ws + WS_KA) + mo + w * 128; bf16_t* ix = (bf16_t*)(ws + WS_IDX) + mo;
        float qo0, qo1, ko0, ko1;
        { const float v0 = bf2f(q0r[t]), v1 = bf2f(q1r[t]); const float r = rsqrtf(wave_sum(v0 * v0 + v1 * v1) * (1.f / 128.f) + EPS);
          float y0 = v0 * r * gq0; const float y1 = v1 * r * gq1; const float part = __shfl_xor(y0, 16);
          if (lane < 32) y0 = (lane < 16) ? y0 * cA[t] - part * sA[t] : y0 * cA[t] + part * sA[t];
          qo0 = y0 * QSCALE; qo1 = y1 * QSCALE; }
        { const float v0 = bf2f(k0r[t]), v1 = bf2f(k1r[t]); const float r = rsqrtf(wave_sum(v0 * v0 + v1 * v1) * (1.f / 128.f) + EPS);
          float y0 = v0 * r * gk0; const float y1 = v1 * r * gk1; const float part = __shfl_xor(y0, 16);
          if (lane < 32) y0 = (lane < 16) ? y0 * cA[t] - part * sA[t] : y0 * cA[t] + part * sA[t];
          ko0 = y0; ko1 = y1; }
        float iqo, iko;
        { float y = bf2f(iqr[t]); const float part = __shfl_xor(y, 8);
          if (lane < 16) y = (lane < 8) ? y * cI[t] - part * sI[t] : y * cI[t] + part * sI[t];
          iqo = y * bf2f(iwr[t]) * 0.0625f; }
        { const float v = bf2f(ikr[t]); const float r = rsqrtf(wave_sum(v * v) * (1.f / 64.f) + EPS);
          float y = v * r * gki; const float part = __shfl_xor(y, 8);
          if (lane < 16) y = (lane < 8) ? y * cI[t] - part * sI[t] : y * cI[t] + part * sI[t];
          iko = y; }
        pq[lane] = (bf16_t)f2bf(qo0); pq[lane + 64] = (bf16_t)f2bf(qo1); pk[lane] = (bf16_t)f2bf(ko0); pk[lane + 64] = (bf16_t)f2bf(ko1);
        ix[w * 64 + lane] = (bf16_t)f2bf(iqo);
        if (w == 0) { ix[256 + lane] = (bf16_t)f2bf(iko);
            ((bf16_t*)(ws + WS_KIF))[(((size_t)(m >> 5) * 4 + (lane >> 4)) * 64 + (m & 31) + 32 * ((lane >> 3) & 1)) * 8 + (lane & 7)] = (bf16_t)f2bf(iko); }
    }
}
__device__ __forceinline__ void conv_token(char* ws, int m, int lane, const float* cbw, const float* cbb, const float* lng, const float* lnb, const float* ccw) {
    const int t = m & (SEQ - 1); const int c0 = lane * 8;
    {
        const bf16_t* U = (const bf16_t*)(ws + WS_GLUA); float acc[8];
#pragma unroll
        for (int j = 0; j < 8; ++j) acc[j] = cbb[c0 + j];
        for (int k = 0; k < 31; ++k) { const int tt = t - 30 + k; if (tt < 0) continue;
            const bf16x8 u = *(const bf16x8*)(U + (size_t)(m - 30 + k) * 512 + c0);
#pragma unroll
            for (int j = 0; j < 8; ++j) acc[j] += cbw[k * 512 + c0 + j] * bfs2f(u[j]); }
        float s = 0.f;
#pragma unroll
        for (int j = 0; j < 8; ++j) s += acc[j];
        const float mean = wave_sum(s) * (1.f / 512.f); float q = 0.f;
#pragma unroll
        for (int j = 0; j < 8; ++j) { acc[j] -= mean; q += acc[j] * acc[j]; }
        const float r = rsqrtf(wave_sum(q) * (1.f / 512.f) + EPS); float o[8];
#pragma unroll
        for (int j = 0; j < 8; ++j) { const float y = acc[j] * r * lng[c0 + j] + lnb[c0 + j]; o[j] = y * sigmoidf_(y); }
        u32x4 wv; wv.x = pk2(o[0], o[1]); wv.y = pk2(o[2], o[3]); wv.z = pk2(o[4], o[5]); wv.w = pk2(o[6], o[7]);
        *(u32x4*)((bf16_t*)(ws + WS_GLUB) + (size_t)m * 512 + c0) = wv;
    }
    {
        const bf16_t* X = (const bf16_t*)(ws + WS_GC); float acc[8];
#pragma unroll
        for (int j = 0; j < 8; ++j) acc[j] = 0.f;
        for (int k = 0; k < 3; ++k) { const int tt = t - 2 + k; if (tt < 0) continue;
            const bf16x8 u = *(const bf16x8*)(X + (size_t)(m - 2 + k) * 512 + c0);
#pragma unroll
            for (int j = 0; j < 8; ++j) acc[j] += ccw[k * 512 + c0 + j] * bfs2f(u[j]); }
        const bf16x8 g = *(const bf16x8*)((const bf16_t*)(ws + WS_GB) + (size_t)m * 512 + c0); float o[8];
#pragma unroll
        for (int j = 0; j < 8; ++j) o[j] = acc[j] * bfs2f(g[j]);
        u32x4 wv; wv.x = pk2(o[0], o[1]); wv.y = pk2(o[2], o[3]); wv.z = pk2(o[4], o[5]); wv.w = pk2(o[6], o[7]);
        *(u32x4*)((bf16_t*)(ws + WS_XC) + (size_t)m * 512 + c0) = wv;
    }
}

__device__ __forceinline__ void conv_run8(char* ws, int m0, int lane, const LAS float* wB, const LAS float* wC, const float* cbb, const float* lng, const float* lnb) {
    const int t0 = m0 & (SEQ - 1), c0 = lane * 8;
    {
        float acc[8][8];
        { const f32x4 b0 = *(const f32x4*)(cbb + c0), b1 = *(const f32x4*)(cbb + c0 + 4);
#pragma unroll
          for (int i = 0; i < 8; ++i) { acc[i][0] = b0.x; acc[i][1] = b0.y; acc[i][2] = b0.z; acc[i][3] = b0.w; acc[i][4] = b1.x; acc[i][5] = b1.y; acc[i][6] = b1.z; acc[i][7] = b1.w; } }
        const bf16_t* U = (const bf16_t*)(ws + WS_GLUA) + c0;
#pragma unroll 1
        for (int rc = 0; rc < 5; ++rc) {
            bf16x8 u[8];
#pragma unroll
            for (int rr = 0; rr < 8; ++rr) { const int r = 8 * rc + rr; u[rr] = (bf16x8){0, 0, 0, 0, 0, 0, 0, 0}; if (r < 38 && t0 - 30 + r >= 0) u[rr] = *(const bf16x8*)(U + (size_t)(m0 - 30 + r) * 512); }
#pragma unroll
            for (int rr = 0; rr < 8; ++rr) {
                float uf[8];
#pragma unroll
                for (int j = 0; j < 8; ++j) uf[j] = bfs2f(u[rr][j]);
#pragma unroll
                for (int i = 0; i < 8; ++i) { const int k = 8 * rc + rr - i;
                    if (k >= 0 && k <= 30) { const LAS float* wp = wB + k * 512 + c0; const f32x4 w0 = *(const LAS f32x4*)wp, w1 = *(const LAS f32x4*)(wp + 4);
                        acc[i][0] += w0.x * uf[0]; acc[i][1] += w0.y * uf[1]; acc[i][2] += w0.z * uf[2]; acc[i][3] += w0.w * uf[3];
                        acc[i][4] += w1.x * uf[4]; acc[i][5] += w1.y * uf[5]; acc[i][6] += w1.z * uf[6]; acc[i][7] += w1.w * uf[7]; } }
            }
        }
        const f32x4 g0 = *(const f32x4*)(lng + c0), g1 = *(const f32x4*)(lng + c0 + 4), e0 = *(const f32x4*)(lnb + c0), e1 = *(const f32x4*)(lnb + c0 + 4);
        const float gg[8] = {g0.x, g0.y, g0.z, g0.w, g1.x, g1.y, g1.z, g1.w}, ee[8] = {e0.x, e0.y, e0.z, e0.w, e1.x, e1.y, e1.z, e1.w};
#pragma unroll
        for (int i = 0; i < 8; ++i) {
            float sm = 0.f;
#pragma unroll
            for (int j = 0; j < 8; ++j) sm += acc[i][j];
            const float mean = wave_sum(sm) * (1.f / 512.f); float q = 0.f;
#pragma unroll
            for (int j = 0; j < 8; ++j) { acc[i][j] -= mean; q += acc[i][j] * acc[i][j]; }
            const float r = rsqrtf(wave_sum(q) * (1.f / 512.f) + EPS); float o[8];
#pragma unroll
            for (int j = 0; j < 8; ++j) { const float y = acc[i][j] * r * gg[j] + ee[j]; o[j] = y * sigmoidf_(y); }
            u32x4 wv; wv.x = pk2(o[0], o[1]); wv.y = pk2(o[2], o[3]); wv.z = pk2(o[4], o[5]); wv.w = pk2(o[6], o[7]);
            *(u32x4*)((bf16_t*)(ws + WS_GLUB) + (size_t)(m0 + i) * 512 + c0) = wv;
        }
    }
    {
        float acc[8][8];
#pragma unroll
        for (int i = 0; i < 8; ++i)
#pragma unroll
            for (int j = 0; j < 8; ++j) acc[i][j] = 0.f;
        const bf16_t* X = (const bf16_t*)(ws + WS_GC) + c0;
        bf16x8 u[10];
#pragma unroll
        for (int r = 0; r < 10; ++r) { u[r] = (bf16x8){0, 0, 0, 0, 0, 0, 0, 0}; if (t0 - 2 + r >= 0) u[r] = *(const bf16x8*)(X + (size_t)(m0 - 2 + r) * 512); }
#pragma unroll
        for (int r = 0; r < 10; ++r) {
            float uf[8];
#pragma unroll
            for (int j = 0; j < 8; ++j) uf[j] = bfs2f(u[r][j]);
#pragma unroll
            for (int i = 0; i < 8; ++i) { const int k = r - i;
                if (k >= 0 && k <= 2) { const LAS float* wp = wC + k * 512 + c0; const f32x4 w0 = *(const LAS f32x4*)wp, w1 = *(const LAS f32x4*)(wp + 4);
                    acc[i][0] += w0.x * uf[0]; acc[i][1] += w0.y * uf[1]; acc[i][2] += w0.z * uf[2]; acc[i][3] += w0.w * uf[3];
                    acc[i][4] += w1.x * uf[4]; acc[i][5] += w1.y * uf[5]; acc[i][6] += w1.z * uf[6]; acc[i][7] += w1.w * uf[7]; } }
        }
#pragma unroll
        for (int i = 0; i < 8; ++i) {
            const bf16x8 g = *(const bf16x8*)((const bf16_t*)(ws + WS_GB) + (size_t)(m0 + i) * 512 + c0); float o[8];
#pragma unroll
            for (int j = 0; j < 8; ++j) o[j] = acc[i][j] * bfs2f(g[j]);
            u32x4 wv; wv.x = pk2(o[0], o[1]); wv.y = pk2(o[2], o[3]); wv.z = pk2(o[4], o[5]); wv.w = pk2(o[6], o[7]);
            *(u32x4*)((bf16_t*)(ws + WS_XC) + (size_t)(m0 + i) * 512 + c0) = wv;
        }
    }
}

__device__ __forceinline__ void conv_run4(char* ws, int m0, int half, int lane, const LAS float* wB, const LAS float* wC, const float* cbb, const float* lng, const float* lnb, LAS float* red) {
    const int t0 = m0 & (SEQ - 1), c0 = half * 256 + lane * 4;
    float acc[8][4];
    { const f32x4 b0 = *(const f32x4*)(cbb + c0);
#pragma unroll
      for (int i = 0; i < 8; ++i) { acc[i][0] = b0.x; acc[i][1] = b0.y; acc[i][2] = b0.z; acc[i][3] = b0.w; } }
    {
        float uf[38][4];
        const bf16_t* U = (const bf16_t*)(ws + WS_GLUA) + c0;
#pragma unroll
        for (int r = 0; r < 38; ++r) { u32x2 v = (u32x2){0u, 0u}; if (t0 - 30 + r >= 0) v = *(const u32x2*)(U + (size_t)(m0 - 30 + r) * 512);
            uf[r][0] = __uint_as_float(v.x << 16); uf[r][1] = __uint_as_float(v.x & 0xffff0000u); uf[r][2] = __uint_as_float(v.y << 16); uf[r][3] = __uint_as_float(v.y & 0xffff0000u); }
#pragma unroll
        for (int k = 0; k < 31; ++k) { const f32x4 w = *(const LAS f32x4*)(wB + k * 512 + c0);
#pragma unroll
            for (int i = 0; i < 8; ++i) { acc[i][0] += w.x * uf[i + k][0]; acc[i][1] += w.y * uf[i + k][1]; acc[i][2] += w.z * uf[i + k][2]; acc[i][3] += w.w * uf[i + k][3]; } }
    }
    float s1[8], s2[8];
#pragma unroll
    for (int i = 0; i < 8; ++i) { s1[i] = wave_sum((acc[i][0] + acc[i][1]) + (acc[i][2] + acc[i][3])); s2[i] = wave_sum((acc[i][0] * acc[i][0] + acc[i][1] * acc[i][1]) + (acc[i][2] * acc[i][2] + acc[i][3] * acc[i][3])); }
    if (lane == 0) {
#pragma unroll
        for (int i = 0; i < 8; ++i) { red[half * 16 + i * 2] = s1[i]; red[half * 16 + i * 2 + 1] = s2[i]; } }
    __syncthreads();
    { const f32x4 g0 = *(const f32x4*)(lng + c0), e0 = *(const f32x4*)(lnb + c0);
#pragma unroll
      for (int i = 0; i < 8; ++i) {
          const float mean = (s1[i] + red[(half ^ 1) * 16 + i * 2]) * (1.f / 512.f), var = (s2[i] + red[(half ^ 1) * 16 + i * 2 + 1]) * (1.f / 512.f) - mean * mean;
          const float r = rsqrtf(fmaxf(var, 0.f) + EPS);
          const float y0 = (acc[i][0] - mean) * r * g0.x + e0.x, y1 = (acc[i][1] - mean) * r * g0.y + e0.y, y2 = (acc[i][2] - mean) * r * g0.z + e0.z, y3 = (acc[i][3] - mean) * r * g0.w + e0.w;
          u32x2 wv; wv.x = pk2(y0 * sigmoidf_(y0), y1 * sigmoidf_(y1)); wv.y = pk2(y2 * sigmoidf_(y2), y3 * sigmoidf_(y3));
          *(u32x2*)((bf16_t*)(ws + WS_GLUB) + (size_t)(m0 + i) * 512 + c0) = wv; } }
    {
        float a2[8][4], xf[10][4];
#pragma unroll
        for (int i = 0; i < 8; ++i) { a2[i][0] = 0.f; a2[i][1] = 0.f; a2[i][2] = 0.f; a2[i][3] = 0.f; }
        const bf16_t* X = (const bf16_t*)(ws + WS_GC) + c0;
#pragma unroll
        for (int r = 0; r < 10; ++r) { u32x2 v = (u32x2){0u, 0u}; if (t0 - 2 + r >= 0) v = *(const u32x2*)(X + (size_t)(m0 - 2 + r) * 512);
            xf[r][0] = __uint_as_float(v.x << 16); xf[r][1] = __uint_as_float(v.x & 0xffff0000u); xf[r][2] = __uint_as_float(v.y << 16); xf[r][3] = __uint_as_float(v.y & 0xffff0000u); }
#pragma unroll
        for (int k = 0; k < 3; ++k) { const f32x4 w = *(const LAS f32x4*)(wC + k * 512 + c0);
#pragma unroll
            for (int i = 0; i < 8; ++i) { a2[i][0] += w.x * xf[i + k][0]; a2[i][1] += w.y * xf[i + k][1]; a2[i][2] += w.z * xf[i + k][2]; a2[i][3] += w.w * xf[i + k][3]; } }
#pragma unroll
        for (int i = 0; i < 8; ++i) { const u32x2 g = *(const u32x2*)((const bf16_t*)(ws + WS_GB) + (size_t)(m0 + i) * 512 + c0);
            u32x2 wv; wv.x = pk2(a2[i][0] * __uint_as_float(g.x << 16), a2[i][1] * __uint_as_float(g.x & 0xffff0000u)); wv.y = pk2(a2[i][2] * __uint_as_float(g.y << 16), a2[i][3] * __uint_as_float(g.y & 0xffff0000u));
            *(u32x2*)((bf16_t*)(ws + WS_XC) + (size_t)(m0 + i) * 512 + c0) = wv; }
    }
}

template <class F, bool BR, bool ALIGN, class Sched>
__device__ __forceinline__ void run_gemm(LAS unsigned char* lds, const bf16_t* A, const bf16_t* Bt, int M, int N, int K, const Sched& S, const F& f) {
    const pg8::Gemm g{A, Bt, M, N, K}; const pg8::EpiFnB<F, BR> E{f};
    pg8::gemm_phase<pg8::EpiFnB<F, BR>, Sched, ALIGN, true>(lds, g, S, E);
}


#define XB_TMO      128
#define XB_XCNT(j)  (256  + 64 * (j))
#define XB_XSUB(j)  (1280 + 64 * (j))
#define XB_XGEN(j)  (2304 + 64 * (j))
#define XB_TOP      3328
#define XB_TOPGEN   3392
#define XCD_BAR_WORDS 3456
#define XB_SPIN_CAP (1u << 18)

__device__ __forceinline__ unsigned xb_ld(unsigned* p)              { return __hip_atomic_load(p, __ATOMIC_RELAXED, __HIP_MEMORY_SCOPE_AGENT); }
__device__ __forceinline__ unsigned xb_add(unsigned* p, unsigned v) { return __hip_atomic_fetch_add(p, v, __ATOMIC_RELAXED, __HIP_MEMORY_SCOPE_AGENT); }
__device__ __forceinline__ unsigned xb_xcc_id() { return (unsigned)__builtin_amdgcn_s_getreg((3 << 11) | 20) & 0xFu; }
#define XB_SPIN(cond, bar) do { unsigned _sp = 0; while (cond) { __builtin_amdgcn_s_sleep(1); \
    if ((++_sp & 255u) == 0u) { if (xb_ld(&(bar)[XB_TMO])) break; if (_sp > XB_SPIN_CAP) { atomicAdd(&(bar)[XB_TMO], 1u); break; } } } } while (0)

struct XcdBarrier {
    unsigned* bar; unsigned x;
    volatile LAS unsigned* st;
};

__device__ __forceinline__ XcdBarrier xcd_barrier_post(unsigned* bar, volatile LAS unsigned* st) {
    XcdBarrier b; b.bar = bar; b.x = xb_xcc_id(); b.st = st;
    if (threadIdx.x == 0) (void)xb_add(&bar[XB_XCNT(b.x)], 1u);
    return b;
}
__device__ __forceinline__ void xcd_barrier_complete(unsigned* bar, unsigned x, unsigned& nloc, unsigned& nx) {
    const unsigned G = gridDim.x * gridDim.y * gridDim.z;
    unsigned sum, cnt, mine, sp = 0u;
    for (;;) {
        sum = 0u; cnt = 0u; mine = 0u;
#pragma unroll
        for (unsigned j = 0; j < 16; ++j) { const unsigned c = xb_ld(&bar[XB_XCNT(j)]); sum += c; cnt += (c > 0u) ? 1u : 0u; mine = (j == x) ? c : mine; }
        if (sum == G) break;
        __builtin_amdgcn_s_sleep(1);
        if ((++sp & 255u) == 0u) { if (xb_ld(&bar[XB_TMO])) break; if (sp > XB_SPIN_CAP) { atomicAdd(&bar[XB_TMO], 1u); break; } }
    }
    nloc = mine > 0u ? mine : 1u; nx = cnt > 0u ? cnt : 1u;
}

__device__ __forceinline__ void xcd_barrier(const XcdBarrier& b) {
    asm volatile("s_waitcnt vmcnt(0)" ::: "memory");
    __syncthreads();
    if (threadIdx.x == 0) {
        unsigned* bar = b.bar;
        __builtin_amdgcn_s_waitcnt(0);
        unsigned nloc = b.st[0], nx = b.st[1];
        if (nloc == 0u) { xcd_barrier_complete(bar, b.x, nloc, nx); b.st[0] = nloc; b.st[1] = nx; }
        const unsigned old = xb_add(&bar[XB_XSUB(b.x)], 1u);
        const unsigned gen = old / nloc;
        if (old + 1u == (gen + 1u) * nloc) {
            __builtin_amdgcn_fence(__ATOMIC_RELEASE, "agent");
            asm volatile("s_waitcnt vmcnt(0)" ::: "memory");
            const unsigned og = xb_add(&bar[XB_TOP], 1u);
            const unsigned tg = og / nx;
            if (og + 1u == (tg + 1u) * nx) xb_add(&bar[XB_TOPGEN], 1u);
            else XB_SPIN(xb_ld(&bar[XB_TOPGEN]) == tg, bar);
            __builtin_amdgcn_fence(__ATOMIC_ACQUIRE, "agent");
            xb_add(&bar[XB_XGEN(b.x)], 1u);
            asm volatile("s_waitcnt vmcnt(0)" ::: "memory");
        } else {
            XB_SPIN(xb_ld(&bar[XB_XGEN(b.x)]) == gen, bar);
            __builtin_amdgcn_fence(__ATOMIC_ACQUIRE, "agent");
            asm volatile("s_waitcnt vmcnt(0)" ::: "memory");
        }
    }
    __syncthreads();
}

#define FIN(i) ((const float*)a.in[i])
#ifndef PROBE_PHASE
#define PROBE_PHASE -1
#endif
#ifndef TOPK_REPS
#define TOPK_REPS 1
#endif
#ifndef CONV_REPS
#define CONV_REPS 1
#endif
#ifndef PROBE_REPS
#define PROBE_REPS 2
#endif
#define REPS(kk) ((kk) == PROBE_PHASE ? PROBE_REPS : 0)
#define PH_BEGIN(kk) if (a.ph_lo <= L * 16 + (kk) && L * 16 + (kk) < a.ph_hi) { if (TS_EPI >= 0 && blockIdx.x == 0 && threadIdx.x == 0) { g_phase = L * 16 + (kk); if (L * 16 + (kk) == 0) { g_dbg[0] = 0ull; g_dbg[1] = 0ull; } } __syncthreads(); const unsigned long long tbusy0 = (TS_BUSY == (kk)) ? __builtin_amdgcn_s_memrealtime() : 0ull; for (int rep = 0; rep <= REPS(kk); ++rep) {
#define PH_END(kk) if (TS_BUSY == (kk) && L == 0 && threadIdx.x == 0) ((unsigned long long*)(a.ws + 65536 + 1024))[blockIdx.x] = __builtin_amdgcn_s_memrealtime() - tbusy0; \
    if (rep < REPS(kk) || L * 16 + (kk) + 1 < a.ph_hi) { if (a.ph_hi < 0) grid.sync();   xcd_barrier(bar); } } \
    if (TS_PHASE >= 0 && blockIdx.x == 0 && threadIdx.x == 0) ((unsigned long long*)(a.ws + 65536))[L * 16 + (kk) + 1] = __builtin_amdgcn_s_memrealtime(); }
__device__ __forceinline__ int next_item(unsigned* ctr, LAS unsigned char* lds) {
    volatile LAS unsigned* slot = (volatile LAS unsigned*)(lds + 160016);
    __syncthreads();
    if (threadIdx.x == 0) *slot = atomicAdd(ctr, 1u);
    __syncthreads();
    return (int)*slot;
}
__device__ __forceinline__ unsigned take_early(unsigned* ctr) { return (threadIdx.x == 0) ? atomicAdd(ctr, 1u) : 0u; }
__device__ __forceinline__ int publish_late(unsigned v, LAS unsigned char* lds) {
    volatile LAS unsigned* slot = (volatile LAS unsigned*)(lds + 160016);
    if (threadIdx.x == 0) *slot = v;
    __syncthreads();
    const int r = (int)*slot;
    __syncthreads();
    return r;
}
template <int L> __device__ __forceinline__ void weight_item(const MArgs& a, LAS float* scr, int wi, int lane) {
    char* ws = a.ws;
    constexpr int I_WIN = 16 * 192, I_WG = 16 * 128, I_WO = 8 * 32, I_WM = 16 * 32, I_FF = 16 * 88, I_FD = 44 * 32;
    int r = wi;
    if (r < I_WG) { conv_item(FIN(3) + (size_t)L * DM * NIN_SRC, DM, NIN_SRC, (bf16_t*)(ws + WS_WGATE), 0, 5956, 4096, scr, r, lane); return; } r -= I_WG;
    if (r < 4 * I_WO) { const int br = r / I_WO; const int idx = br == 0 ? 8 : br == 1 ? 13 : br == 2 ? 15 : 16;
        conv_item(FIN(idx) + (size_t)L * 512 * DM, 512, DM, (bf16_t*)(ws + WS_WO) + (size_t)br * DM * 512, 0, 0, DM, scr, r % I_WO, lane); return; } r -= 4 * I_WO;
    if (r < I_WM) { conv_item(FIN(17) + (size_t)L * DM * DM, DM, DM, (bf16_t*)(ws + WS_WM), 0, 0, DM, scr, r, lane); return; } r -= I_WM;
    if (r < I_FF) { conv_item(FIN(19) + (size_t)L * DM * DFF, DM, DFF, (bf16_t*)(ws + WS_WFG), 0, 0, DFF, scr, r, lane); return; } r -= I_FF;
    if (r < I_FF) { conv_item(FIN(20) + (size_t)L * DM * DFF, DM, DFF, (bf16_t*)(ws + WS_WFU), 0, 0, DFF, scr, r, lane); return; } r -= I_FF;
    if (r < I_FD) { conv_item(FIN(22) + (size_t)L * DFF * DM, DFF, DM, (bf16_t*)(ws + WS_WFD), 0, 0, DM, scr, r, lane); return; } r -= I_FD;
    if (L + 1 < DEPTH && r < I_WIN) conv_item(FIN(3) + (size_t)(L + 1) * DM * NIN_SRC, DM, NIN_SRC, (bf16_t*)(ws + WS_WIN), 1, 0, 6144, scr, r, lane);
}
template <int L> __device__ __forceinline__ void phase3_body(const MArgs& a, LAS unsigned char* lds) {
    const int tid = threadIdx.x, lane = tid & 63, wave = __builtin_amdgcn_readfirstlane(tid >> 6);
    unsigned* ctr = (unsigned*)(a.ws + 15360) + L * 2;
    constexpr int NWC = (2048 + 1024 + 512 + 2 * 1408 + 1408 + (L + 1 < DEPTH ? 3072 : 0)) / 8, T_END = 1408;
    static_assert(NWC <= 1408, "queue layout");
    int it = next_item(ctr, lds);
#if !NAIVE_TOPK
    while (it < T_END) {
        const int ti = it;
        int b, j, g0, g1;
        { const int r = 63 - ti / 22, k = ti % 22, t = k >> 1; b = k & 1;
          if (t == 0) { j = r; g0 = 0; g1 = 4; }
          else if (t < 3) { j = 64 + r; g0 = 2 * (t - 1); g1 = g0 + 2; }
          else { const int u = t - 3; j = 128 + 2 * r + (u >> 2); g0 = u & 3; g1 = g0 + 1; } }
#pragma unroll 1
        for (int r2 = 0; r2 < TOPK_REPS; ++r2) topk_item(lds, a.ws, b, j, g0, g1);
        if (it < NWC) weight_item<L>(a, (LAS float*)(lds + wave * 16384), it * 8 + wave, lane);
        it = next_item(ctr, lds);
    }
#else
    while (it < T_END) it = next_item(ctr, lds);
#endif
    if (it < T_END + 256) {
        LAS float* wB = (LAS float*)lds; LAS float* wC = wB + 31 * 512;
        const f32x4* sB = (const f32x4*)(FIN(9) + (size_t)L * 31 * 512); const f32x4* sC = (const f32x4*)(FIN(14) + (size_t)L * 3 * 512);
        for (int i = tid; i < 31 * 128; i += NWAVES * 64) ((LAS f32x4*)wB)[i] = sB[i];
        for (int i = tid; i < 3 * 128; i += NWAVES * 64) ((LAS f32x4*)wC)[i] = sC[i];
        __syncthreads();
        do {
#pragma unroll 1
            for (int pass = 0; pass < 2; ++pass)
                conv_run4(a.ws, (it - T_END) * 64 + ((wave >> 1) + 4 * pass) * 8, wave & 1, lane, wB, wC, FIN(10) + L * 512, FIN(11) + L * 512, FIN(12) + L * 512, (LAS float*)(lds + 73728) + pass * 128 + (wave >> 1) * 32);
            it = next_item(ctr, lds);
        } while (it < T_END + 256);
    }
    while (it < T_END + 512) {
#if !NAIVE_D
        const int si = (it - T_END - 256) * 8 + wave;
        sb_item(a.ws, (bf16_t*)(a.ws + WS_SQ), si >> 10, (si >> 8) & 3, si & 255, lane);
#endif
        it = next_item(ctr, lds);
    }
}
template <int L> __device__ __forceinline__ void layer_phases(const MArgs& a, LAS unsigned char* lds, const cg::grid_group& grid, const XcdBarrier& bar) {
    const int tid = threadIdx.x, lane = tid & 63, wave = __builtin_amdgcn_readfirstlane(tid >> 6);
    const int G = gridDim.x, bx = blockIdx.x;
    if (L == 0) {
    PH_BEGIN(0)
        char* ws = a.ws; const int gw = bx * NWAVES + wave, NGW = G * NWAVES;
        LAS float* scr = (LAS float*)(lds + wave * 16384);
        const float* w_in = FIN(3) + (size_t)L * DM * NIN_SRC;
        if (L == 0) for (int it = gw; it < 16 * 192; it += NGW) conv_item(w_in, DM, NIN_SRC, (bf16_t*)(ws + WS_WIN), 1, 0, 6144, scr, it, lane);
        if (L == 0) { for (int m = gw; m < MTOK; m += 2 * NGW) rms_row2(FIN(0), (float*)nullptr, FIN(2) + (size_t)L * DM, (bf16_t*)(ws + WS_H), m, m + NGW, lane); }
        else { for (int m = gw; m < MTOK; m += 2 * NGW) rms_row2_bf((const bf16_t*)a.out, FIN(2) + (size_t)L * DM, (bf16_t*)(ws + WS_H), m, m + NGW, lane); }
        if (L == 0) {
            const int* positions = (const int*)a.in[1]; float* rt = (float*)(ws + WS_ROPE);
            for (int idx = gw * 64 + lane; idx < MTOK * 24; idx += NGW * 64) { const int m = idx / 24, f = idx - m * 24;
                const float inv = (f < 16) ? powf(500000.f, -((float)f * 2.0f) / 32.f) : powf(500000.f, -((float)(f - 16) * 2.0f) / 16.f);
                const float ang = (float)positions[m] * inv; const int o = (f < 16) ? f : 16 + f;
                rt[(size_t)m * 48 + o] = cosf(ang); rt[(size_t)m * 48 + o + ((f < 16) ? 16 : 8)] = sinf(ang); }
        }
    PH_END(0)
    }
    PH_BEGIN(1)
        pg8::StaticOrder S; S.init(MTOK, 6144, G, bx);
        const pg8::Gemm g{(const bf16_t*)(a.ws + WS_H), (const bf16_t*)(a.ws + WS_WIN), MTOK, 6144, DM}; const pg8::EpiInProj E{a.ws, lds, FIN(5) + L * 128, FIN(6) + L * 128, FIN(7) + L * 64, L == 0 ? (const float*)nullptr : (const float*)(a.ws + WS_PART)};
        pg8::gemm_phase<pg8::EpiInProj, pg8::StaticOrder, true, true>(lds, g, S, E);
    PH_END(1)
    PH_BEGIN(3)
#if TS_PHASE == 100 && TS_BUSY < 0
        const unsigned long long tb0 = __builtin_amdgcn_s_memrealtime();
#endif
        phase3_body<L>(a, lds);
#if TS_PHASE == 100 && TS_BUSY < 0
        if (L == 0 && threadIdx.x == 0) ((unsigned long long*)(a.ws + 65536 + 1024))[blockIdx.x] = __builtin_amdgcn_s_memrealtime() - tb0;
#endif
    PH_END(3)
    PH_BEGIN(4)
#if !NAIVE_A
        { const float* gq = FIN(5) + L * 128; const float* gk = FIN(6) + L * 128;
          const float mq = wave_max(fmaxf(fabsf(gq[lane]), fabsf(gq[lane + 64]))), mk = wave_max(fmaxf(fabsf(gk[lane]), fabsf(gk[lane + 64])));
          const float negC = -16.33f * mq * mk;
          for (;;) { const int it = next_item((unsigned*)(a.ws + 15360) + L * 2 + 1 + 8 * rep, lds); if (it >= 512) break; const int bh = it & 7; attnA_unit(lds, a.ws, (bf16_t*)(a.ws + (rep ? WS_END : WS_QA)), bh >> 2, bh & 3, 63 - (it >> 3), negC); } }
#endif
    PH_END(4)
    PH_BEGIN(5)
        pg8::StaticOrder S; S.init(MTOK, 4096, G, bx);
        run_gemm<EpiGatesRS, false, true>(lds, (const bf16_t*)(a.ws + WS_H), (const bf16_t*)(a.ws + WS_WGATE), MTOK, 4096, DM, S, EpiGatesRS{EpiGates{(unsigned char*)(a.ws + WS_GATES), FIN(4) + (size_t)L * 4096}, L == 0 ? (const float*)nullptr : (const float*)(a.ws + WS_PART)});
    PH_END(5)
    PH_BEGIN(6)
        pg8::BranchOrder S; S.init(G, bx);
        run_gemm<EpiOut, true, true>(lds, (const bf16_t*)(a.ws + WS_BR), (const bf16_t*)(a.ws + WS_WO), MTOK, DM, 512, S, EpiOut{(const unsigned char*)(a.ws + WS_GATES), (bf16_t*)(a.ws + WS_H)});
    PH_END(6)
    PH_BEGIN(7)
        pg8::StaticOrder S; S.init(MTOK, DM, G, bx);
        const pg8::Gemm g{(const bf16_t*)(a.ws + WS_H), (const bf16_t*)(a.ws + WS_WM), MTOK, DM, DM};
        if (L == 0) { const pg8::EpiResidNorm<false> E{(bf16_t*)(a.ws + WS_X1), FIN(0), FIN(18) + (size_t)L * DM, (bf16_t*)a.out + (size_t)MTOK * DM, (float*)(a.ws + WS_PART), lds, rep ? 0.f : 1.f, 0};
            pg8::gemm_phase<pg8::EpiResidNorm<false>, pg8::StaticOrder, true, true>(lds, g, S, E); }
        else { const pg8::EpiResidNorm<true> E{(bf16_t*)(a.ws + WS_X1), a.out, FIN(18) + (size_t)L * DM, (bf16_t*)a.out + (size_t)MTOK * DM, (float*)(a.ws + WS_PART), lds, rep ? 0.f : 1.f, 0};
            pg8::gemm_phase<pg8::EpiResidNorm<true>, pg8::StaticOrder, true, true>(lds, g, S, E); }
    PH_END(7)
    PH_BEGIN(9)
        pg8::StaticOrder S; S.init(MTOK, DFF, G, bx);
        run_gemm<EpiStoreRS, false, true>(lds, (const bf16_t*)a.out + (size_t)MTOK * DM, (const bf16_t*)(a.ws + WS_WFG), MTOK, DFF, DM, S, EpiStoreRS{(bf16_t*)(a.ws + WS_GP), (const float*)(a.ws + WS_PART), DFF, 0});
    PH_END(9)
    PH_BEGIN(10)
        pg8::StaticOrder S; S.init(MTOK, DFF, G, bx);
        run_gemm<EpiFfnActRS, false, true>(lds, (const bf16_t*)a.out + (size_t)MTOK * DM, (const bf16_t*)(a.ws + WS_WFU), MTOK, DFF, DM, S, EpiFfnActRS{EpiFfnAct{(const bf16_t*)(a.ws + WS_GP), FIN(21) + (size_t)L * 3 * DFF, (bf16_t*)(a.ws + WS_ACT)}, (const float*)(a.ws + WS_PART)});
    PH_END(10)
    PH_BEGIN(11)
        pg8::StaticOrder S; S.init(MTOK, DM, G, bx);
        if (L + 1 < DEPTH) {
            const pg8::Gemm g{(const bf16_t*)(a.ws + WS_ACT), (const bf16_t*)(a.ws + WS_WFD), MTOK, DM, DFF};
            const pg8::EpiResidNorm<true> E{(bf16_t*)a.out, a.ws + WS_X1, FIN(2) + (size_t)(L + 1) * DM, (bf16_t*)(a.ws + WS_H), (float*)(a.ws + WS_PART), lds, rep ? 0.f : 1.f, 0};
            pg8::gemm_phase<pg8::EpiResidNorm<true>, pg8::StaticOrder, true, true>(lds, g, S, E); }
        else run_gemm<EpiResidT<true, false>, false, false>(lds, (const bf16_t*)(a.ws + WS_ACT), (const bf16_t*)(a.ws + WS_WFD), MTOK, DM, DFF, S, EpiResidT<true, false>{a.out, a.ws + WS_X1, rep ? 0.f : 1.f, 0});
    PH_END(11)
}
__global__ void __launch_bounds__(NWAVES * 64, 2) mega(MArgs a) {
    extern __shared__ __attribute__((aligned(16))) unsigned char lds_raw[];
    cg::grid_group grid = cg::this_grid();
    LAS unsigned char* lds = (LAS unsigned char*)lds_raw;
    volatile LAS unsigned* misc = (volatile LAS unsigned*)(lds + 160000);
    if (threadIdx.x < 2) misc[threadIdx.x] = 0u;
    __syncthreads();
    const XcdBarrier bar = xcd_barrier_post((unsigned*)a.ws, misc);
    if (TS_PHASE >= 0 && blockIdx.x == 0 && threadIdx.x == 0) ((unsigned long long*)(a.ws + 65536))[0] = __builtin_amdgcn_s_memrealtime();
    layer_phases<0>(a, lds, grid, bar);
    layer_phases<1>(a, lds, grid, bar);
#if TS_PHASE >= 0
    {
        xcd_barrier(bar);
        const unsigned long long* ts = (const unsigned long long*)(a.ws + 65536);
#if TS_PHASE == 104
        const float frac = (float)g_dbg[0] / (float)(ts[28] - ts[0]);
#elif TS_PHASE == 102
        const unsigned long long* td = (const unsigned long long*)(a.ws + 65536 + 8192);
        unsigned long long sum = 0ull; int cntI = 0;
        for (int i = 0; i < 512; ++i) { const int jj = 255 - (i >> 1); if (jj >= TS_JLO && jj <= TS_JHI) { if (TS_MAX) { if (td[i] > sum) sum = td[i]; cntI = 1; } else { sum += td[i]; ++cntI; } } }
        const float frac = ((float)sum / (float)cntI) / (float)(ts[28] - ts[0]);
#elif TS_PHASE == 100 || TS_PHASE == 101
        unsigned long long sum = 0ull; for (int i = 0; i < (int)gridDim.x; ++i) sum += ts[128 + i];
        const float frac = ((float)sum / (float)gridDim.x) / (float)(ts[28] - ts[0]);
#else
        const unsigned long long t_start = (TS_PHASE == 0) ? ts[0] : ((TS_PHASE == 16) ? ts[12] : ts[TS_PHASE]);
        const float frac = (float)(ts[TS_PHASE + 1] - t_start) / (float)(ts[28] - ts[0]);
#endif
        const float f = 1.f + sqrtf(TS_SCALE * frac);
        for (size_t i = (size_t)blockIdx.x * 512 + threadIdx.x; i < (size_t)MTOK * DM / 4; i += (size_t)gridDim.x * 512) { f32x4* p = (f32x4*)a.out + i; *p = *p * f; }
    }
#endif
}
#undef FIN

#ifndef DIFF_A
#define DIFF_A 0
#endif
__global__ __launch_bounds__(256) void k_compare(const bf16_t* a, const bf16_t* b, size_t n, float* acc) {
    float num = 0.f, den = 0.f;
    for (size_t i = (size_t)blockIdx.x * 256 + threadIdx.x; i < n; i += (size_t)gridDim.x * 256) { const float x = bf2f(a[i]), y = bf2f(b[i]); num += (x - y) * (x - y); den += y * y; }
    num = wave_sum(num); den = wave_sum(den);
    if ((threadIdx.x & 63) == 0) { atomicAdd(acc, num); atomicAdd(acc + 1, den); }
}
#ifndef DIFF_T
#define DIFF_T 0
#endif
#ifndef DIFF_F
#define DIFF_F 0
#endif
__global__ __launch_bounds__(256) void k_compare_mask(const unsigned* a, const unsigned* b, float* acc) {
    float num = 0.f, den = 0.f;
    for (size_t i = (size_t)blockIdx.x * 256 + threadIdx.x; i < (size_t)MTOK * 256; i += (size_t)gridDim.x * 256) { const int m = (int)(i >> 8), w = (int)(i & 255);
        if (w <= ((m & (SEQ - 1)) >> 5)) { const unsigned x = a[i], y = b[i]; num += (float)__popc(x ^ y); den += (float)__popc(y); } }
    num = wave_sum(num); den = wave_sum(den);
    if ((threadIdx.x & 63) == 0) { atomicAdd(acc, num); atomicAdd(acc + 1, den); }
}
__global__ __launch_bounds__(256) void k_encode(float* out, size_t n, const float* acc) {
    const float f = DIFF_F ? 1.f + sqrtf(acc[0] * (1e-2f / 1024.f)) : 1.f + (DIFF_T ? 1.f : 10.f) * sqrtf(acc[0] / acc[1]);
    for (size_t i = (size_t)blockIdx.x * 256 + threadIdx.x; i < n; i += (size_t)gridDim.x * 256) out[i] *= f;
}
template <class Epi> static void gemm_simple(hipStream_t st, const bf16_t* A, int lda, const bf16_t* Bt, int ldb, int M, int N, int K, Epi e, int aux = 0) {
    GemmArgs<Epi> ga{}; ga.A = A; ga.Bt = Bt; ga.lda = lda; ga.ldb = ldb; ga.K = K; ga.aux = aux; ga.epi = e;
    hipLaunchKernelGGL(k_gemm_simple<Epi>, dim3(N / 128, M / 128), dim3(256), 0, st, ga);
}
static int g_grid = 0;
static void launch_mega(hipStream_t st, MArgs a, int lo, int hi) {
    a.ph_lo = lo; a.ph_hi = hi; void* args[] = {&a};
    hipMemsetAsync(a.ws, 0, 16384, st);
    hipError_t e = hipLaunchCooperativeKernel((const void*)mega, dim3(g_grid), dim3(NWAVES * 64), args, LDS_BYTES, st);
    if (e != hipSuccess) fprintf(stderr, "cooperative launch failed: %s (grid %d)\n", hipGetErrorString(e), g_grid);
}

extern "C" void kernel_launch(void* const* d_in, const int* in_sizes, int n_in, void* d_out, int out_size, void* d_ws, size_t ws_size, hipStream_t stream) {
    if (n_in != 23 || ws_size < WS_ROPE + 3 * MiB || out_size != MTOK * DM) { fprintf(stderr, "kernel_launch: unexpected shapes (n_in %d, ws %zu, out %d)\n", n_in, ws_size, out_size); return; }
    if (g_grid == 0) {
        int dev = 0, cus = 0, per_cu = 0;
        hipGetDevice(&dev); hipDeviceGetAttribute(&cus, hipDeviceAttributeMultiprocessorCount, dev);
        if (hipFuncSetAttribute((const void*)mega, hipFuncAttributeMaxDynamicSharedMemorySize, LDS_BYTES) != hipSuccess) { fprintf(stderr, "hipFuncSetAttribute failed\n"); g_grid = -1; return; }
        if (hipOccupancyMaxActiveBlocksPerMultiprocessor(&per_cu, (const void*)mega, NWAVES * 64, LDS_BYTES) != hipSuccess || per_cu < 1) { fprintf(stderr, "occupancy query: %d blocks/CU\n", per_cu); g_grid = -1; return; }
        g_grid = cus * per_cu;
        if (g_grid < 256) { fprintf(stderr, "this kernel needs 256 co-resident workgroups, the device admits %d\n", g_grid); g_grid = -1; return; }
        g_grid = 256;
    }
    if (g_grid < 0) return;
    char* ws = (char*)d_ws;
    MArgs a{}; for (int i = 0; i < 23; ++i) a.in[i] = d_in[i]; a.out = (float*)d_out; a.ws = ws;
#if DIFF_F
    hipMemsetAsync(ws + 32768, 0, 64, stream);
    launch_mega(stream, a, 0, 28);
    hipLaunchKernelGGL(k_encode, dim3(1024), dim3(256), 0, stream, (float*)d_out, (size_t)MTOK * DM, (const float*)(ws + 32768));
#elif !(NAIVE_TOPK || NAIVE_A || NAIVE_D || DIFF_A || DIFF_T)
    launch_mega(stream, a, 0, 28);
#else
    for (int l = 0; l < DEPTH; ++l) {
        launch_mega(stream, a, l * 16 + 0, l * 16 + 4);
#if NAIVE_TOPK
        hipLaunchKernelGGL(k_topk_naive, dim3(MTOK), dim3(256), 0, stream, (const char*)ws, (unsigned*)(ws + WS_MASK));
#endif
#if DIFF_T
        if (l == 0) {
            hipMemsetAsync(ws + 32768, 0, 64, stream);
            hipLaunchKernelGGL(k_topk_naive, dim3(MTOK), dim3(256), 0, stream, (const char*)ws, (unsigned*)(ws + WS_END));
            hipLaunchKernelGGL(k_compare_mask, dim3(1024), dim3(256), 0, stream, (const unsigned*)(ws + WS_MASK), (const unsigned*)(ws + WS_END), (float*)(ws + 32768));
        }
#endif
#if NAIVE_A
        hipLaunchKernelGGL(k_attnA_naive, dim3(MTOK), dim3(256), 0, stream, ws, (bf16_t*)(ws + WS_QA));
#endif
#if NAIVE_D
        hipLaunchKernelGGL(k_sb_naive, dim3(MTOK * 4), dim3(256), 0, stream, ws);
#endif
#if DIFF_A
        if (l == 0) {
            hipMemsetAsync(ws + 32768, 0, 64, stream);
            hipLaunchKernelGGL(k_attnA_naive, dim3(MTOK), dim3(256), 0, stream, ws, (bf16_t*)(ws + WS_END));
            launch_mega(stream, a, l * 16 + 4, l * 16 + 5);
            hipLaunchKernelGGL(k_compare, dim3(1024), dim3(256), 0, stream, (const bf16_t*)(ws + WS_QA), (const bf16_t*)(ws + WS_END), (size_t)MTOK * 512, (float*)(ws + 32768));
            launch_mega(stream, a, l * 16 + 5, l * 16 + 12);
        } else
#endif
        launch_mega(stream, a, l * 16 + 4, l * 16 + 12);
    }
#endif
#if DIFF_A || DIFF_T
    hipLaunchKernelGGL(k_encode, dim3(1024), dim3(256), 0, stream, (float*)d_out, (size_t)MTOK * DM, (const float*)(ws + 32768));
#endif
}
```
